# Optimizing an MI355X kernel written in HIP

```python
import jax, jax.numpy as jnp
from jax import lax
import numpy as np


D_MODEL = 1024
BATCH = 16
SEQ = 4096
DEPTH = 1

CHUNK = 64
Q_BLOCK = 128
GLA_HEADS = 4
GLA_DK = 64
GLA_DV = 128
GLA_LOWRANK = 16
GLA_TAU = 16.0
FOX_HEADS = 8
FOX_HD = 64
D_FF = 2816
CONV_W = 3
EPS = 1e-6

GLA_WIDTH = GLA_HEADS * GLA_DV
FOX_WIDTH = FOX_HEADS * FOX_HD
IN_SPLITS = (GLA_HEADS * GLA_DK, GLA_HEADS * GLA_DK, GLA_WIDTH, GLA_WIDTH, GLA_LOWRANK,
             FOX_WIDTH, FOX_WIDTH, FOX_WIDTH, FOX_HEADS, D_MODEL, D_MODEL)
IN_COLS = sum(IN_SPLITS)
IN_OFFSETS = tuple(int(v) for v in np.cumsum(IN_SPLITS)[:-1])

kernel_name = 'hybrid_gla_fox_convffn_block'


def rmsnorm(x, g):
    xf = x.astype(jnp.float32)
    y = xf * lax.rsqrt(jnp.mean(xf * xf, axis=-1, keepdims=True) + EPS)
    return (y * g.astype(jnp.float32)).astype(x.dtype)


def gla_chunked(q, k, v, log_a):
    B, S, H, dk = q.shape
    dv = v.shape[-1]
    n = S // CHUNK
    def blocks(t):
        return t.astype(jnp.float32).reshape(B, n, CHUNK, H, t.shape[-1]).transpose(0, 3, 1, 2, 4)
    qc, kc, vc, la = blocks(q), blocks(k), blocks(v), blocks(log_a)
    b = jnp.cumsum(la, axis=3)
    q_e = qc * jnp.exp(b)
    k_e = kc * jnp.exp(-b)
    causal = jnp.tril(jnp.ones((CHUNK, CHUNK), dtype=bool))
    scores = jnp.where(causal, jnp.einsum('bhnld,bhnmd->bhnlm', q_e, k_e), 0.0)
    o_intra = jnp.einsum('bhnlm,bhnmv->bhnlv', scores, vc)
    b_last = b[:, :, :, -1:, :]
    chunk_kv = jnp.einsum('bhnld,bhnlv->bhndv', kc * jnp.exp(b_last - b), vc)
    decay = jnp.exp(b_last[:, :, :, 0, :])

    def step(state, inp):
        dec, kv = inp
        return dec[..., None] * state + kv, state

    _, prev = lax.scan(step, jnp.zeros((B, H, dk, dv), jnp.float32),
                       (jnp.moveaxis(decay, 2, 0), jnp.moveaxis(chunk_kv, 2, 0)))
    prev = jnp.moveaxis(prev, 0, 2)
    o = o_intra + jnp.einsum('bhnld,bhndv->bhnlv', q_e, prev)
    return o.transpose(0, 2, 3, 1, 4).reshape(B, S, H, dv).astype(v.dtype)


def fox_attention(q, k, v, log_f):
    B, S, H, d = q.shape
    scale = d ** -0.5
    qh, kh, vh = (t.transpose(0, 2, 1, 3) for t in (q, k, v))
    c = jnp.cumsum(log_f.astype(jnp.float32), axis=1).transpose(0, 2, 1)
    outs = []
    for i in range(S // Q_BLOCK):
        lo, hi = i * Q_BLOCK, (i + 1) * Q_BLOCK
        logits = jnp.einsum('bhqd,bhkd->bhqk', qh[:, :, lo:hi], kh[:, :, :hi]).astype(jnp.float32) * scale
        logits = logits + c[:, :, lo:hi, None] - c[:, :, None, :hi]
        mask = jnp.arange(hi)[None, :] <= jnp.arange(lo, hi)[:, None]
        p = jax.nn.softmax(jnp.where(mask, logits, -jnp.inf), axis=-1)
        outs.append(jnp.einsum('bhqk,bhkd->bhqd', p.astype(v.dtype), vh[:, :, :hi]))
    return jnp.concatenate(outs, axis=2).transpose(0, 2, 1, 3)


def causal_dwconv(u, w, bias):
    S = u.shape[1]
    up = jnp.pad(u, ((0, 0), (CONV_W - 1, 0), (0, 0)))
    out = bias
    for j in range(CONV_W):
        out = out + w[j] * up[:, j:j + S]
    return out


def hybrid_layer(x, norm_mix_g, w_in, gla_alpha_w2, gla_alpha_b, gla_out_norm_g,
                 fox_forget_b, fox_q_norm_g, fox_k_norm_g, gate_b, w_gla_branch,
                 w_fox_branch, w_out, norm_ffn_g, w_up, conv_w, conv_b, w_down):
    B, S, _ = x.shape
    h = rmsnorm(x, norm_mix_g)
    gq, gk, gv, gr, glr, fq, fk, fv, ff, g_gla, g_fox = jnp.split(h @ w_in, IN_OFFSETS, axis=-1)

    log_a = jax.nn.log_sigmoid(glr @ gla_alpha_w2 + gla_alpha_b) / GLA_TAU
    o_gla = gla_chunked(gq.reshape(B, S, GLA_HEADS, GLA_DK) * (GLA_DK ** -0.5),
                        gk.reshape(B, S, GLA_HEADS, GLA_DK),
                        gv.reshape(B, S, GLA_HEADS, GLA_DV),
                        log_a.reshape(B, S, GLA_HEADS, GLA_DK))
    o_gla = rmsnorm(o_gla, gla_out_norm_g.reshape(GLA_HEADS, GLA_DV)).reshape(B, S, GLA_WIDTH) * jax.nn.silu(gr)

    fqh = rmsnorm(fq.reshape(B, S, FOX_HEADS, FOX_HD), fox_q_norm_g)
    fkh = rmsnorm(fk.reshape(B, S, FOX_HEADS, FOX_HD), fox_k_norm_g)
    log_f = jax.nn.log_sigmoid(ff + fox_forget_b)
    o_fox = fox_attention(fqh, fkh, fv.reshape(B, S, FOX_HEADS, FOX_HD), log_f).reshape(B, S, FOX_WIDTH)

    y = jax.nn.sigmoid(g_gla + gate_b[0]) * (o_gla @ w_gla_branch) \
        + jax.nn.sigmoid(g_fox + gate_b[1]) * (o_fox @ w_fox_branch)
    x = x + y @ w_out

    a, val = jnp.split(rmsnorm(x, norm_ffn_g) @ w_up, 2, axis=-1)
    a = causal_dwconv(a, conv_w, conv_b)
    return x + (jax.nn.gelu(a) * val) @ w_down


def setup_inputs(seed: int = 0) -> dict:
    key = jax.random.key(seed)
    ks = jax.random.split(key, 20)
    L = DEPTH
    nrm = jax.random.normal
    return {
        'x': nrm(ks[0], (BATCH, SEQ, D_MODEL), jnp.float32),
        'norm_mix_g': 1.0 + 0.02 * nrm(ks[1], (L, D_MODEL), jnp.float32),
        'w_in': nrm(ks[2], (L, D_MODEL, IN_COLS), jnp.float32) * D_MODEL ** -0.5,
        'gla_alpha_w2': nrm(ks[3], (L, GLA_LOWRANK, GLA_HEADS * GLA_DK), jnp.float32) * GLA_LOWRANK ** -0.5,
        'gla_alpha_b': 0.1 * nrm(ks[4], (L, GLA_HEADS * GLA_DK), jnp.float32),
        'gla_out_norm_g': 1.0 + 0.02 * nrm(ks[5], (L, GLA_WIDTH), jnp.float32),
        'fox_forget_b': 3.0 + nrm(ks[6], (L, FOX_HEADS), jnp.float32),
        'fox_q_norm_g': 1.0 + 0.02 * nrm(ks[7], (L, FOX_HD), jnp.float32),
        'fox_k_norm_g': 1.0 + 0.02 * nrm(ks[8], (L, FOX_HD), jnp.float32),
        'gate_b': 0.1 * nrm(ks[9], (L, 2, D_MODEL), jnp.float32),
        'w_gla_branch': nrm(ks[10], (L, GLA_WIDTH, D_MODEL), jnp.float32) * GLA_WIDTH ** -0.5,
        'w_fox_branch': nrm(ks[11], (L, FOX_WIDTH, D_MODEL), jnp.float32) * FOX_WIDTH ** -0.5,
        'w_out': nrm(ks[12], (L, D_MODEL, D_MODEL), jnp.float32) * D_MODEL ** -0.5,
        'norm_ffn_g': 1.0 + 0.02 * nrm(ks[13], (L, D_MODEL), jnp.float32),
        'w_up': nrm(ks[14], (L, D_MODEL, 2 * D_FF), jnp.float32) * D_MODEL ** -0.5,
        'conv_w': nrm(ks[15], (L, CONV_W, D_FF), jnp.float32) * CONV_W ** -0.5,
        'conv_b': 0.02 * nrm(ks[16], (L, D_FF), jnp.float32),
        'w_down': nrm(ks[17], (L, D_FF, D_MODEL), jnp.float32) * D_FF ** -0.5,
        'norm_final_g': 1.0 + 0.02 * nrm(ks[18], (D_MODEL,), jnp.float32),
    }


def reference(x, norm_mix_g, w_in, gla_alpha_w2, gla_alpha_b, gla_out_norm_g,
              fox_forget_b, fox_q_norm_g, fox_k_norm_g, gate_b, w_gla_branch,
              w_fox_branch, w_out, norm_ffn_g, w_up, conv_w, conv_b, w_down, norm_final_g):
    for l in range(DEPTH):
        x = hybrid_layer(x, norm_mix_g[l], w_in[l], gla_alpha_w2[l], gla_alpha_b[l], gla_out_norm_g[l],
                         fox_forget_b[l], fox_q_norm_g[l], fox_k_norm_g[l], gate_b[l], w_gla_branch[l],
                         w_fox_branch[l], w_out[l], norm_ffn_g[l], w_up[l], conv_w[l], conv_b[l], w_down[l])
    return rmsnorm(x, norm_final_g)
```

```cpp
#include <hip/hip_runtime.h>
#include <hip/hip_bf16.h>
#include <cstdint>
#include <cstdio>
#include <cmath>

typedef unsigned short bf16_t;
__device__ __forceinline__ float bf2f(bf16_t v) { return __uint_as_float(((unsigned)v) << 16); }
__device__ __forceinline__ bf16_t f2bf(float f) { unsigned u = __float_as_uint(f); return (bf16_t)((u + 0x7fffu + ((u >> 16) & 1u)) >> 16); }
#define LOG2E 1.4426950408889634f
#define QSCALE2 (0.125f * 1.4426950408889634f)

constexpr int M_TOK = 65536, DM = 1024, SEQ = 4096, NB = 16, DFF = 2816, INC = 5144;
constexpr size_t MiB = 1u << 20;
constexpr size_t WS_CTL = 0;
constexpr size_t WS_W = 1 * MiB;
constexpr size_t WS_A = 32 * MiB;
constexpr size_t WS_GQ = 160 * MiB, WS_GK = 192 * MiB, WS_GV = 224 * MiB, WS_GR = 288 * MiB, WS_FQ = 352 * MiB, WS_FK = 416 * MiB, WS_FV = 480 * MiB;
constexpr size_t WS_SG = 544 * MiB, WS_SF = 672 * MiB;
constexpr size_t WS_GLR = 800 * MiB, WS_LF2 = 804 * MiB, WS_C2S = 806 * MiB;
constexpr size_t WS_Y = 160 * MiB;
constexpr size_t WS_HM = 160 * MiB;
constexpr size_t WS_C = 832 * MiB;
constexpr size_t WS_END = 1008 * MiB;
namespace gold {
__device__ __forceinline__ float wsum(float v) {
#pragma unroll
    for (int o = 1; o < 64; o <<= 1) v += __shfl_xor(v, o);
    return v;
}
__device__ __forceinline__ float logsigmoidf_(float z) { return fminf(z, 0.f) - log1pf(expf(-fabsf(z))); }
__device__ __forceinline__ float sigmoidf_(float z) { return 1.f / (1.f + expf(-z)); }

__global__ void __launch_bounds__(256) k_rmsnorm_bf16(const float* x, const float* g, bf16_t* out, int rows) {
    const int w = (blockIdx.x * 256 + threadIdx.x) >> 6, lane = threadIdx.x & 63;
    if (w >= rows) return;
    const float* xr = x + (size_t)w * 1024;
    float v[16]; float s = 0.f;
#pragma unroll
    for (int j = 0; j < 16; ++j) { v[j] = xr[lane + 64 * j]; s += v[j] * v[j]; }
    s = wsum(s); const float rs = rsqrtf(s * (1.f / 1024.f) + 1e-6f);
#pragma unroll
    for (int j = 0; j < 16; ++j) out[(size_t)w * 1024 + lane + 64 * j] = f2bf(v[j] * rs * g[lane + 64 * j]);
}
__global__ void __launch_bounds__(256) k_rmsnorm_f32(float* x, const float* g, int rows) {
    const int w = (blockIdx.x * 256 + threadIdx.x) >> 6, lane = threadIdx.x & 63;
    if (w >= rows) return;
    float* xr = x + (size_t)w * 1024;
    float v[16]; float s = 0.f;
#pragma unroll
    for (int j = 0; j < 16; ++j) { v[j] = xr[lane + 64 * j]; s += v[j] * v[j]; }
    s = wsum(s); const float rs = rsqrtf(s * (1.f / 1024.f) + 1e-6f);
#pragma unroll
    for (int j = 0; j < 16; ++j) xr[lane + 64 * j] = v[j] * rs * g[lane + 64 * j];
}
__global__ void __launch_bounds__(256) k_gemm(const bf16_t* A, int lda, const float* W, int ldw, float* C, int ldc, int N, int K) {
    __shared__ float As[16][68]; __shared__ float Bs[16][68];
    const int t = threadIdx.x, tx = t & 15, ty = t >> 4;
    const int m0 = blockIdx.y * 64, n0 = blockIdx.x * 64;
    float acc[4][4];
#pragma unroll
    for (int i = 0; i < 4; ++i)
#pragma unroll
        for (int j = 0; j < 4; ++j) acc[i][j] = 0.f;
    const int ar = t >> 2, ak = (t & 3) * 4, bk = t >> 4, bn = (t & 15) * 4;
    for (int k0 = 0; k0 < K; k0 += 16) {
        const bf16_t* ap = A + (size_t)(m0 + ar) * lda + k0 + ak;
#pragma unroll
        for (int i = 0; i < 4; ++i) As[ak + i][ar] = bf2f(ap[i]);
        const float* wp = W + (size_t)(k0 + bk) * ldw + n0 + bn;
#pragma unroll
        for (int i = 0; i < 4; ++i) Bs[bk][bn + i] = (n0 + bn + i < N) ? wp[i] : 0.f;
        __syncthreads();
#pragma unroll
        for (int kk = 0; kk < 16; ++kk) {
            float a[4], b[4];
#pragma unroll
            for (int i = 0; i < 4; ++i) { a[i] = As[kk][ty * 4 + i]; b[i] = Bs[kk][tx * 4 + i]; }
#pragma unroll
            for (int i = 0; i < 4; ++i)
#pragma unroll
                for (int j = 0; j < 4; ++j) acc[i][j] += a[i] * b[j];
        }
        __syncthreads();
    }
#pragma unroll
    for (int i = 0; i < 4; ++i)
#pragma unroll
        for (int j = 0; j < 4; ++j) if (n0 + tx * 4 + j < N) C[(size_t)(m0 + ty * 4 + i) * ldc + n0 + tx * 4 + j] = acc[i][j];
}
__global__ void __launch_bounds__(256) k_inproj_epi(const float* P, int row0, const float* fb, const float* qg, const float* kg, const float* gate_b,
                                                    bf16_t* GQ, bf16_t* GK, bf16_t* GV, bf16_t* GR, float* GLR, bf16_t* FQ, bf16_t* FK, bf16_t* FV, float* LF2, bf16_t* SG, bf16_t* SF) {
    const int r = blockIdx.x, t = threadIdx.x; const float* p = P + (size_t)r * 5144; const size_t m = (size_t)row0 + r;
    GQ[m * 256 + t] = f2bf(p[t] * 0.125f); GK[m * 256 + t] = f2bf(p[256 + t]);
#pragma unroll
    for (int j = 0; j < 2; ++j) { const int c = t + 256 * j; GV[m * 512 + c] = f2bf(p[512 + c]); GR[m * 512 + c] = f2bf(p[1024 + c]); FV[m * 512 + c] = f2bf(p[2576 + c]); }
    if (t < 16) GLR[m * 16 + t] = p[1536 + t];
    if (t < 8) LF2[m * 8 + t] = logsigmoidf_(p[3088 + t] + fb[t]) * LOG2E;
#pragma unroll
    for (int j = 0; j < 2; ++j) { const int c = t + 256 * j;
        float v = p[1552 + c]; float rs = rsqrtf(wsum(v * v) * (1.f / 64.f) + 1e-6f); FQ[m * 512 + c] = f2bf(v * rs * qg[c & 63] * QSCALE2);
        v = p[2064 + c]; rs = rsqrtf(wsum(v * v) * (1.f / 64.f) + 1e-6f); FK[m * 512 + c] = f2bf(v * rs * kg[c & 63]); }
#pragma unroll
    for (int j = 0; j < 4; ++j) { const int c = t + 256 * j; SG[m * 1024 + c] = f2bf(sigmoidf_(p[3096 + c] + gate_b[c])); SF[m * 1024 + c] = f2bf(sigmoidf_(p[4120 + c] + gate_b[1024 + c])); }
}
__global__ void __launch_bounds__(256) k_gla(const bf16_t* GQ, const bf16_t* GK, const bf16_t* GV, const bf16_t* GR, const float* GLR, const float* w2, const float* ba, const float* gn, bf16_t* OGF) {
    __shared__ float sa[64], sq[64], sk[64], so[2][128], sred[4];
    const int bh = blockIdx.x, b = bh >> 2, h = bh & 3, t = threadIdx.x, dv = t & 127, dh = t >> 7;
    float S[32];
#pragma unroll
    for (int i = 0; i < 32; ++i) S[i] = 0.f;
    float w2c[16]; float bac = 0.f;
#pragma unroll
    for (int r = 0; r < 16; ++r) w2c[r] = (t < 64) ? w2[r * 256 + h * 64 + t] : 0.f;
    if (t < 64) bac = ba[h * 64 + t];
    const float gnv = gn[h * 128 + dv];
    for (int tok = 0; tok < 4096; ++tok) {
        const size_t m = (size_t)b * 4096 + tok;
        if (t < 64) { float z = bac;
#pragma unroll
            for (int r = 0; r < 16; ++r) z += GLR[m * 16 + r] * w2c[r];
            sa[t] = expf(logsigmoidf_(z) * (1.f / 16.f)); sq[t] = bf2f(GQ[m * 256 + h * 64 + t]); sk[t] = bf2f(GK[m * 256 + h * 64 + t]); }
        __syncthreads();
        const float v = bf2f(GV[m * 512 + h * 128 + dv]); float op = 0.f;
#pragma unroll
        for (int i = 0; i < 32; ++i) { const int d = 32 * dh + i; S[i] = sa[d] * S[i] + sk[d] * v; op += sq[d] * S[i]; }
        so[dh][dv] = op;
        __syncthreads();
        const float o = so[0][dv] + so[1][dv]; const float ss = wsum(o * o);
        if ((t & 63) == 0) sred[t >> 6] = ss;
        __syncthreads();
        const float tot = sred[0] + sred[1]; const float rs = rsqrtf(tot * (1.f / 128.f) + 1e-6f);
        if (dh == 0) { const float gr = bf2f(GR[m * 512 + h * 128 + dv]); OGF[m * 1024 + h * 128 + dv] = f2bf(o * rs * gnv * gr * sigmoidf_(gr)); }
    }
}
__global__ void __launch_bounds__(64) k_cumsum(const float* LF2, float* C2S) {
    const int bh = blockIdx.x, b = bh >> 3, h = bh & 7, lane = threadIdx.x;
    float s = 0.f;
    for (int i = 0; i < 64; ++i) s += LF2[((size_t)b * 4096 + lane * 64 + i) * 8 + h];
    float inc = s;
#pragma unroll
    for (int o = 1; o < 64; o <<= 1) { const float u = __shfl_up(inc, o); if (lane >= o) inc += u; }
    float run = inc - s;
    for (int i = 0; i < 64; ++i) { run += LF2[((size_t)b * 4096 + lane * 64 + i) * 8 + h]; C2S[(size_t)bh * 4096 + lane * 64 + i] = run; }
}
__global__ void __launch_bounds__(256) k_fox(const bf16_t* FQ, const bf16_t* FK, const bf16_t* FV, const float* C2S, bf16_t* OGF) {
    __shared__ float sk[64][64], sv[64][64], sc[64];
    const int qb = blockIdx.x, bh = blockIdx.y, b = bh >> 3, h = bh & 7, t = threadIdx.x, tq = qb * 256 + t;
    const size_t mq = (size_t)b * 4096 + tq;
    float q[64], o[64];
#pragma unroll
    for (int d = 0; d < 64; ++d) { q[d] = bf2f(FQ[mq * 512 + h * 64 + d]); o[d] = 0.f; }
    const float ct = C2S[(size_t)bh * 4096 + tq];
    float mr = -INFINITY, l = 0.f;
    const int ntile = (qb * 256 + 256) / 64;
    for (int kt = 0; kt < ntile; ++kt) {
        __syncthreads();
        for (int e = t; e < 4096; e += 256) { const int j = e >> 6, d = e & 63; const size_t mk = (size_t)b * 4096 + kt * 64 + j; sk[j][d] = bf2f(FK[mk * 512 + h * 64 + d]); sv[j][d] = bf2f(FV[mk * 512 + h * 64 + d]); }
        if (t < 64) sc[t] = C2S[(size_t)bh * 4096 + kt * 64 + t];
        __syncthreads();
        for (int j = 0; j < 64; ++j) {
            const int s = kt * 64 + j;
            if (s <= tq) {
                float dot = 0.f;
#pragma unroll
                for (int d = 0; d < 64; ++d) dot += q[d] * sk[j][d];
                const float lg = dot + ct - sc[j];
                const float mn = fmaxf(mr, lg), sc_ = exp2f(mr - mn), p = exp2f(lg - mn);
                l = l * sc_ + p;
#pragma unroll
                for (int d = 0; d < 64; ++d) o[d] = o[d] * sc_ + p * sv[j][d];
                mr = mn;
            }
        }
    }
    const float il = 1.f / l;
#pragma unroll
    for (int d = 0; d < 64; ++d) OGF[mq * 1024 + 512 + h * 64 + d] = f2bf(o[d] * il);
}
__global__ void __launch_bounds__(256) k_merge(const float* C1, const float* C2, const bf16_t* SG, const bf16_t* SF, bf16_t* Y, int row0, int n) {
    const int i = blockIdx.x * 256 + threadIdx.x; if (i >= n) return; const size_t g = (size_t)row0 * 1024 + i;
    Y[g] = f2bf(bf2f(SG[g]) * C1[i] + bf2f(SF[g]) * C2[i]);
}
__global__ void __launch_bounds__(256) k_resid(const float* base, const float* C, float* out, int row0, int n) {
    const int i = blockIdx.x * 256 + threadIdx.x; if (i >= n) return; const size_t g = (size_t)row0 * 1024 + i;
    out[g] = base[g] + C[i];
}
__device__ __forceinline__ float gelu_tanh_(float x) { return 0.5f * x * (1.f + tanhf(0.7978845608028654f * (x + 0.044715f * x * x * x))); }
__global__ void __launch_bounds__(256) k_conv_gelu(const float* U, int row0, int rows, const float* cw, const float* cb, bf16_t* HM) {
    const size_t i = (size_t)blockIdx.x * 256 + threadIdx.x; if (i >= (size_t)rows * 2816) return;
    const int r = (int)(i / 2816), c = (int)(i % 2816); const int tok = (row0 + r) & 4095;
    const float a0 = U[(size_t)r * 5632 + c], a1 = tok >= 1 ? U[(size_t)(r - 1) * 5632 + c] : 0.f, a2 = tok >= 2 ? U[(size_t)(r - 2) * 5632 + c] : 0.f;
    const float cv = cb[c] + cw[c] * a2 + cw[2816 + c] * a1 + cw[2 * 2816 + c] * a0;
    HM[((size_t)row0 + r) * 2816 + c] = f2bf(gelu_tanh_(cv) * U[(size_t)r * 5632 + 2816 + c]);
}
}
static void gold_forward(void* const* d_in, float* out, unsigned char* ws, hipStream_t st, int s_lo, int s_hi) {
    const float* x = (const float*)d_in[0];
    bf16_t* A = (bf16_t*)(ws + WS_A); bf16_t *GQ = (bf16_t*)(ws + WS_GQ), *GK = (bf16_t*)(ws + WS_GK), *GV = (bf16_t*)(ws + WS_GV), *GR = (bf16_t*)(ws + WS_GR);
    bf16_t *FQ = (bf16_t*)(ws + WS_FQ), *FK = (bf16_t*)(ws + WS_FK), *FV = (bf16_t*)(ws + WS_FV), *SG = (bf16_t*)(ws + WS_SG), *SF = (bf16_t*)(ws + WS_SF);
    float *GLR = (float*)(ws + WS_GLR), *LF2 = (float*)(ws + WS_LF2), *C2S = (float*)(ws + WS_C2S), *C1 = (float*)(ws + WS_C), *C2 = (float*)(ws + WS_C + 32 * MiB);
    bf16_t *Y = (bf16_t*)(ws + WS_Y), *HM = (bf16_t*)(ws + WS_HM);
    const int CH = 8192, NCH = M_TOK / CH;
#define ST(k) (s_lo <= (k) && (k) < s_hi)
    if (ST(0)) gold::k_rmsnorm_bf16<<<M_TOK / 4, 256, 0, st>>>(x, (const float*)d_in[1], A, M_TOK);
    if (ST(1)) for (int c = 0; c < NCH; ++c) {
        gold::k_gemm<<<dim3((INC + 63) / 64, CH / 64), 256, 0, st>>>(A + (size_t)c * CH * 1024, 1024, (const float*)d_in[2], INC, C1, INC, INC, 1024);
        gold::k_inproj_epi<<<CH, 256, 0, st>>>(C1, c * CH, (const float*)d_in[6], (const float*)d_in[7], (const float*)d_in[8], (const float*)d_in[9], GQ, GK, GV, GR, GLR, FQ, FK, FV, LF2, SG, SF);
    }
    if (ST(2)) gold::k_gla<<<64, 256, 0, st>>>(GQ, GK, GV, GR, GLR, (const float*)d_in[3], (const float*)d_in[4], (const float*)d_in[5], A);
    if (ST(3)) { gold::k_cumsum<<<128, 64, 0, st>>>(LF2, C2S); gold::k_fox<<<dim3(16, 128), 256, 0, st>>>(FQ, FK, FV, C2S, A); }
    if (ST(4)) for (int c = 0; c < NCH; ++c) {
        gold::k_gemm<<<dim3(16, CH / 64), 256, 0, st>>>(A + (size_t)c * CH * 1024, 1024, (const float*)d_in[10], 1024, C1, 1024, 1024, 512);
        gold::k_gemm<<<dim3(16, CH / 64), 256, 0, st>>>(A + (size_t)c * CH * 1024 + 512, 1024, (const float*)d_in[11], 1024, C2, 1024, 1024, 512);
        gold::k_merge<<<CH * 1024 / 256, 256, 0, st>>>(C1, C2, SG, SF, Y, c * CH, CH * 1024);
    }
    if (ST(5)) for (int c = 0; c < NCH; ++c) {
        gold::k_gemm<<<dim3(16, CH / 64), 256, 0, st>>>(Y + (size_t)c * CH * 1024, 1024, (const float*)d_in[12], 1024, C1, 1024, 1024, 1024);
        gold::k_resid<<<CH * 1024 / 256, 256, 0, st>>>(x, C1, out, c * CH, CH * 1024);
    }
    if (ST(6)) gold::k_rmsnorm_bf16<<<M_TOK / 4, 256, 0, st>>>(out, (const float*)d_in[13], A, M_TOK);
    if (ST(7)) for (int c = 0; c < NCH; ++c) {
        gold::k_gemm<<<dim3(5632 / 64, CH / 64), 256, 0, st>>>(A + (size_t)c * CH * 1024, 1024, (const float*)d_in[14], 5632, C1, 5632, 5632, 1024);
        gold::k_conv_gelu<<<(unsigned)(((size_t)CH * 2816 + 255) / 256), 256, 0, st>>>(C1, c * CH, CH, (const float*)d_in[15], (const float*)d_in[16], HM);
    }
    if (ST(8)) for (int c = 0; c < NCH; ++c) {
        gold::k_gemm<<<dim3(16, CH / 64), 256, 0, st>>>(HM + (size_t)c * CH * 2816, 2816, (const float*)d_in[17], 1024, C1, 1024, 1024, 2816);
        gold::k_resid<<<CH * 1024 / 256, 256, 0, st>>>(out, C1, out, c * CH, CH * 1024);
    }
    if (ST(9)) gold::k_rmsnorm_f32<<<M_TOK / 4, 256, 0, st>>>(out, (const float*)d_in[18], M_TOK);
#undef ST
}
extern "C" void kernel_launch(void* const* d_in, const int* in_sizes, int n_in, void* d_out, int out_size, void* d_ws, size_t ws_size, hipStream_t stream) {
    if (n_in != 19 || out_size != M_TOK * DM || ws_size < WS_END) { fprintf(stderr, "kernel_launch: unexpected shapes (n_in %d out %d ws %zu)\n", n_in, out_size, ws_size); return; }
    gold_forward(d_in, (float*)d_out, (unsigned char*)d_ws, stream, 0, 10);
}
```

```cpp
#include <hip/hip_runtime.h>
#include <hip/hip_bf16.h>
#include <cstdint>
#include <cstdio>
#include <cmath>

typedef unsigned short bf16_t;
__device__ __forceinline__ float bf2f(bf16_t v) { return __uint_as_float(((unsigned)v) << 16); }
__device__ __forceinline__ bf16_t f2bf(float f) { unsigned u = __float_as_uint(f); return (bf16_t)((u + 0x7fffu + ((u >> 16) & 1u)) >> 16); }
#define LOG2E 1.4426950408889634f
#define QSCALE2 (0.125f * 1.4426950408889634f)

constexpr int M_TOK = 65536, DM = 1024, SEQ = 4096, NB = 16, DFF = 2816, INC = 5144;
constexpr size_t MiB = 1u << 20;
constexpr size_t WS_CTL = 0;
constexpr size_t WS_W = 1 * MiB;
constexpr size_t WS_A = 32 * MiB;
constexpr size_t WS_GQ = 160 * MiB, WS_GK = 192 * MiB, WS_GV = 224 * MiB, WS_GR = 288 * MiB, WS_FQ = 352 * MiB, WS_FK = 416 * MiB, WS_FV = 480 * MiB;
constexpr size_t WS_SG = 544 * MiB, WS_SF = 672 * MiB;
constexpr size_t WS_GLR = 800 * MiB, WS_LF2 = 804 * MiB, WS_C2S = 806 * MiB;
constexpr size_t WS_Y = 160 * MiB;
constexpr size_t WS_HM = 160 * MiB;
constexpr size_t WS_C = 832 * MiB;
constexpr size_t WS_END = 1008 * MiB;
namespace gold {
__device__ __forceinline__ float wsum(float v) {
#pragma unroll
    for (int o = 1; o < 64; o <<= 1) v += __shfl_xor(v, o);
    return v;
}
__device__ __forceinline__ float logsigmoidf_(float z) { return fminf(z, 0.f) - log1pf(expf(-fabsf(z))); }
__device__ __forceinline__ float sigmoidf_(float z) { return 1.f / (1.f + expf(-z)); }

__global__ void __launch_bounds__(256) k_rmsnorm_bf16(const float* x, const float* g, bf16_t* out, int rows) {
    const int w = (blockIdx.x * 256 + threadIdx.x) >> 6, lane = threadIdx.x & 63;
    if (w >= rows) return;
    const float* xr = x + (size_t)w * 1024;
    float v[16]; float s = 0.f;
#pragma unroll
    for (int j = 0; j < 16; ++j) { v[j] = xr[lane + 64 * j]; s += v[j] * v[j]; }
    s = wsum(s); const float rs = rsqrtf(s * (1.f / 1024.f) + 1e-6f);
#pragma unroll
    for (int j = 0; j < 16; ++j) out[(size_t)w * 1024 + lane + 64 * j] = f2bf(v[j] * rs * g[lane + 64 * j]);
}
__global__ void __launch_bounds__(256) k_rmsnorm_f32(float* x, const float* g, int rows) {
    const int w = (blockIdx.x * 256 + threadIdx.x) >> 6, lane = threadIdx.x & 63;
    if (w >= rows) return;
    float* xr = x + (size_t)w * 1024;
    float v[16]; float s = 0.f;
#pragma unroll
    for (int j = 0; j < 16; ++j) { v[j] = xr[lane + 64 * j]; s += v[j] * v[j]; }
    s = wsum(s); const float rs = rsqrtf(s * (1.f / 1024.f) + 1e-6f);
#pragma unroll
    for (int j = 0; j < 16; ++j) xr[lane + 64 * j] = v[j] * rs * g[lane + 64 * j];
}
__global__ void __launch_bounds__(256) k_gemm(const bf16_t* A, int lda, const float* W, int ldw, float* C, int ldc, int N, int K) {
    __shared__ float As[16][68]; __shared__ float Bs[16][68];
    const int t = threadIdx.x, tx = t & 15, ty = t >> 4;
    const int m0 = blockIdx.y * 64, n0 = blockIdx.x * 64;
    float acc[4][4];
#pragma unroll
    for (int i = 0; i < 4; ++i)
#pragma unroll
        for (int j = 0; j < 4; ++j) acc[i][j] = 0.f;
    const int ar = t >> 2, ak = (t & 3) * 4, bk = t >> 4, bn = (t & 15) * 4;
    for (int k0 = 0; k0 < K; k0 += 16) {
        const bf16_t* ap = A + (size_t)(m0 + ar) * lda + k0 + ak;
#pragma unroll
        for (int i = 0; i < 4; ++i) As[ak + i][ar] = bf2f(ap[i]);
        const float* wp = W + (size_t)(k0 + bk) * ldw + n0 + bn;
#pragma unroll
        for (int i = 0; i < 4; ++i) Bs[bk][bn + i] = (n0 + bn + i < N) ? wp[i] : 0.f;
        __syncthreads();
#pragma unroll
        for (int kk = 0; kk < 16; ++kk) {
            float a[4], b[4];
#pragma unroll
            for (int i = 0; i < 4; ++i) { a[i] = As[kk][ty * 4 + i]; b[i] = Bs[kk][tx * 4 + i]; }
#pragma unroll
            for (int i = 0; i < 4; ++i)
#pragma unroll
                for (int j = 0; j < 4; ++j) acc[i][j] += a[i] * b[j];
        }
        __syncthreads();
    }
#pragma unroll
    for (int i = 0; i < 4; ++i)
#pragma unroll
        for (int j = 0; j < 4; ++j) if (n0 + tx * 4 + j < N) C[(size_t)(m0 + ty * 4 + i) * ldc + n0 + tx * 4 + j] = acc[i][j];
}
__global__ void __launch_bounds__(256) k_inproj_epi(const float* P, int row0, const float* fb, const float* qg, const float* kg, const float* gate_b,
                                                    bf16_t* GQ, bf16_t* GK, bf16_t* GV, bf16_t* GR, float* GLR, bf16_t* FQ, bf16_t* FK, bf16_t* FV, float* LF2, bf16_t* SG, bf16_t* SF, int gm) {
    const int r = blockIdx.x, t = threadIdx.x; const float* p = P + (size_t)r * 5144; const size_t m = (size_t)row0 + r;
    if (gm & 1) { GQ[m * 256 + t] = f2bf(p[t] * 0.125f); GK[m * 256 + t] = f2bf(p[256 + t]); }
    if (gm & 1)
#pragma unroll
    for (int j = 0; j < 2; ++j) { const int c = t + 256 * j; GV[m * 512 + c] = f2bf(p[512 + c]); GR[m * 512 + c] = f2bf(p[1024 + c]); FV[m * 512 + c] = f2bf(p[2576 + c]); }
    if ((gm & 2) && t < 16) GLR[m * 16 + t] = p[1536 + t];
    if ((gm & 2) && t < 8) LF2[m * 8 + t] = logsigmoidf_(p[3088 + t] + fb[t]) * LOG2E;
    if (gm & 4)
#pragma unroll
    for (int j = 0; j < 2; ++j) { const int c = t + 256 * j;
        float v = p[1552 + c]; float rs = rsqrtf(wsum(v * v) * (1.f / 64.f) + 1e-6f); FQ[m * 512 + c] = f2bf(v * rs * qg[c & 63] * QSCALE2);
        v = p[2064 + c]; rs = rsqrtf(wsum(v * v) * (1.f / 64.f) + 1e-6f); FK[m * 512 + c] = f2bf(v * rs * kg[c & 63]); }
    if (gm & 8)
#pragma unroll
    for (int j = 0; j < 4; ++j) { const int c = t + 256 * j; SG[m * 1024 + c] = f2bf(sigmoidf_(p[3096 + c] + gate_b[c])); SF[m * 1024 + c] = f2bf(sigmoidf_(p[4120 + c] + gate_b[1024 + c])); }
}
__global__ void __launch_bounds__(256) k_gla(const bf16_t* GQ, const bf16_t* GK, const bf16_t* GV, const bf16_t* GR, const float* GLR, const float* w2, const float* ba, const float* gn, bf16_t* OGF) {
    __shared__ float sa[64], sq[64], sk[64], so[2][128], sred[4];
    const int bh = blockIdx.x, b = bh >> 2, h = bh & 3, t = threadIdx.x, dv = t & 127, dh = t >> 7;
    float S[32];
#pragma unroll
    for (int i = 0; i < 32; ++i) S[i] = 0.f;
    float w2c[16]; float bac = 0.f;
#pragma unroll
    for (int r = 0; r < 16; ++r) w2c[r] = (t < 64) ? w2[r * 256 + h * 64 + t] : 0.f;
    if (t < 64) bac = ba[h * 64 + t];
    const float gnv = gn[h * 128 + dv];
    for (int tok = 0; tok < 4096; ++tok) {
        const size_t m = (size_t)b * 4096 + tok;
        if (t < 64) { float z = bac;
#pragma unroll
            for (int r = 0; r < 16; ++r) z += GLR[m * 16 + r] * w2c[r];
            sa[t] = expf(logsigmoidf_(z) * (1.f / 16.f)); sq[t] = bf2f(GQ[m * 256 + h * 64 + t]); sk[t] = bf2f(GK[m * 256 + h * 64 + t]); }
        __syncthreads();
        const float v = bf2f(GV[m * 512 + h * 128 + dv]); float op = 0.f;
#pragma unroll
        for (int i = 0; i < 32; ++i) { const int d = 32 * dh + i; S[i] = sa[d] * S[i] + sk[d] * v; op += sq[d] * S[i]; }
        so[dh][dv] = op;
        __syncthreads();
        const float o = so[0][dv] + so[1][dv]; const float ss = wsum(o * o);
        if ((t & 63) == 0) sred[t >> 6] = ss;
        __syncthreads();
        const float tot = sred[0] + sred[1]; const float rs = rsqrtf(tot * (1.f / 128.f) + 1e-6f);
        if (dh == 0) { const float gr = bf2f(GR[m * 512 + h * 128 + dv]); OGF[m * 1024 + h * 128 + dv] = f2bf(o * rs * gnv * gr * sigmoidf_(gr)); }
    }
}
__global__ void __launch_bounds__(64) k_cumsum(const float* LF2, float* C2S) {
    const int bh = blockIdx.x, b = bh >> 3, h = bh & 7, lane = threadIdx.x;
    float s = 0.f;
    for (int i = 0; i < 64; ++i) s += LF2[((size_t)b * 4096 + lane * 64 + i) * 8 + h];
    float inc = s;
#pragma unroll
    for (int o = 1; o < 64; o <<= 1) { const float u = __shfl_up(inc, o); if (lane >= o) inc += u; }
    float run = inc - s;
    for (int i = 0; i < 64; ++i) { run += LF2[((size_t)b * 4096 + lane * 64 + i) * 8 + h]; C2S[(size_t)bh * 4096 + lane * 64 + i] = run; }
}
__global__ void __launch_bounds__(256) k_fox(const bf16_t* FQ, const bf16_t* FK, const bf16_t* FV, const float* C2S, bf16_t* OGF) {
    __shared__ float sk[64][64], sv[64][64], sc[64];
    const int qb = blockIdx.x, bh = blockIdx.y, b = bh >> 3, h = bh & 7, t = threadIdx.x, tq = qb * 256 + t;
    const size_t mq = (size_t)b * 4096 + tq;
    float q[64], o[64];
#pragma unroll
    for (int d = 0; d < 64; ++d) { q[d] = bf2f(FQ[mq * 512 + h * 64 + d]); o[d] = 0.f; }
    const float ct = C2S[(size_t)bh * 4096 + tq];
    float mr = -INFINITY, l = 0.f;
    const int ntile = (qb * 256 + 256) / 64;
    for (int kt = 0; kt < ntile; ++kt) {
        __syncthreads();
        for (int e = t; e < 4096; e += 256) { const int j = e >> 6, d = e & 63; const size_t mk = (size_t)b * 4096 + kt * 64 + j; sk[j][d] = bf2f(FK[mk * 512 + h * 64 + d]); sv[j][d] = bf2f(FV[mk * 512 + h * 64 + d]); }
        if (t < 64) sc[t] = C2S[(size_t)bh * 4096 + kt * 64 + t];
        __syncthreads();
        for (int j = 0; j < 64; ++j) {
            const int s = kt * 64 + j;
            if (s <= tq) {
                float dot = 0.f;
#pragma unroll
                for (int d = 0; d < 64; ++d) dot += q[d] * sk[j][d];
                const float lg = dot + ct - sc[j];
                const float mn = fmaxf(mr, lg), sc_ = exp2f(mr - mn), p = exp2f(lg - mn);
                l = l * sc_ + p;
#pragma unroll
                for (int d = 0; d < 64; ++d) o[d] = o[d] * sc_ + p * sv[j][d];
                mr = mn;
            }
        }
    }
    const float il = 1.f / l;
#pragma unroll
    for (int d = 0; d < 64; ++d) OGF[mq * 1024 + 512 + h * 64 + d] = f2bf(o[d] * il);
}
__global__ void __launch_bounds__(256) k_merge(const float* C1, const float* C2, const bf16_t* SG, const bf16_t* SF, bf16_t* Y, int row0, int n) {
    const int i = blockIdx.x * 256 + threadIdx.x; if (i >= n) return; const size_t g = (size_t)row0 * 1024 + i;
    Y[g] = f2bf(bf2f(SG[g]) * C1[i] + bf2f(SF[g]) * C2[i]);
}
__global__ void __launch_bounds__(256) k_resid(const float* base, const float* C, float* out, int row0, int n) {
    const int i = blockIdx.x * 256 + threadIdx.x; if (i >= n) return; const size_t g = (size_t)row0 * 1024 + i;
    out[g] = base[g] + C[i];
}
__device__ __forceinline__ float gelu_tanh_(float x) { return 0.5f * x * (1.f + tanhf(0.7978845608028654f * (x + 0.044715f * x * x * x))); }
__global__ void __launch_bounds__(256) k_conv_gelu(const float* U, int row0, int rows, const float* cw, const float* cb, bf16_t* HM) {
    const size_t i = (size_t)blockIdx.x * 256 + threadIdx.x; if (i >= (size_t)rows * 2816) return;
    const int r = (int)(i / 2816), c = (int)(i % 2816); const int tok = (row0 + r) & 4095;
    const float a0 = U[(size_t)r * 5632 + c], a1 = tok >= 1 ? U[(size_t)(r - 1) * 5632 + c] : 0.f, a2 = tok >= 2 ? U[(size_t)(r - 2) * 5632 + c] : 0.f;
    const float cv = cb[c] + cw[c] * a2 + cw[2816 + c] * a1 + cw[2 * 2816 + c] * a0;
    HM[((size_t)row0 + r) * 2816 + c] = f2bf(gelu_tanh_(cv) * U[(size_t)r * 5632 + 2816 + c]);
}
}
static void gold_forward(void* const* d_in, float* out, unsigned char* ws, hipStream_t st, int s_lo, int s_hi, int gm1 = 15) {
    const float* x = (const float*)d_in[0];
    bf16_t* A = (bf16_t*)(ws + WS_A); bf16_t *GQ = (bf16_t*)(ws + WS_GQ), *GK = (bf16_t*)(ws + WS_GK), *GV = (bf16_t*)(ws + WS_GV), *GR = (bf16_t*)(ws + WS_GR);
    bf16_t *FQ = (bf16_t*)(ws + WS_FQ), *FK = (bf16_t*)(ws + WS_FK), *FV = (bf16_t*)(ws + WS_FV), *SG = (bf16_t*)(ws + WS_SG), *SF = (bf16_t*)(ws + WS_SF);
    float *GLR = (float*)(ws + WS_GLR), *LF2 = (float*)(ws + WS_LF2), *C2S = (float*)(ws + WS_C2S), *C1 = (float*)(ws + WS_C), *C2 = (float*)(ws + WS_C + 32 * MiB);
    bf16_t *Y = (bf16_t*)(ws + WS_Y), *HM = (bf16_t*)(ws + WS_HM);
    const int CH = 8192, NCH = M_TOK / CH;
#define ST(k) (s_lo <= (k) && (k) < s_hi)
    if (ST(0)) gold::k_rmsnorm_bf16<<<M_TOK / 4, 256, 0, st>>>(x, (const float*)d_in[1], A, M_TOK);
    if (ST(1)) for (int c = 0; c < NCH; ++c) {
        gold::k_gemm<<<dim3((INC + 63) / 64, CH / 64), 256, 0, st>>>(A + (size_t)c * CH * 1024, 1024, (const float*)d_in[2], INC, C1, INC, INC, 1024);
        gold::k_inproj_epi<<<CH, 256, 0, st>>>(C1, c * CH, (const float*)d_in[6], (const float*)d_in[7], (const float*)d_in[8], (const float*)d_in[9], GQ, GK, GV, GR, GLR, FQ, FK, FV, LF2, SG, SF, gm1);
    }
    if (ST(2)) gold::k_gla<<<64, 256, 0, st>>>(GQ, GK, GV, GR, GLR, (const float*)d_in[3], (const float*)d_in[4], (const float*)d_in[5], A);
    if (ST(3)) { gold::k_cumsum<<<128, 64, 0, st>>>(LF2, C2S); gold::k_fox<<<dim3(16, 128), 256, 0, st>>>(FQ, FK, FV, C2S, A); }
    if (ST(4)) for (int c = 0; c < NCH; ++c) {
        gold::k_gemm<<<dim3(16, CH / 64), 256, 0, st>>>(A + (size_t)c * CH * 1024, 1024, (const float*)d_in[10], 1024, C1, 1024, 1024, 512);
        gold::k_gemm<<<dim3(16, CH / 64), 256, 0, st>>>(A + (size_t)c * CH * 1024 + 512, 1024, (const float*)d_in[11], 1024, C2, 1024, 1024, 512);
        gold::k_merge<<<CH * 1024 / 256, 256, 0, st>>>(C1, C2, SG, SF, Y, c * CH, CH * 1024);
    }
    if (ST(5)) for (int c = 0; c < NCH; ++c) {
        gold::k_gemm<<<dim3(16, CH / 64), 256, 0, st>>>(Y + (size_t)c * CH * 1024, 1024, (const float*)d_in[12], 1024, C1, 1024, 1024, 1024);
        gold::k_resid<<<CH * 1024 / 256, 256, 0, st>>>(x, C1, out, c * CH, CH * 1024);
    }
    if (ST(6)) gold::k_rmsnorm_bf16<<<M_TOK / 4, 256, 0, st>>>(out, (const float*)d_in[13], A, M_TOK);
    if (ST(7)) for (int c = 0; c < NCH; ++c) {
        gold::k_gemm<<<dim3(5632 / 64, CH / 64), 256, 0, st>>>(A + (size_t)c * CH * 1024, 1024, (const float*)d_in[14], 5632, C1, 5632, 5632, 1024);
        gold::k_conv_gelu<<<(unsigned)(((size_t)CH * 2816 + 255) / 256), 256, 0, st>>>(C1, c * CH, CH, (const float*)d_in[15], (const float*)d_in[16], HM);
    }
    if (ST(8)) for (int c = 0; c < NCH; ++c) {
        gold::k_gemm<<<dim3(16, CH / 64), 256, 0, st>>>(HM + (size_t)c * CH * 2816, 2816, (const float*)d_in[17], 1024, C1, 1024, 1024, 2816);
        gold::k_resid<<<CH * 1024 / 256, 256, 0, st>>>(out, C1, out, c * CH, CH * 1024);
    }
    if (ST(9)) gold::k_rmsnorm_f32<<<M_TOK / 4, 256, 0, st>>>(out, (const float*)d_in[18], M_TOK);
#undef ST
}
namespace pg8 {
#define PG8_LAS __attribute__((address_space(3)))
typedef unsigned short bf16_t;
typedef short bf16x8 __attribute__((ext_vector_type(8)));
typedef float f32x4 __attribute__((ext_vector_type(4)));
typedef unsigned u32x4 __attribute__((ext_vector_type(4)));
constexpr int BM = 256, BK = 64, HALF = 128, HTB = HALF * BK * 2  , STAGE_BYTES = 8 * HTB, NXCD = 8, WGM = 8;

__host__ __device__ __forceinline__ int lds_byte(int r, int c) { const int st = (r >> 4) * 2 + (c >> 5), rr = r & 15, cc = c & 31, ob = rr * 64 + cc * 2; return st * 1024 + (ob ^ (((ob >> 9) & 1) << 5)); }
__host__ __device__ __forceinline__ void stage_rc(int b, int& R, int& C) { const int st = b / 1024, sb = b % 1024, swz = sb ^ (((sb >> 9) & 1) << 5); R = (st >> 1) * 16 + swz / 64; C = (st & 1) * 32 + (swz % 64) / 2; }
__host__ __device__ __forceinline__ int perm32(int rho) { const int n = rho >> 4, i = rho & 15; return 8 * (i >> 2) + 4 * n + (i & 3); }

struct Unit { int pm, pn; };
struct Gemm { const bf16_t* A; const bf16_t* Bt; int M, N, K; };

struct StaticOrder {
    int nM, nN, nwg, G, c;
    __host__ __device__ void init(int M, int N, int G_, int c_) { nM = M / BM; nN = N / BM; nwg = nM * nN; G = G_; c = c_; }
    __host__ __device__ bool next(int i, Unit& u) const {
        const long L = (long)i * G + c; if (L >= nwg) return false;
        int wgid = (int)L; { const int q = nwg / NXCD, r = nwg % NXCD, xcd = wgid % NXCD, off = wgid / NXCD; wgid = (xcd < r ? xcd * (q + 1) : r * (q + 1) + (xcd - r) * q) + off; }
        const int nig = WGM * nN, gid = wgid / nig, fm = gid * WGM, gsz = (nM - fm) < WGM ? (nM - fm) : WGM;
        u.pm = fm + ((wgid % nig) % gsz); u.pn = (wgid % nig) / gsz; return true;
    }
    __device__ __forceinline__ void a_ready(const Unit&) const {}
    __device__ __forceinline__ void done(const Unit&) const {}
};

typedef float f32x2 __attribute__((ext_vector_type(2))); typedef __bf16 bf16x2_t __attribute__((ext_vector_type(2)));
__device__ __forceinline__ unsigned cvt_pk_bf16(float lo, float hi) { f32x2 v = {lo, hi}; bf16x2_t b = __builtin_convertvector(v, bf16x2_t); return __builtin_bit_cast(unsigned, b); }
template <class Epi, class Sched, bool ALIGN_EPI = false, bool SP2 = false>
__device__ __forceinline__ void gemm_phase(PG8_LAS unsigned char* lds, const Gemm g, const Sched& S, const Epi& E) {
    const int tid = threadIdx.x, wid = __builtin_amdgcn_readfirstlane(tid >> 6), lane = tid & 63, wr = wid >> 2, wc = wid & 3, fr = lane & 15, fq = lane >> 4;
    const int K = g.K, nt = K / BK;
    unsigned voffA[2], voffB[2];
#pragma unroll
    for (int i = 0; i < 2; ++i) { int R, C; stage_rc(tid * 16 + i * 8192, R, C); const int Rb = Epi::PERM ? ((R & ~31) + perm32(R & 31)) : R;
        voffA[i] = (unsigned)(R * K + C) * 2u; voffB[i] = (unsigned)(Rb * K + C) * 2u; }
    const size_t kstep = (size_t)(BK * 2);
    const size_t hstep = (size_t)HALF * K * 2;
    const size_t tstep = 2 * hstep;
    const unsigned ldsw = (unsigned)wid * 1024u;
    const int aoff = lds_byte(wr * 64 + fr, fq * 8), boff = lds_byte(wc * 32 + fr, fq * 8);
#define PG8_SA(b, h) (((b) * 2 + (h)) * HTB)
#define PG8_SB(b, h) ((4 + (b) * 2 + (h)) * HTB)
#define PG8_STAGE(bufoff, gbase, voff) do { _Pragma("unroll") for (int _i = 0; _i < 2; ++_i) \
        __builtin_amdgcn_global_load_lds((const unsigned*)((const char*)(gbase) + (voff)[_i]), (PG8_LAS unsigned*)(lds + (bufoff) + ldsw + _i * 8192), 16, 0, 0); } while (0)
#define PG8_LDA(dst, b, h) do { _Pragma("unroll") for (int m = 0; m < 4; ++m) _Pragma("unroll") for (int k = 0; k < 2; ++k) dst[m][k] = *(const PG8_LAS bf16x8*)(lds + PG8_SA(b, h) + aoff + m * 2048 + k * 1024); } while (0)
#define PG8_LDB(dst, b, h) do { _Pragma("unroll") for (int n = 0; n < 2; ++n) _Pragma("unroll") for (int k = 0; k < 2; ++k) dst[n][k] = *(const PG8_LAS bf16x8*)(lds + PG8_SB(b, h) + boff + n * 2048 + k * 1024); } while (0)
#define PG8_MMA(ai, bj, At, Bt) do { __builtin_amdgcn_s_setprio(1); _Pragma("unroll") for (int m = 0; m < 4; ++m) _Pragma("unroll") for (int n = 0; n < 2; ++n) _Pragma("unroll") for (int k = 0; k < 2; ++k) \
        acc[ai][bj][m][n] = __builtin_amdgcn_mfma_f32_16x16x32_bf16(Bt[n][k], At[m][k], acc[ai][bj][m][n], 0, 0, 0); __builtin_amdgcn_s_setprio(0); } while (0)
#define PG8_WAIT_V(n) asm volatile("s_waitcnt vmcnt(" #n ")" ::: "memory")
#define PG8_WAIT_L(n) asm volatile("s_waitcnt lgkmcnt(" #n ")" ::: "memory")
#define PG8_BAR __builtin_amdgcn_s_barrier()
#define PG8_SCHED __builtin_amdgcn_sched_barrier(0)
    Unit cur, nxt; int ui = 0;
    if (!S.next(0, cur)) return;
    f32x4 acc[2][2][4][2];
#pragma unroll
    for (int a = 0; a < 2; ++a)
#pragma unroll
        for (int b = 0; b < 2; ++b)
#pragma unroll
            for (int m = 0; m < 4; ++m)
#pragma unroll
                for (int n = 0; n < 2; ++n) acc[a][b][m][n] = (f32x4){0.f, 0.f, 0.f, 0.f};
    bf16x8 At[4][2], B0[2][2], B1[2][2];
    const char* cA = (const char*)g.A + (size_t)cur.pm * tstep; const char* cB = (const char*)g.Bt + (size_t)cur.pn * tstep;
    S.a_ready(cur);
    if constexpr (SP2) {
        PG8_STAGE(PG8_SB(0, 0), cB, voffB); PG8_STAGE(PG8_SB(0, 1), cB + hstep, voffB); PG8_STAGE(PG8_SA(0, 0), cA, voffA); PG8_STAGE(PG8_SA(0, 1), cA + hstep, voffA);
        if (wr == 1) PG8_BAR;
        PG8_WAIT_V(2); PG8_BAR;
        PG8_STAGE(PG8_SB(1, 0), cB + kstep, voffB); PG8_STAGE(PG8_SA(1, 0), cA + kstep, voffA); PG8_STAGE(PG8_SB(1, 1), cB + hstep + kstep, voffB);
        PG8_WAIT_V(6); PG8_BAR;
    } else {
        PG8_STAGE(PG8_SB(0, 0), cB, voffB); PG8_STAGE(PG8_SA(0, 0), cA, voffA); PG8_STAGE(PG8_SB(0, 1), cB + hstep, voffB); PG8_STAGE(PG8_SA(0, 1), cA + hstep, voffA);
        if (wr == 1) PG8_BAR;
        PG8_WAIT_V(4); PG8_BAR;
        PG8_STAGE(PG8_SB(1, 0), cB + kstep, voffB); PG8_STAGE(PG8_SA(1, 0), cA + kstep, voffA); PG8_STAGE(PG8_SB(1, 1), cB + hstep + kstep, voffB);
        PG8_WAIT_V(6); PG8_BAR;
    }
    for (;;) {
        const bool has_next = S.next(ui + 1, nxt);
        const char* nA = has_next ? (const char*)g.A + (size_t)nxt.pm * tstep : cA; const char* nB = has_next ? (const char*)g.Bt + (size_t)nxt.pn * tstep : cB;
        for (int t = 0; t < nt; t += 2) {
            if constexpr (Epi::MIDK) { if (t == nt / 2) { PG8_SCHED; E.mid(acc, cur, wr, wc, fr, fq); PG8_SCHED; } }
            const bool last = (t == nt - 2);
            const char* a1 = cA + (size_t)(t + 1) * kstep;
            const char* a2 = last ? nA : cA + (size_t)(t + 2) * kstep; const char* b2 = last ? nB : cB + (size_t)(t + 2) * kstep;
            const char* a3 = a2 + kstep; const char* b3 = b2 + kstep;
            if (last && has_next) S.a_ready(nxt);
            if constexpr (SP2) {
            PG8_LDB(B0, 0, 0); PG8_LDB(B1, 0, 1); PG8_SCHED; PG8_LDA(At, 0, 0); PG8_STAGE(PG8_SA(1, 1), a1 + hstep, voffA);
            PG8_WAIT_V(8); PG8_WAIT_L(0); PG8_BAR; PG8_MMA(0, 0, At, B0); PG8_MMA(0, 1, At, B1); PG8_BAR; PG8_SCHED;
            PG8_LDA(At, 0, 1); PG8_STAGE(PG8_SB(0, 0), b2, voffB); PG8_STAGE(PG8_SB(0, 1), b2 + hstep, voffB); PG8_STAGE(PG8_SA(0, 0), a2, voffA);
            PG8_WAIT_V(8); PG8_WAIT_L(0); PG8_BAR; PG8_MMA(1, 0, At, B0); PG8_MMA(1, 1, At, B1); PG8_BAR; PG8_SCHED;
            PG8_LDB(B0, 1, 0); PG8_LDB(B1, 1, 1); PG8_SCHED; PG8_LDA(At, 1, 0); PG8_STAGE(PG8_SA(0, 1), a2 + hstep, voffA);
            PG8_WAIT_V(8); PG8_WAIT_L(0); PG8_BAR; PG8_MMA(0, 0, At, B0); PG8_MMA(0, 1, At, B1); PG8_BAR; PG8_SCHED;
            PG8_LDA(At, 1, 1); PG8_STAGE(PG8_SB(1, 0), b3, voffB); PG8_STAGE(PG8_SB(1, 1), b3 + hstep, voffB); PG8_STAGE(PG8_SA(1, 0), a3, voffA);
            PG8_WAIT_V(8); PG8_WAIT_L(0); PG8_BAR; PG8_MMA(1, 0, At, B0); PG8_MMA(1, 1, At, B1); PG8_BAR; PG8_SCHED;
            } else {
            PG8_LDB(B0, 0, 0); PG8_SCHED; PG8_LDA(At, 0, 0); PG8_STAGE(PG8_SA(1, 1), a1 + hstep, voffA);
            PG8_WAIT_L(8); PG8_BAR; PG8_WAIT_L(0); PG8_MMA(0, 0, At, B0); PG8_BAR; PG8_SCHED;
            PG8_LDB(B1, 0, 1); PG8_STAGE(PG8_SB(0, 0), b2, voffB);
            PG8_BAR; PG8_WAIT_L(0); PG8_MMA(0, 1, At, B1); PG8_BAR;
            PG8_LDA(At, 0, 1); PG8_STAGE(PG8_SA(0, 0), a2, voffA);
            PG8_BAR; PG8_WAIT_L(0); PG8_MMA(1, 0, At, B0); PG8_BAR; PG8_SCHED;
            PG8_STAGE(PG8_SB(0, 1), b2 + hstep, voffB);
            PG8_WAIT_V(6); PG8_BAR; PG8_MMA(1, 1, At, B1); PG8_BAR;
            PG8_LDB(B0, 1, 0); PG8_SCHED; PG8_LDA(At, 1, 0); PG8_STAGE(PG8_SA(0, 1), a2 + hstep, voffA);
            PG8_WAIT_L(8); PG8_BAR; PG8_WAIT_L(0); PG8_MMA(0, 0, At, B0); PG8_BAR; PG8_SCHED;
            PG8_LDB(B1, 1, 1); PG8_STAGE(PG8_SB(1, 0), b3, voffB);
            PG8_BAR; PG8_WAIT_L(0); PG8_MMA(0, 1, At, B1); PG8_BAR;
            PG8_LDA(At, 1, 1); PG8_STAGE(PG8_SA(1, 0), a3, voffA);
            PG8_BAR; PG8_WAIT_L(0); PG8_MMA(1, 0, At, B0); PG8_BAR; PG8_SCHED;
            PG8_STAGE(PG8_SB(1, 1), b3 + hstep, voffB);
            PG8_WAIT_V(6); PG8_BAR; PG8_MMA(1, 1, At, B1); PG8_BAR;
            }
        }
        if constexpr (ALIGN_EPI) { if (wr == 0) PG8_BAR; }
        if constexpr (!Epi::AFTER_DRAIN) { E(acc, cur, wr, wc, fr, fq); S.done(cur); }
        if (!has_next) break;
#pragma unroll
        for (int a = 0; a < 2; ++a)
#pragma unroll
            for (int b = 0; b < 2; ++b)
#pragma unroll
                for (int m = 0; m < 4; ++m)
#pragma unroll
                    for (int n = 0; n < 2; ++n) acc[a][b][m][n] = (f32x4){0.f, 0.f, 0.f, 0.f};
        cur = nxt; cA = nA; cB = nB; ++ui;
        if constexpr (ALIGN_EPI) { if (wr == 1) PG8_BAR; }
    }
    PG8_WAIT_V(0);
    if constexpr (!ALIGN_EPI) { if (wr == 0) PG8_BAR; }
    PG8_BAR;
    if constexpr (Epi::AFTER_DRAIN) { E.fused(acc, cur, wr, wc, fr, fq, lds, wid, lane); S.done(cur); }
#undef PG8_SA
#undef PG8_SB
#undef PG8_STAGE
#undef PG8_LDA
#undef PG8_LDB
#undef PG8_MMA
#undef PG8_WAIT_V
#undef PG8_WAIT_L
#undef PG8_BAR
#undef PG8_SCHED
}
}
namespace pg8 {
typedef unsigned u32x2 __attribute__((ext_vector_type(2)));
__device__ __forceinline__ u32x4 pack8(f32x4 a, f32x4 b) { u32x4 w; w.x = cvt_pk_bf16(a[0], a[1]); w.y = cvt_pk_bf16(a[2], a[3]); w.z = cvt_pk_bf16(b[0], b[1]); w.w = cvt_pk_bf16(b[2], b[3]); return w; }
__device__ __forceinline__ float bflo(unsigned w) { return __uint_as_float(w << 16); }
__device__ __forceinline__ float bfhi(unsigned w) { return __uint_as_float(w & 0xffff0000u); }
__device__ __forceinline__ void unpack8(u32x4 w, f32x4& a, f32x4& b) { a = (f32x4){bflo(w.x), bfhi(w.x), bflo(w.y), bfhi(w.y)}; b = (f32x4){bflo(w.z), bfhi(w.z), bflo(w.w), bfhi(w.w)}; }
__device__ __forceinline__ float fast_sigmoid(float z) { return __builtin_amdgcn_rcpf(1.f + __builtin_amdgcn_exp2f(-LOG2E * z)); }
__device__ __forceinline__ f32x4 sig4(f32x4 z) { return (f32x4){fast_sigmoid(z[0]), fast_sigmoid(z[1]), fast_sigmoid(z[2]), fast_sigmoid(z[3])}; }
__device__ __forceinline__ float logsig(float z) { return fminf(z, 0.f) - log1pf(expf(-fabsf(z))); }

struct EpiInProj {
    static constexpr bool PERM = true, AFTER_DRAIN = false, MIDK = false;
    bf16_t *GQ, *GK, *GV, *GR, *FQ, *FK, *FV, *SG, *SF; float *GLR, *LF2; const float *fb, *qg, *kg, *gate_b;
    __device__ __forceinline__ void operator()(const f32x4 (&acc)[2][2][4][2], const Unit& u, int wr, int wc, int fr, int fq) const {
        const int pn = u.pn; const size_t row0 = (size_t)u.pm * BM + wr * 64 + fr; const int qc = 64 * wc + 8 * fq;
        if (pn < 6 || pn == 10 || pn == 11) {
            bf16_t* base; int ld, col0; float sc = 1.f;
            if (pn == 0) { base = GQ; ld = 256; col0 = 0; sc = 0.125f; } else if (pn == 1) { base = GK; ld = 256; col0 = 0; }
            else if (pn < 4) { base = GV; ld = 512; col0 = 256 * (pn - 2); } else if (pn < 6) { base = GR; ld = 512; col0 = 256 * (pn - 4); } else { base = FV; ld = 512; col0 = 256 * (pn - 10); }
#pragma unroll
            for (int ai = 0; ai < 2; ++ai)
#pragma unroll
                for (int m = 0; m < 4; ++m) { bf16_t* rp = base + (row0 + ai * HALF + m * 16) * ld + col0 + qc;
#pragma unroll
                    for (int bj = 0; bj < 2; ++bj) *(u32x4*)(rp + 32 * bj) = pack8(acc[ai][bj][m][0] * sc, acc[ai][bj][m][1] * sc); }
        } else if (pn < 10) {
            const bool isq = pn < 8; bf16_t* base = isq ? FQ : FK; const float* g = isq ? qg : kg; const int head = 4 * ((pn - 6) & 1) + wc; const float osc = isq ? QSCALE2 : 1.f;
            f32x4 gv[2][2];
#pragma unroll
            for (int bj = 0; bj < 2; ++bj)
#pragma unroll
                for (int n = 0; n < 2; ++n) gv[bj][n] = *(const f32x4*)(g + 32 * bj + 8 * fq + 4 * n);
#pragma unroll
            for (int ai = 0; ai < 2; ++ai)
#pragma unroll
                for (int m = 0; m < 4; ++m) { float ss = 0.f;
#pragma unroll
                    for (int bj = 0; bj < 2; ++bj)
#pragma unroll
                        for (int n = 0; n < 2; ++n) { const f32x4 x = acc[ai][bj][m][n]; ss += (x[0] * x[0] + x[1] * x[1]) + (x[2] * x[2] + x[3] * x[3]); }
                    ss += __shfl_xor(ss, 16); ss += __shfl_xor(ss, 32);
                    const float rs = rsqrtf(ss * (1.f / 64.f) + 1e-6f) * osc;
                    bf16_t* rp = base + (row0 + ai * HALF + m * 16) * 512 + 64 * head + 8 * fq;
#pragma unroll
                    for (int bj = 0; bj < 2; ++bj) *(u32x4*)(rp + 32 * bj) = pack8(acc[ai][bj][m][0] * rs * gv[bj][0], acc[ai][bj][m][1] * rs * gv[bj][1]); }
        } else if (pn < 20) {
            const bool isg = pn < 16; bf16_t* base = isg ? SG : SF; const int col0 = 256 * ((pn - 12) & 3); const float* gb = gate_b + (isg ? 0 : 1024) + col0 + qc;
            f32x4 bv[2][2];
#pragma unroll
            for (int bj = 0; bj < 2; ++bj)
#pragma unroll
                for (int n = 0; n < 2; ++n) bv[bj][n] = *(const f32x4*)(gb + 32 * bj + 4 * n);
#pragma unroll
            for (int ai = 0; ai < 2; ++ai)
#pragma unroll
                for (int m = 0; m < 4; ++m) { bf16_t* rp = base + (row0 + ai * HALF + m * 16) * 1024 + col0 + qc;
#pragma unroll
                    for (int bj = 0; bj < 2; ++bj) *(u32x4*)(rp + 32 * bj) = pack8(sig4(acc[ai][bj][m][0] + bv[bj][0]), sig4(acc[ai][bj][m][1] + bv[bj][1])); }
        } else {
            if (wc == 0 && fq < 3) {
                const f32x4 f0 = *(const f32x4*)fb, f1 = *(const f32x4*)(fb + 4);
#pragma unroll
                for (int ai = 0; ai < 2; ++ai)
#pragma unroll
                    for (int m = 0; m < 4; ++m) { const size_t row = row0 + ai * HALF + m * 16; const f32x4 v0 = acc[ai][0][m][0], v1 = acc[ai][0][m][1];
                        if (fq < 2) { *(f32x4*)(GLR + row * 16 + 8 * fq) = v0; *(f32x4*)(GLR + row * 16 + 8 * fq + 4) = v1; }
                        else { f32x4 o0, o1;
#pragma unroll
                            for (int i = 0; i < 4; ++i) { o0[i] = logsig(v0[i] + f0[i]) * LOG2E; o1[i] = logsig(v1[i] + f1[i]) * LOG2E; }
                            *(f32x4*)(LF2 + row * 8) = o0; *(f32x4*)(LF2 + row * 8 + 4) = o1; } }
            }
        }
    }
};
struct EpiMerge {
    static constexpr bool PERM = true, AFTER_DRAIN = false, MIDK = true;
    const bf16_t *SG, *SF; bf16_t* Y;
    __device__ __forceinline__ void mid(f32x4 (&acc)[2][2][4][2], const Unit& u, int wr, int wc, int fr, int fq) const {
        asm volatile("" : "+v"(fr), "+v"(fq));
        const size_t row0 = (size_t)u.pm * BM + wr * 64 + fr; const int col = u.pn * BM + 64 * wc + 8 * fq;
#pragma unroll
        for (int ai = 0; ai < 2; ++ai)
#pragma unroll
            for (int m = 0; m < 4; ++m) { const size_t off = (row0 + ai * HALF + m * 16) * 1024 + col;
#pragma unroll
                for (int bj = 0; bj < 2; ++bj) { f32x4 g0, g1, s0, s1; unpack8(*(const u32x4*)(SG + off + 32 * bj), g0, g1); unpack8(*(const u32x4*)(SF + off + 32 * bj), s0, s1);
#pragma unroll
                    for (int i = 0; i < 4; ++i) { acc[ai][bj][m][0][i] *= g0[i] * __builtin_amdgcn_rcpf(s0[i]); acc[ai][bj][m][1][i] *= g1[i] * __builtin_amdgcn_rcpf(s1[i]); } }
                asm volatile("" : "+v"(acc[ai][0][m][0]), "+v"(acc[ai][0][m][1]), "+v"(acc[ai][1][m][0]), "+v"(acc[ai][1][m][1]));
                if (m & 1) asm volatile("" ::: "memory"); }
    }
    __device__ __forceinline__ void operator()(const f32x4 (&acc)[2][2][4][2], const Unit& u, int wr, int wc, int fr, int fq) const {
        const size_t row0 = (size_t)u.pm * BM + wr * 64 + fr; const int col = u.pn * BM + 64 * wc + 8 * fq;
#pragma unroll
        for (int ai = 0; ai < 2; ++ai)
#pragma unroll
            for (int m = 0; m < 4; ++m) { const size_t off = (row0 + ai * HALF + m * 16) * 1024 + col;
#pragma unroll
                for (int bj = 0; bj < 2; ++bj) { f32x4 s0, s1; unpack8(*(const u32x4*)(SF + off + 32 * bj), s0, s1); *(u32x4*)(Y + off + 32 * bj) = pack8(acc[ai][bj][m][0] * s0, acc[ai][bj][m][1] * s1); } }
    }
};
struct EpiResid {
    static constexpr bool PERM = true, AFTER_DRAIN = false, MIDK = false;
    const float* base; float* out;
    __device__ __forceinline__ void operator()(const f32x4 (&acc)[2][2][4][2], const Unit& u, int wr, int wc, int fr, int fq) const {
        const size_t row0 = (size_t)u.pm * BM + wr * 64 + fr; const int col = u.pn * BM + 64 * wc + 8 * fq;
#pragma unroll
        for (int ai = 0; ai < 2; ++ai)
#pragma unroll
            for (int m = 0; m < 4; ++m) { const size_t off = (row0 + ai * HALF + m * 16) * 1024 + col;
#pragma unroll
                for (int bj = 0; bj < 2; ++bj)
#pragma unroll
                    for (int n = 0; n < 2; ++n) { const f32x4 b = *(const f32x4*)(base + off + 32 * bj + 4 * n); *(f32x4*)(out + off + 32 * bj + 4 * n) = b + acc[ai][bj][m][n]; } }
    }
};
template <int CTRL> __device__ __forceinline__ float dppmov(float v) { return __builtin_bit_cast(float, __builtin_amdgcn_update_dpp(0, __builtin_bit_cast(int, v), CTRL, 0xf, 0xf, false)); }
__device__ __forceinline__ float gelu_tanh_fast(float x) { const float u = x * (1.f + 0.044715f * x * x); return x * __builtin_amdgcn_rcpf(1.f + __builtin_amdgcn_exp2f(-1.5957691216057308f * LOG2E * u)); }
struct EpiUp {
    static constexpr bool PERM = true, AFTER_DRAIN = false, MIDK = false;
    bf16_t* HM; float* EDGE; const float *cw, *cb;
    __device__ __forceinline__ void operator()(const f32x4 (&acc)[2][2][4][2], const Unit& u, int wr, int wc, int fr, int fq) const {
        const int ch0 = 128 * u.pn + 32 * wc + 8 * fq;
        f32x4 w0[2], w1[2], w2[2], bb[2];
#pragma unroll
        for (int n = 0; n < 2; ++n) { w0[n] = *(const f32x4*)(cw + ch0 + 4 * n); w1[n] = *(const f32x4*)(cw + 2816 + ch0 + 4 * n); w2[n] = *(const f32x4*)(cw + 5632 + ch0 + 4 * n); bb[n] = *(const f32x4*)(cb + ch0 + 4 * n); }
#pragma unroll
        for (int ai = 0; ai < 2; ++ai) {
            const size_t rowg = (size_t)u.pm * BM + ai * HALF + wr * 64;
            float* eg = EDGE + (rowg >> 6) * (size_t)(6 * 2816) + ch0;
            if (fr < 2) {
#pragma unroll
                for (int n = 0; n < 2; ++n) { *(f32x4*)(eg + fr * 2816 + 4 * n) = acc[ai][0][0][n]; *(f32x4*)(eg + (4 + fr) * 2816 + 4 * n) = acc[ai][1][0][n]; } }
            if (fr >= 14) {
#pragma unroll
                for (int n = 0; n < 2; ++n) *(f32x4*)(eg + (fr - 12) * 2816 + 4 * n) = acc[ai][0][3][n]; }
#pragma unroll
            for (int m = 0; m < 4; ++m) { f32x4 h[2];
#pragma unroll
                for (int n = 0; n < 2; ++n)
#pragma unroll
                    for (int i = 0; i < 4; ++i) { const float a0 = acc[ai][0][m][n][i];
                        float a1 = dppmov<0x111>(a0), a2 = dppmov<0x112>(a0);
                        if (m > 0) { const float p = acc[ai][0][m - 1][n][i]; const float p1 = dppmov<0x121>(p), p2 = dppmov<0x122>(p);
                            a1 = fr == 0 ? p1 : a1; a2 = fr < 2 ? p2 : a2; }
                        const float cv = bb[n][i] + w0[n][i] * a2 + w1[n][i] * a1 + w2[n][i] * a0;
                        h[n][i] = gelu_tanh_fast(cv) * acc[ai][1][m][n][i]; }
                *(u32x4*)(HM + (rowg + m * 16 + fr) * 2816 + ch0) = pack8(h[0], h[1]); }
        }
    }
};
}
#define GAS __attribute__((address_space(1)))
#define LAS __attribute__((address_space(3)))
typedef unsigned v4u __attribute__((ext_vector_type(4)));
typedef float f32x4 __attribute__((ext_vector_type(4)));
typedef short bf16x8 __attribute__((ext_vector_type(8)));
typedef GAS unsigned gu32;
typedef GAS unsigned long long gu64;
#define RLX_AGENT __ATOMIC_RELAXED, __HIP_MEMORY_SCOPE_AGENT
#define LDS_WAIT() asm volatile("s_waitcnt lgkmcnt(0)" ::: "memory")
#define VM_WAIT() asm volatile("s_waitcnt vmcnt(0)" ::: "memory")
__device__ __forceinline__ unsigned long long rt() { return __builtin_amdgcn_s_memrealtime(); }
__device__ __forceinline__ unsigned pk2(float lo, float hi) { return (unsigned)f2bf(lo) | ((unsigned)f2bf(hi) << 16); }
#define XB_TMO      128
#define XB_XCNT(j)  (256  + 64 * (j))
#define XB_XSUB(j)  (1280 + 64 * (j))
#define XB_XGEN(j)  (2304 + 64 * (j))
#define XB_TOP      3328
#define XB_TOPGEN   3392
#define XCD_BAR_WORDS 3456
#define XB_SPIN_CAP (1u << 18)

__device__ __forceinline__ unsigned xb_ld(unsigned* p)              { return __hip_atomic_load(p, __ATOMIC_RELAXED, __HIP_MEMORY_SCOPE_AGENT); }
__device__ __forceinline__ unsigned xb_add(unsigned* p, unsigned v) { return __hip_atomic_fetch_add(p, v, __ATOMIC_RELAXED, __HIP_MEMORY_SCOPE_AGENT); }
__device__ __forceinline__ unsigned xb_xcc_id() { return (unsigned)__builtin_amdgcn_s_getreg((3 << 11) | 20) & 0xFu; }
#define XB_SPIN(cond, bar) do { unsigned _sp = 0; while (cond) { __builtin_amdgcn_s_sleep(1); \
    if ((++_sp & 255u) == 0u) { if (xb_ld(&(bar)[XB_TMO])) break; if (_sp > XB_SPIN_CAP) { atomicAdd(&(bar)[XB_TMO], 1u); break; } } } } while (0)

struct XcdBarrier {
    unsigned* bar; unsigned x;
    volatile LAS unsigned* st;
};

__device__ __forceinline__ XcdBarrier xcd_barrier_post(unsigned* bar, volatile LAS unsigned* st) {
    XcdBarrier b; b.bar = bar; b.x = xb_xcc_id(); b.st = st;
    if (threadIdx.x == 0) (void)xb_add(&bar[XB_XCNT(b.x)], 1u);
    return b;
}
__device__ __forceinline__ void xcd_barrier_complete(unsigned* bar, unsigned x, unsigned& nloc, unsigned& nx) {
    const unsigned G = gridDim.x * gridDim.y * gridDim.z;
    unsigned sum, cnt, mine, sp = 0u;
    for (;;) {
        sum = 0u; cnt = 0u; mine = 0u;
#pragma unroll
        for (unsigned j = 0; j < 16; ++j) { const unsigned c = xb_ld(&bar[XB_XCNT(j)]); sum += c; cnt += (c > 0u) ? 1u : 0u; mine = (j == x) ? c : mine; }
        if (sum == G) break;
        __builtin_amdgcn_s_sleep(1);
        if ((++sp & 255u) == 0u) { if (xb_ld(&bar[XB_TMO])) break; if (sp > XB_SPIN_CAP) { atomicAdd(&bar[XB_TMO], 1u); break; } }
    }
    nloc = mine > 0u ? mine : 1u; nx = cnt > 0u ? cnt : 1u;
}

__device__ __forceinline__ void xcd_barrier(const XcdBarrier& b) {
    asm volatile("s_waitcnt vmcnt(0)" ::: "memory");
    __syncthreads();
    if (threadIdx.x == 0) {
        unsigned* bar = b.bar;
        __builtin_amdgcn_s_waitcnt(0);
        unsigned nloc = b.st[0], nx = b.st[1];
        if (nloc == 0u) { xcd_barrier_complete(bar, b.x, nloc, nx); b.st[0] = nloc; b.st[1] = nx; }
        const unsigned old = xb_add(&bar[XB_XSUB(b.x)], 1u);
        const unsigned gen = old / nloc;
        if (old + 1u == (gen + 1u) * nloc) {
            __builtin_amdgcn_fence(__ATOMIC_RELEASE, "agent");
            asm volatile("s_waitcnt vmcnt(0)" ::: "memory");
            const unsigned og = xb_add(&bar[XB_TOP], 1u);
            const unsigned tg = og / nx;
            if (og + 1u == (tg + 1u) * nx) xb_add(&bar[XB_TOPGEN], 1u);
            else XB_SPIN(xb_ld(&bar[XB_TOPGEN]) == tg, bar);
            __builtin_amdgcn_fence(__ATOMIC_ACQUIRE, "agent");
            xb_add(&bar[XB_XGEN(b.x)], 1u);
            asm volatile("s_waitcnt vmcnt(0)" ::: "memory");
        } else {
            XB_SPIN(xb_ld(&bar[XB_XGEN(b.x)]) == gen, bar);
            __builtin_amdgcn_fence(__ATOMIC_ACQUIRE, "agent");
            asm volatile("s_waitcnt vmcnt(0)" ::: "memory");
        }
    }
    __syncthreads();
}
#define PHASE_GLA do {} while (0)
#define PHASE_FOX do {} while (0)
constexpr int NWAVES = 8;
constexpr int RING_OFF = 0, RING_BYTES = 131072, LDSCTL_OFF = RING_BYTES, MISC_OFF = LDSCTL_OFF + 320, LDS_BYTES = 147456;
constexpr size_t CTL_ZERO_BYTES = 1 * MiB;
constexpr int CW_TMO = 0, CW_CODE = 1, CW_BAR = 4096;
constexpr int N_PHASES = 12;
constexpr size_t WS_WIN = WS_W, WS_WGF = WS_WIN + (size_t)5376 * 1024 * 2, WS_WOUT = WS_WGF + 2 * MiB, WS_WUP = WS_WOUT + 2 * MiB, WS_WDN = WS_WUP + (size_t)5632 * 1024 * 2;
static_assert(WS_WDN + (size_t)1024 * 2816 * 2 <= WS_A, "weights fit below WS_A");
constexpr size_t WS_EDGE = WS_C;

struct Frame {
    LAS unsigned char* lds; volatile LAS unsigned* MISC; gu32* ctl;
    int tid, lane, wave, vcu, G;
};
__device__ __forceinline__ float wave_sum(float v) {
#pragma unroll
    for (int o = 1; o < 64; o <<= 1) v += __shfl_xor(v, o);
    return v;
}
__device__ __forceinline__ void p0_xpose(const float* colp, int ldw, bf16_t* dst, int ldd, LAS float* scr, int lane) {
#pragma unroll 8
    for (int i = 0; i < 32; ++i) { const int kk = 2 * i + (lane >> 5); scr[kk * 33 + (lane & 31)] = colp ? colp[(size_t)kk * ldw] : 0.f; }
    LDS_WAIT(); asm volatile("" ::: "memory");
    const int c = lane & 7;
#pragma unroll
    for (int j = 0; j < 4; ++j) { const int n = (lane >> 3) + 8 * j; const LAS float* s = scr + (8 * c) * 33 + n;
        v4u o; o.x = pk2(s[0 * 33], s[1 * 33]); o.y = pk2(s[2 * 33], s[3 * 33]); o.z = pk2(s[4 * 33], s[5 * 33]); o.w = pk2(s[6 * 33], s[7 * 33]);
        *(GAS v4u*)(dst + (size_t)n * ldd + 8 * c) = o; }
    LDS_WAIT(); asm volatile("" ::: "memory");
}
__device__ __forceinline__ int inproj_base(int pn) { return pn < 6 ? 256 * pn : (pn < 12 ? 1552 + 256 * (pn - 6) : 3096 + 256 * (pn - 12)); }
struct Args { const float* in[19]; float* out; unsigned char* ws; int ph_lo, ph_hi, li, pad; };

__device__ __forceinline__ void p0_weights(Frame& F, const Args& a) {
    LAS float* scr = (LAS float*)(F.lds + RING_OFF + F.wave * 16384);
    const int gw = F.vcu * NWAVES + F.wave, NGW = F.G * NWAVES, lane = F.lane, c = lane & 31;
    constexpr int I_IN = 16 * 168, I_GF = 16 * 32, I_OUT = 16 * 32, I_UP = 16 * 176, I_DN = 44 * 32, NITEMS = I_IN + I_GF + I_OUT + I_UP + I_DN;
    unsigned char* ws = a.ws;
    for (int it = gw; it < NITEMS; it += NGW) {
        int r = it; const float* colp; int ldw, ldd; bf16_t* dst;
        if (r < I_IN) { const int kb = r / 168, nb = r % 168, pn = nb >> 3, pb = nb & 7, q0 = 64 * (pb & 3) + 32 * (pb >> 2);
            int col; if (pn < 20) col = inproj_base(pn) + q0 + c; else col = (q0 == 0) ? (c < 16 ? 1536 + c : (c < 24 ? 3088 + c - 16 : -1)) : -1;
            ldw = INC; ldd = 1024; colp = col >= 0 ? a.in[2] + (size_t)(64 * kb) * INC + col : nullptr; dst = (bf16_t*)(ws + WS_WIN) + (size_t)(32 * nb) * 1024 + 64 * kb;
        } else if ((r -= I_IN) < I_GF) { const int kb = r / 32, nb = r % 32, pn = nb >> 3, pb = nb & 7, col = 256 * pn + 64 * (pb & 3) + 32 * (pb >> 2) + c;
            ldw = 1024; ldd = 1024; colp = (kb < 8 ? a.in[10] + (size_t)(64 * kb) * 1024 : a.in[11] + (size_t)(64 * (kb - 8)) * 1024) + col; dst = (bf16_t*)(ws + WS_WGF) + (size_t)(32 * nb) * 1024 + 64 * kb;
        } else if ((r -= I_GF) < I_OUT) { const int kb = r / 32, nb = r % 32, pn = nb >> 3, pb = nb & 7, col = 256 * pn + 64 * (pb & 3) + 32 * (pb >> 2) + c;
            ldw = 1024; ldd = 1024; colp = a.in[12] + (size_t)(64 * kb) * 1024 + col; dst = (bf16_t*)(ws + WS_WOUT) + (size_t)(32 * nb) * 1024 + 64 * kb;
        } else if ((r -= I_OUT) < I_UP) { const int kb = r / 176, nb = r % 176, pn = nb >> 3, pb = nb & 7, col = (pb >> 2) * 2816 + 128 * pn + 32 * (pb & 3) + c;
            ldw = 5632; ldd = 1024; colp = a.in[14] + (size_t)(64 * kb) * 5632 + col; dst = (bf16_t*)(ws + WS_WUP) + (size_t)(32 * nb) * 1024 + 64 * kb;
        } else { r -= I_UP; const int kb = r / 32, nb = r % 32, pn = nb >> 3, pb = nb & 7, col = 256 * pn + 64 * (pb & 3) + 32 * (pb >> 2) + c;
            ldw = 1024; ldd = 2816; colp = a.in[17] + (size_t)(64 * kb) * 1024 + col; dst = (bf16_t*)(ws + WS_WDN) + (size_t)(32 * nb) * 2816 + 64 * kb; }
        p0_xpose(colp, ldw, dst, ldd, scr, lane);
    }
}
__device__ __forceinline__ void rms_rows_bf16(Frame& F, const float* x, const float* g, bf16_t* out) {
    const int gw = F.vcu * NWAVES + F.wave, NGW = F.G * NWAVES;
    f32x4 gv[4];
#pragma unroll
    for (int j = 0; j < 4; ++j) gv[j] = ((const GAS f32x4*)g)[F.lane + 64 * j];
    for (int m = gw; m < M_TOK; m += NGW) {
        const GAS f32x4* xr = (const GAS f32x4*)(x + (size_t)m * 1024) + F.lane;
        f32x4 v[4]; float s = 0.f;
#pragma unroll
        for (int j = 0; j < 4; ++j) { v[j] = xr[64 * j]; s += (v[j].x * v[j].x + v[j].y * v[j].y) + (v[j].z * v[j].z + v[j].w * v[j].w); }
        const float rs = rsqrtf(wave_sum(s) * (1.f / 1024.f) + 1e-6f);
        GAS unsigned long long* o8 = (GAS unsigned long long*)(out + (size_t)m * 1024) + F.lane;
#pragma unroll
        for (int j = 0; j < 4; ++j) { const f32x4 y = v[j] * rs * gv[j]; o8[64 * j] = (unsigned long long)pk2(y.x, y.y) | ((unsigned long long)pk2(y.z, y.w) << 32); }
    }
}
__device__ __forceinline__ void rms_rows_f32(Frame& F, float* x, const float* g) {
    const int gw = F.vcu * NWAVES + F.wave, NGW = F.G * NWAVES;
    f32x4 gv[4];
#pragma unroll
    for (int j = 0; j < 4; ++j) gv[j] = ((const GAS f32x4*)g)[F.lane + 64 * j];
    for (int m = gw; m < M_TOK; m += NGW) {
        GAS f32x4* xr = (GAS f32x4*)(x + (size_t)m * 1024) + F.lane;
        f32x4 v[4]; float s = 0.f;
#pragma unroll
        for (int j = 0; j < 4; ++j) { v[j] = xr[64 * j]; s += (v[j].x * v[j].x + v[j].y * v[j].y) + (v[j].z * v[j].z + v[j].w * v[j].w); }
        const float rs = rsqrtf(wave_sum(s) * (1.f / 1024.f) + 1e-6f);
#pragma unroll
        for (int j = 0; j < 4; ++j) xr[64 * j] = v[j] * rs * gv[j];
    }
}
__device__ __forceinline__ void conv_fixup(Frame& F, const float* EDGE, const float* cw, const float* cb, bf16_t* HM) {
    const int gt = (F.vcu * NWAVES + F.wave) * 64 + F.lane, NT = F.G * NWAVES * 64;
    constexpr int NQ = 2816 / 4, TOTAL = 1024 * 2 * NQ;
    for (int it = gt; it < TOTAL; it += NT) {
        const int q = it % NQ, j = (it / NQ) & 1, g = it / (2 * NQ); const int c = 4 * q;
        const bool prev = ((g * 64) & 4095) != 0;
        const float* eg = EDGE + (size_t)g * (6 * 2816) + c; const float* ep = eg - 6 * 2816;
        const f32x4 z = {0.f, 0.f, 0.f, 0.f};
        const f32x4 a0 = *(const f32x4*)(eg + j * 2816);
        const f32x4 a1 = j ? *(const f32x4*)(eg) : (prev ? *(const f32x4*)(ep + 3 * 2816) : z);
        const f32x4 a2 = j ? (prev ? *(const f32x4*)(ep + 3 * 2816) : z) : (prev ? *(const f32x4*)(ep + 2 * 2816) : z);
        const f32x4 vl = *(const f32x4*)(eg + (4 + j) * 2816);
        const f32x4 w0 = *(const f32x4*)(cw + c), w1 = *(const f32x4*)(cw + 2816 + c), w2 = *(const f32x4*)(cw + 5632 + c), b = *(const f32x4*)(cb + c);
        const f32x4 cv = b + w0 * a2 + w1 * a1 + w2 * a0;
        unsigned long long o = (unsigned long long)pk2(pg8::gelu_tanh_fast(cv.x) * vl.x, pg8::gelu_tanh_fast(cv.y) * vl.y) | ((unsigned long long)pk2(pg8::gelu_tanh_fast(cv.z) * vl.z, pg8::gelu_tanh_fast(cv.w) * vl.w) << 32);
        *(unsigned long long*)(HM + ((size_t)g * 64 + j) * 2816 + c) = o;
    }
}

__global__ void __launch_bounds__(NWAVES * 64, 2) skel_fwd(Args args) {
    extern __shared__ __attribute__((aligned(16))) unsigned char lds[];
    Frame F;
    F.lds = (LAS unsigned char*)lds; F.MISC = (volatile LAS unsigned*)(F.lds + MISC_OFF);
    F.tid = threadIdx.x; F.lane = F.tid & 63; F.wave = __builtin_amdgcn_readfirstlane(F.tid >> 6);
    F.G = gridDim.x; { const int bx = blockIdx.x; F.vcu = (F.G % 8 == 0) ? (bx % 8) * (F.G / 8) + bx / 8 : bx; }
    unsigned char* ws = args.ws;
    F.ctl = (gu32*)(ws + WS_CTL);
    for (int u = F.tid; u < (LDS_BYTES - LDSCTL_OFF) / 4; u += NWAVES * 64) ((LAS unsigned*)(F.lds + LDSCTL_OFF))[u] = 0u;
    __syncthreads();
    XcdBarrier bar = xcd_barrier_post((unsigned*)(F.ctl + CW_BAR) + args.li * XCD_BAR_WORDS, F.MISC + 8);
#define GRID_BAR() xcd_barrier(bar)
    const int lo = args.ph_lo, hi = args.ph_hi;
#define IN(k) (lo <= (k) && (k) < hi)
#define BOTH(k) (IN(k) && IN((k) + 1))
    bf16_t* const A = (bf16_t*)(ws + WS_A);
    bf16_t *GQ = (bf16_t*)(ws + WS_GQ), *GK = (bf16_t*)(ws + WS_GK), *GV = (bf16_t*)(ws + WS_GV), *GR = (bf16_t*)(ws + WS_GR), *FQ = (bf16_t*)(ws + WS_FQ), *FK = (bf16_t*)(ws + WS_FK), *FV = (bf16_t*)(ws + WS_FV);
    bf16_t *SG = (bf16_t*)(ws + WS_SG), *SF = (bf16_t*)(ws + WS_SF), *Y = (bf16_t*)(ws + WS_Y), *HM = (bf16_t*)(ws + WS_HM);
    float *GLR = (float*)(ws + WS_GLR), *LF2 = (float*)(ws + WS_LF2), *EDGE = (float*)(ws + WS_EDGE);

    if (IN(0)) { p0_weights(F, args); if (BOTH(0)) GRID_BAR(); }
    if (IN(1)) { rms_rows_bf16(F, args.in[0], args.in[1], A); if (BOTH(1)) GRID_BAR(); }
    if (IN(2)) {
        pg8::Gemm g{A, (const bf16_t*)(ws + WS_WIN), M_TOK, 5376, 1024}; pg8::StaticOrder S; S.init(M_TOK, 5376, F.G, (int)blockIdx.x);
        pg8::EpiInProj E{GQ, GK, GV, GR, FQ, FK, FV, SG, SF, GLR, LF2, args.in[6], args.in[7], args.in[8], args.in[9]};
        pg8::gemm_phase<pg8::EpiInProj, pg8::StaticOrder, true, true>(F.lds + RING_OFF, g, S, E);
        if (BOTH(2)) GRID_BAR();
    }
    if (IN(3)) { PHASE_GLA; if (BOTH(3)) GRID_BAR(); }
    if (IN(4)) { PHASE_FOX; if (BOTH(4)) GRID_BAR(); }
    if (IN(5)) {
        pg8::Gemm g{A, (const bf16_t*)(ws + WS_WGF), M_TOK, 1024, 1024}; pg8::StaticOrder S; S.init(M_TOK, 1024, F.G, (int)blockIdx.x);
        pg8::EpiMerge E{SG, SF, Y};
        pg8::gemm_phase<pg8::EpiMerge, pg8::StaticOrder, true, true>(F.lds + RING_OFF, g, S, E);
        if (BOTH(5)) GRID_BAR();
    }
    if (IN(6)) {
        pg8::Gemm g{Y, (const bf16_t*)(ws + WS_WOUT), M_TOK, 1024, 1024}; pg8::StaticOrder S; S.init(M_TOK, 1024, F.G, (int)blockIdx.x);
        pg8::EpiResid E{args.in[0], args.out};
        pg8::gemm_phase<pg8::EpiResid, pg8::StaticOrder, true, true>(F.lds + RING_OFF, g, S, E);
        if (BOTH(6)) GRID_BAR();
    }
    if (IN(7)) { rms_rows_bf16(F, args.out, args.in[13], A); if (BOTH(7)) GRID_BAR(); }
    if (IN(8)) {
        pg8::Gemm g{A, (const bf16_t*)(ws + WS_WUP), M_TOK, 5632, 1024}; pg8::StaticOrder S; S.init(M_TOK, 5632, F.G, (int)blockIdx.x);
        pg8::EpiUp E{HM, EDGE, args.in[15], args.in[16]};
        pg8::gemm_phase<pg8::EpiUp, pg8::StaticOrder, true, true>(F.lds + RING_OFF, g, S, E);
        if (BOTH(8)) GRID_BAR();
    }
    if (IN(9)) { conv_fixup(F, EDGE, args.in[15], args.in[16], HM); if (BOTH(9)) GRID_BAR(); }
    if (IN(10)) {
        pg8::Gemm g{HM, (const bf16_t*)(ws + WS_WDN), M_TOK, 1024, 2816}; pg8::StaticOrder S; S.init(M_TOK, 1024, F.G, (int)blockIdx.x);
        pg8::EpiResid E{args.out, args.out};
        pg8::gemm_phase<pg8::EpiResid, pg8::StaticOrder, true, true>(F.lds + RING_OFF, g, S, E);
        if (BOTH(10)) GRID_BAR();
    }
    if (IN(11)) { rms_rows_f32(F, args.out, args.in[18]); }
#undef IN
#undef BOTH
}
static const int ST_PH_LO[10] = {1, 2, 3, 4, 5, 6, 7, 8, 10, 11}, ST_PH_HI[10] = {2, 3, 4, 5, 6, 7, 8, 10, 11, 12};
#ifndef OPT_MASK
#define OPT_MASK 0x3F3
#endif
extern "C" void kernel_launch(void* const* d_in, const int* in_sizes, int n_in, void* d_out, int out_size, void* d_ws, size_t ws_size, hipStream_t stream) {
    static int grid = 0;
    if (grid == 0) {
        if (n_in != 19 || out_size != M_TOK * DM || ws_size < WS_END) { fprintf(stderr, "kernel_launch: unexpected shapes (n_in %d out %d ws %zu)\n", n_in, out_size, ws_size); grid = -1; return; }
        int dev = 0, cus = 0, per_cu = 0;
        if (hipGetDevice(&dev) != hipSuccess || hipDeviceGetAttribute(&cus, hipDeviceAttributeMultiprocessorCount, dev) != hipSuccess) { grid = -1; return; }
        if (hipFuncSetAttribute((const void*)skel_fwd, hipFuncAttributeMaxDynamicSharedMemorySize, LDS_BYTES) != hipSuccess) { fprintf(stderr, "kernel_launch: hipFuncSetAttribute failed\n"); grid = -1; return; }
        if (hipOccupancyMaxActiveBlocksPerMultiprocessor(&per_cu, (const void*)skel_fwd, NWAVES * 64, LDS_BYTES) != hipSuccess || per_cu < 1) fprintf(stderr, "kernel_launch: occupancy query reports %d\n", per_cu);
        (void)hipGetLastError();
        grid = cus;
    }
    if (grid < 0) return;
    (void)hipMemsetAsync((char*)d_ws + WS_CTL, 0, CTL_ZERO_BYTES, stream);
    Args a{};
    for (int i = 0; i < 19; ++i) a.in[i] = (const float*)d_in[i];
    a.out = (float*)d_out; a.ws = (unsigned char*)d_ws;
    int li = 0;
    auto launch = [&](int lo, int hi) { a.ph_lo = lo; a.ph_hi = hi; a.li = li++; hipLaunchKernelGGL(skel_fwd, dim3(grid), dim3(NWAVES * 64), LDS_BYTES, stream, a); };
    const unsigned mask = OPT_MASK;
    int pend_lo = 0, pend_hi = 1;
    for (int s = 0; s < 10; ++s) {
#ifdef DBG_G1MASK
        if (s == 1 && (mask & 2u)) { launch(pend_lo, ST_PH_HI[1]); pend_lo = pend_hi = 0; gold_forward(d_in, (float*)d_out, (unsigned char*)d_ws, stream, 1, 2, DBG_G1MASK); continue; }
#endif
        if (mask & (1u << s)) { if (pend_hi == ST_PH_LO[s]) pend_hi = ST_PH_HI[s]; else { if (pend_hi > pend_lo) launch(pend_lo, pend_hi); pend_lo = ST_PH_LO[s]; pend_hi = ST_PH_HI[s]; } }
        else { if (pend_hi > pend_lo) launch(pend_lo, pend_hi); pend_lo = pend_hi = 0; gold_forward(d_in, (float*)d_out, (unsigned char*)d_ws, stream, s, s + 1); }
    }
    if (pend_hi > pend_lo) launch(pend_lo, pend_hi);
}
```

```cpp
#include <hip/hip_runtime.h>
#include <hip/hip_bf16.h>
#include <cstdint>
#include <cstdio>
#include <cmath>

typedef unsigned short bf16_t;
__device__ __forceinline__ float bf2f(bf16_t v) { return __uint_as_float(((unsigned)v) << 16); }
__device__ __forceinline__ bf16_t f2bf(float f) { unsigned u = __float_as_uint(f); return (bf16_t)((u + 0x7fffu + ((u >> 16) & 1u)) >> 16); }
#define LOG2E 1.4426950408889634f
#define QSCALE2 (0.125f * 1.4426950408889634f)

constexpr int M_TOK = 65536, DM = 1024, SEQ = 4096, NB = 16, DFF = 2816, INC = 5144;
constexpr size_t MiB = 1u << 20;
constexpr size_t WS_CTL = 0;
constexpr size_t WS_W = 1 * MiB;
constexpr size_t WS_A = 32 * MiB;
constexpr size_t WS_GQ = 160 * MiB, WS_GK = 192 * MiB, WS_GV = 224 * MiB, WS_GR = 288 * MiB, WS_FQ = 352 * MiB, WS_FK = 416 * MiB, WS_FV = 480 * MiB;
constexpr size_t WS_SG = 544 * MiB, WS_SF = 672 * MiB;
constexpr size_t WS_GLR = 800 * MiB, WS_LF2 = 804 * MiB, WS_C2S = 806 * MiB;
constexpr size_t WS_Y = 160 * MiB;
constexpr size_t WS_HM = 160 * MiB;
constexpr size_t WS_C = 832 * MiB;
constexpr size_t WS_END = 1008 * MiB;
#define OPT_MASK 0x3FF
namespace gold {
__device__ __forceinline__ float wsum(float v) {
#pragma unroll
    for (int o = 1; o < 64; o <<= 1) v += __shfl_xor(v, o);
    return v;
}
__device__ __forceinline__ float logsigmoidf_(float z) { return fminf(z, 0.f) - log1pf(expf(-fabsf(z))); }
__device__ __forceinline__ float sigmoidf_(float z) { return 1.f / (1.f + expf(-z)); }

__global__ void __launch_bounds__(256) k_rmsnorm_bf16(const float* x, const float* g, bf16_t* out, int rows) {
    const int w = (blockIdx.x * 256 + threadIdx.x) >> 6, lane = threadIdx.x & 63;
    if (w >= rows) return;
    const float* xr = x + (size_t)w * 1024;
    float v[16]; float s = 0.f;
#pragma unroll
    for (int j = 0; j < 16; ++j) { v[j] = xr[lane + 64 * j]; s += v[j] * v[j]; }
    s = wsum(s); const float rs = rsqrtf(s * (1.f / 1024.f) + 1e-6f);
#pragma unroll
    for (int j = 0; j < 16; ++j) out[(size_t)w * 1024 + lane + 64 * j] = f2bf(v[j] * rs * g[lane + 64 * j]);
}
__global__ void __launch_bounds__(256) k_rmsnorm_f32(float* x, const float* g, int rows) {
    const int w = (blockIdx.x * 256 + threadIdx.x) >> 6, lane = threadIdx.x & 63;
    if (w >= rows) return;
    float* xr = x + (size_t)w * 1024;
    float v[16]; float s = 0.f;
#pragma unroll
    for (int j = 0; j < 16; ++j) { v[j] = xr[lane + 64 * j]; s += v[j] * v[j]; }
    s = wsum(s); const float rs = rsqrtf(s * (1.f / 1024.f) + 1e-6f);
#pragma unroll
    for (int j = 0; j < 16; ++j) xr[lane + 64 * j] = v[j] * rs * g[lane + 64 * j];
}
__global__ void __launch_bounds__(256) k_gemm(const bf16_t* A, int lda, const float* W, int ldw, float* C, int ldc, int N, int K) {
    __shared__ float As[16][68]; __shared__ float Bs[16][68];
    const int t = threadIdx.x, tx = t & 15, ty = t >> 4;
    const int m0 = blockIdx.y * 64, n0 = blockIdx.x * 64;
    float acc[4][4];
#pragma unroll
    for (int i = 0; i < 4; ++i)
#pragma unroll
        for (int j = 0; j < 4; ++j) acc[i][j] = 0.f;
    const int ar = t >> 2, ak = (t & 3) * 4, bk = t >> 4, bn = (t & 15) * 4;
    for (int k0 = 0; k0 < K; k0 += 16) {
        const bf16_t* ap = A + (size_t)(m0 + ar) * lda + k0 + ak;
#pragma unroll
        for (int i = 0; i < 4; ++i) As[ak + i][ar] = bf2f(ap[i]);
        const float* wp = W + (size_t)(k0 + bk) * ldw + n0 + bn;
#pragma unroll
        for (int i = 0; i < 4; ++i) Bs[bk][bn + i] = (n0 + bn + i < N) ? wp[i] : 0.f;
        __syncthreads();
#pragma unroll
        for (int kk = 0; kk < 16; ++kk) {
            float a[4], b[4];
#pragma unroll
            for (int i = 0; i < 4; ++i) { a[i] = As[kk][ty * 4 + i]; b[i] = Bs[kk][tx * 4 + i]; }
#pragma unroll
            for (int i = 0; i < 4; ++i)
#pragma unroll
                for (int j = 0; j < 4; ++j) acc[i][j] += a[i] * b[j];
        }
        __syncthreads();
    }
#pragma unroll
    for (int i = 0; i < 4; ++i)
#pragma unroll
        for (int j = 0; j < 4; ++j) if (n0 + tx * 4 + j < N) C[(size_t)(m0 + ty * 4 + i) * ldc + n0 + tx * 4 + j] = acc[i][j];
}
__global__ void __launch_bounds__(256) k_inproj_epi(const float* P, int row0, const float* fb, const float* qg, const float* kg, const float* gate_b,
                                                    bf16_t* GQ, bf16_t* GK, bf16_t* GV, bf16_t* GR, float* GLR, bf16_t* FQ, bf16_t* FK, bf16_t* FV, float* LF2, bf16_t* SG, bf16_t* SF, int gm) {
    const int r = blockIdx.x, t = threadIdx.x; const float* p = P + (size_t)r * 5144; const size_t m = (size_t)row0 + r;
    if (gm & 1) { GQ[m * 256 + t] = f2bf(p[t] * 0.125f); GK[m * 256 + t] = f2bf(p[256 + t]); }
    if (gm & 1)
#pragma unroll
    for (int j = 0; j < 2; ++j) { const int c = t + 256 * j; GV[m * 512 + c] = f2bf(p[512 + c]); GR[m * 512 + c] = f2bf(p[1024 + c]); FV[m * 512 + c] = f2bf(p[2576 + c]); }
    if ((gm & 2) && t < 16) GLR[m * 16 + t] = p[1536 + t];
    if ((gm & 2) && t < 8) LF2[m * 8 + t] = logsigmoidf_(p[3088 + t] + fb[t]) * LOG2E;
    if (gm & 4)
#pragma unroll
    for (int j = 0; j < 2; ++j) { const int c = t + 256 * j;
        float v = p[1552 + c]; float rs = rsqrtf(wsum(v * v) * (1.f / 64.f) + 1e-6f); FQ[m * 512 + c] = f2bf(v * rs * qg[c & 63] * QSCALE2);
        v = p[2064 + c]; rs = rsqrtf(wsum(v * v) * (1.f / 64.f) + 1e-6f); FK[m * 512 + c] = f2bf(v * rs * kg[c & 63]); }
    if (gm & 8)
#pragma unroll
    for (int j = 0; j < 4; ++j) { const int c = t + 256 * j; SG[m * 1024 + c] = f2bf(sigmoidf_(p[3096 + c] + gate_b[c])); SF[m * 1024 + c] = f2bf(sigmoidf_(p[4120 + c] + gate_b[1024 + c])); }
}
__global__ void __launch_bounds__(256) k_gla(const bf16_t* GQ, const bf16_t* GK, const bf16_t* GV, const bf16_t* GR, const float* GLR, const float* w2, const float* ba, const float* gn, bf16_t* OGF) {
    __shared__ float sa[64], sq[64], sk[64], so[2][128], sred[4];
    const int bh = blockIdx.x, b = bh >> 2, h = bh & 3, t = threadIdx.x, dv = t & 127, dh = t >> 7;
    float S[32];
#pragma unroll
    for (int i = 0; i < 32; ++i) S[i] = 0.f;
    float w2c[16]; float bac = 0.f;
#pragma unroll
    for (int r = 0; r < 16; ++r) w2c[r] = (t < 64) ? w2[r * 256 + h * 64 + t] : 0.f;
    if (t < 64) bac = ba[h * 64 + t];
    const float gnv = gn[h * 128 + dv];
    for (int tok = 0; tok < 4096; ++tok) {
        const size_t m = (size_t)b * 4096 + tok;
        if (t < 64) { float z = bac;
#pragma unroll
            for (int r = 0; r < 16; ++r) z += GLR[m * 16 + r] * w2c[r];
            sa[t] = expf(logsigmoidf_(z) * (1.f / 16.f)); sq[t] = bf2f(GQ[m * 256 + h * 64 + t]); sk[t] = bf2f(GK[m * 256 + h * 64 + t]); }
        __syncthreads();
        const float v = bf2f(GV[m * 512 + h * 128 + dv]); float op = 0.f;
#pragma unroll
        for (int i = 0; i < 32; ++i) { const int d = 32 * dh + i; S[i] = sa[d] * S[i] + sk[d] * v; op += sq[d] * S[i]; }
        so[dh][dv] = op;
        __syncthreads();
        const float o = so[0][dv] + so[1][dv]; const float ss = wsum(o * o);
        if ((t & 63) == 0) sred[t >> 6] = ss;
        __syncthreads();
        const float tot = sred[0] + sred[1]; const float rs = rsqrtf(tot * (1.f / 128.f) + 1e-6f);
        if (dh == 0) { const float gr = bf2f(GR[m * 512 + h * 128 + dv]); OGF[m * 1024 + h * 128 + dv] = f2bf(o * rs * gnv * gr * sigmoidf_(gr)); }
    }
}
__global__ void __launch_bounds__(64) k_cumsum(const float* LF2, float* C2S) {
    const int bh = blockIdx.x, b = bh >> 3, h = bh & 7, lane = threadIdx.x;
    float s = 0.f;
    for (int i = 0; i < 64; ++i) s += LF2[((size_t)b * 4096 + lane * 64 + i) * 8 + h];
    float inc = s;
#pragma unroll
    for (int o = 1; o < 64; o <<= 1) { const float u = __shfl_up(inc, o); if (lane >= o) inc += u; }
    float run = inc - s;
    for (int i = 0; i < 64; ++i) { run += LF2[((size_t)b * 4096 + lane * 64 + i) * 8 + h]; C2S[(size_t)bh * 4096 + lane * 64 + i] = run; }
}
__global__ void __launch_bounds__(256) k_fox(const bf16_t* FQ, const bf16_t* FK, const bf16_t* FV, const float* C2S, bf16_t* OGF) {
    __shared__ float sk[64][64], sv[64][64], sc[64];
    const int qb = blockIdx.x, bh = blockIdx.y, b = bh >> 3, h = bh & 7, t = threadIdx.x, tq = qb * 256 + t;
    const size_t mq = (size_t)b * 4096 + tq;
    float q[64], o[64];
#pragma unroll
    for (int d = 0; d < 64; ++d) { q[d] = bf2f(FQ[mq * 512 + h * 64 + d]); o[d] = 0.f; }
    const float ct = C2S[(size_t)bh * 4096 + tq];
    float mr = -INFINITY, l = 0.f;
    const int ntile = (qb * 256 + 256) / 64;
    for (int kt = 0; kt < ntile; ++kt) {
        __syncthreads();
        for (int e = t; e < 4096; e += 256) { const int j = e >> 6, d = e & 63; const size_t mk = (size_t)b * 4096 + kt * 64 + j; sk[j][d] = bf2f(FK[mk * 512 + h * 64 + d]); sv[j][d] = bf2f(FV[mk * 512 + h * 64 + d]); }
        if (t < 64) sc[t] = C2S[(size_t)bh * 4096 + kt * 64 + t];
        __syncthreads();
        for (int j = 0; j < 64; ++j) {
            const int s = kt * 64 + j;
            if (s <= tq) {
                float dot = 0.f;
#pragma unroll
                for (int d = 0; d < 64; ++d) dot += q[d] * sk[j][d];
                const float lg = dot + ct - sc[j];
                const float mn = fmaxf(mr, lg), sc_ = exp2f(mr - mn), p = exp2f(lg - mn);
                l = l * sc_ + p;
#pragma unroll
                for (int d = 0; d < 64; ++d) o[d] = o[d] * sc_ + p * sv[j][d];
                mr = mn;
            }
        }
    }
    const float il = 1.f / l;
#pragma unroll
    for (int d = 0; d < 64; ++d) OGF[mq * 1024 + 512 + h * 64 + d] = f2bf(o[d] * il);
}
__global__ void __launch_bounds__(256) k_merge(const float* C1, const float* C2, const bf16_t* SG, const bf16_t* SF, bf16_t* Y, int row0, int n) {
    const int i = blockIdx.x * 256 + threadIdx.x; if (i >= n) return; const size_t g = (size_t)row0 * 1024 + i;
    Y[g] = f2bf(bf2f(SG[g]) * C1[i] + bf2f(SF[g]) * C2[i]);
}
__global__ void __launch_bounds__(256) k_resid(const float* base, const float* C, float* out, int row0, int n) {
    const int i = blockIdx.x * 256 + threadIdx.x; if (i >= n) return; const size_t g = (size_t)row0 * 1024 + i;
    out[g] = base[g] + C[i];
}
__device__ __forceinline__ float gelu_tanh_(float x) { return 0.5f * x * (1.f + tanhf(0.7978845608028654f * (x + 0.044715f * x * x * x))); }
__global__ void __launch_bounds__(256) k_conv_gelu(const float* U, int row0, int rows, const float* cw, const float* cb, bf16_t* HM) {
    const size_t i = (size_t)blockIdx.x * 256 + threadIdx.x; if (i >= (size_t)rows * 2816) return;
    const int r = (int)(i / 2816), c = (int)(i % 2816); const int tok = (row0 + r) & 4095;
    const float a0 = U[(size_t)r * 5632 + c], a1 = tok >= 1 ? U[(size_t)(r - 1) * 5632 + c] : 0.f, a2 = tok >= 2 ? U[(size_t)(r - 2) * 5632 + c] : 0.f;
    const float cv = cb[c] + cw[c] * a2 + cw[2816 + c] * a1 + cw[2 * 2816 + c] * a0;
    HM[((size_t)row0 + r) * 2816 + c] = f2bf(gelu_tanh_(cv) * U[(size_t)r * 5632 + 2816 + c]);
}
}
static void gold_forward(void* const* d_in, float* out, unsigned char* ws, hipStream_t st, int s_lo, int s_hi, int gm1 = 15) {
    const float* x = (const float*)d_in[0];
    bf16_t* A = (bf16_t*)(ws + WS_A); bf16_t *GQ = (bf16_t*)(ws + WS_GQ), *GK = (bf16_t*)(ws + WS_GK), *GV = (bf16_t*)(ws + WS_GV), *GR = (bf16_t*)(ws + WS_GR);
    bf16_t *FQ = (bf16_t*)(ws + WS_FQ), *FK = (bf16_t*)(ws + WS_FK), *FV = (bf16_t*)(ws + WS_FV), *SG = (bf16_t*)(ws + WS_SG), *SF = (bf16_t*)(ws + WS_SF);
    float *GLR = (float*)(ws + WS_GLR), *LF2 = (float*)(ws + WS_LF2), *C2S = (float*)(ws + WS_C2S), *C1 = (float*)(ws + WS_C), *C2 = (float*)(ws + WS_C + 32 * MiB);
    bf16_t *Y = (bf16_t*)(ws + WS_Y), *HM = (bf16_t*)(ws + WS_HM);
    const int CH = 8192, NCH = M_TOK / CH;
#define ST(k) (s_lo <= (k) && (k) < s_hi)
    if (ST(0)) gold::k_rmsnorm_bf16<<<M_TOK / 4, 256, 0, st>>>(x, (const float*)d_in[1], A, M_TOK);
    if (ST(1)) for (int c = 0; c < NCH; ++c) {
        gold::k_gemm<<<dim3((INC + 63) / 64, CH / 64), 256, 0, st>>>(A + (size_t)c * CH * 1024, 1024, (const float*)d_in[2], INC, C1, INC, INC, 1024);
        gold::k_inproj_epi<<<CH, 256, 0, st>>>(C1, c * CH, (const float*)d_in[6], (const float*)d_in[7], (const float*)d_in[8], (const float*)d_in[9], GQ, GK, GV, GR, GLR, FQ, FK, FV, LF2, SG, SF, gm1);
    }
    if (ST(2)) gold::k_gla<<<64, 256, 0, st>>>(GQ, GK, GV, GR, GLR, (const float*)d_in[3], (const float*)d_in[4], (const float*)d_in[5], A);
    if (ST(3)) { gold::k_cumsum<<<128, 64, 0, st>>>(LF2, C2S); gold::k_fox<<<dim3(16, 128), 256, 0, st>>>(FQ, FK, FV, C2S, A); }
    if (ST(4)) for (int c = 0; c < NCH; ++c) {
        gold::k_gemm<<<dim3(16, CH / 64), 256, 0, st>>>(A + (size_t)c * CH * 1024, 1024, (const float*)d_in[10], 1024, C1, 1024, 1024, 512);
        gold::k_gemm<<<dim3(16, CH / 64), 256, 0, st>>>(A + (size_t)c * CH * 1024 + 512, 1024, (const float*)d_in[11], 1024, C2, 1024, 1024, 512);
        gold::k_merge<<<CH * 1024 / 256, 256, 0, st>>>(C1, C2, SG, SF, Y, c * CH, CH * 1024);
    }
    if (ST(5)) for (int c = 0; c < NCH; ++c) {
        gold::k_gemm<<<dim3(16, CH / 64), 256, 0, st>>>(Y + (size_t)c * CH * 1024, 1024, (const float*)d_in[12], 1024, C1, 1024, 1024, 1024);
        gold::k_resid<<<CH * 1024 / 256, 256, 0, st>>>(x, C1, out, c * CH, CH * 1024);
    }
    if (ST(6)) gold::k_rmsnorm_bf16<<<M_TOK / 4, 256, 0, st>>>(out, (const float*)d_in[13], A, M_TOK);
    if (ST(7)) for (int c = 0; c < NCH; ++c) {
        gold::k_gemm<<<dim3(5632 / 64, CH / 64), 256, 0, st>>>(A + (size_t)c * CH * 1024, 1024, (const float*)d_in[14], 5632, C1, 5632, 5632, 1024);
        gold::k_conv_gelu<<<(unsigned)(((size_t)CH * 2816 + 255) / 256), 256, 0, st>>>(C1, c * CH, CH, (const float*)d_in[15], (const float*)d_in[16], HM);
    }
    if (ST(8)) for (int c = 0; c < NCH; ++c) {
        gold::k_gemm<<<dim3(16, CH / 64), 256, 0, st>>>(HM + (size_t)c * CH * 2816, 2816, (const float*)d_in[17], 1024, C1, 1024, 1024, 2816);
        gold::k_resid<<<CH * 1024 / 256, 256, 0, st>>>(out, C1, out, c * CH, CH * 1024);
    }
    if (ST(9)) gold::k_rmsnorm_f32<<<M_TOK / 4, 256, 0, st>>>(out, (const float*)d_in[18], M_TOK);
#undef ST
}
namespace pg8 {
#define PG8_LAS __attribute__((address_space(3)))
typedef unsigned short bf16_t;
typedef short bf16x8 __attribute__((ext_vector_type(8)));
typedef float f32x4 __attribute__((ext_vector_type(4)));
typedef unsigned u32x4 __attribute__((ext_vector_type(4)));
constexpr int BM = 256, BK = 64, HALF = 128, HTB = HALF * BK * 2  , STAGE_BYTES = 8 * HTB, NXCD = 8, WGM = 8;

__host__ __device__ __forceinline__ int lds_byte(int r, int c) { const int st = (r >> 4) * 2 + (c >> 5), rr = r & 15, cc = c & 31, ob = rr * 64 + cc * 2; return st * 1024 + (ob ^ (((ob >> 9) & 1) << 5)); }
__host__ __device__ __forceinline__ void stage_rc(int b, int& R, int& C) { const int st = b / 1024, sb = b % 1024, swz = sb ^ (((sb >> 9) & 1) << 5); R = (st >> 1) * 16 + swz / 64; C = (st & 1) * 32 + (swz % 64) / 2; }
__host__ __device__ __forceinline__ int perm32(int rho) { const int n = rho >> 4, i = rho & 15; return 8 * (i >> 2) + 4 * n + (i & 3); }

struct Unit { int pm, pn; };
struct Gemm { const bf16_t* A; const bf16_t* Bt; int M, N, K; };

struct StaticOrder {
    int nM, nN, nwg, G, c;
    __host__ __device__ void init(int M, int N, int G_, int c_) { nM = M / BM; nN = N / BM; nwg = nM * nN; G = G_; c = c_; }
    __host__ __device__ bool next(int i, Unit& u) const {
        const long L = (long)i * G + c; if (L >= nwg) return false;
        int wgid = (int)L; { const int q = nwg / NXCD, r = nwg % NXCD, xcd = wgid % NXCD, off = wgid / NXCD; wgid = (xcd < r ? xcd * (q + 1) : r * (q + 1) + (xcd - r) * q) + off; }
        const int nig = WGM * nN, gid = wgid / nig, fm = gid * WGM, gsz = (nM - fm) < WGM ? (nM - fm) : WGM;
        u.pm = fm + ((wgid % nig) % gsz); u.pn = (wgid % nig) / gsz; return true;
    }
    __device__ __forceinline__ void a_ready(const Unit&) const {}
    __device__ __forceinline__ void done(const Unit&) const {}
};

typedef float f32x2 __attribute__((ext_vector_type(2))); typedef __bf16 bf16x2_t __attribute__((ext_vector_type(2)));
__device__ __forceinline__ unsigned cvt_pk_bf16(float lo, float hi) { f32x2 v = {lo, hi}; bf16x2_t b = __builtin_convertvector(v, bf16x2_t); return __builtin_bit_cast(unsigned, b); }
template <class Epi, class Sched, bool ALIGN_EPI = false, bool SP2 = false>
__device__ __forceinline__ void gemm_phase(PG8_LAS unsigned char* lds, const Gemm g, const Sched& S, const Epi& E) {
    const int tid = threadIdx.x, wid = __builtin_amdgcn_readfirstlane(tid >> 6), lane = tid & 63, wr = wid >> 2, wc = wid & 3, fr = lane & 15, fq = lane >> 4;
    const int K = g.K, nt = K / BK;
    unsigned voffA[2], voffB[2];
#pragma unroll
    for (int i = 0; i < 2; ++i) { int R, C; stage_rc(tid * 16 + i * 8192, R, C); const int Rb = Epi::PERM ? ((R & ~31) + perm32(R & 31)) : R;
        voffA[i] = (unsigned)(R * K + C) * 2u; voffB[i] = (unsigned)(Rb * K + C) * 2u; }
    const size_t kstep = (size_t)(BK * 2);
    const size_t hstep = (size_t)HALF * K * 2;
    const size_t tstep = 2 * hstep;
    const unsigned ldsw = (unsigned)wid * 1024u;
    const int aoff = lds_byte(wr * 64 + fr, fq * 8), boff = lds_byte(wc * 32 + fr, fq * 8);
#define PG8_SA(b, h) (((b) * 2 + (h)) * HTB)
#define PG8_SB(b, h) ((4 + (b) * 2 + (h)) * HTB)
#define PG8_STAGE(bufoff, gbase, voff) do { _Pragma("unroll") for (int _i = 0; _i < 2; ++_i) \
        __builtin_amdgcn_global_load_lds((const unsigned*)((const char*)(gbase) + (voff)[_i]), (PG8_LAS unsigned*)(lds + (bufoff) + ldsw + _i * 8192), 16, 0, 0); } while (0)
#define PG8_LDA(dst, b, h) do { _Pragma("unroll") for (int m = 0; m < 4; ++m) _Pragma("unroll") for (int k = 0; k < 2; ++k) dst[m][k] = *(const PG8_LAS bf16x8*)(lds + PG8_SA(b, h) + aoff + m * 2048 + k * 1024); } while (0)
#define PG8_LDB(dst, b, h) do { _Pragma("unroll") for (int n = 0; n < 2; ++n) _Pragma("unroll") for (int k = 0; k < 2; ++k) dst[n][k] = *(const PG8_LAS bf16x8*)(lds + PG8_SB(b, h) + boff + n * 2048 + k * 1024); } while (0)
#define PG8_MMA(ai, bj, At, Bt) do { __builtin_amdgcn_s_setprio(1); _Pragma("unroll") for (int m = 0; m < 4; ++m) _Pragma("unroll") for (int n = 0; n < 2; ++n) _Pragma("unroll") for (int k = 0; k < 2; ++k) \
        acc[ai][bj][m][n] = __builtin_amdgcn_mfma_f32_16x16x32_bf16(Bt[n][k], At[m][k], acc[ai][bj][m][n], 0, 0, 0); __builtin_amdgcn_s_setprio(0); } while (0)
#define PG8_WAIT_V(n) asm volatile("s_waitcnt vmcnt(" #n ")" ::: "memory")
#define PG8_WAIT_L(n) asm volatile("s_waitcnt lgkmcnt(" #n ")" ::: "memory")
#define PG8_BAR __builtin_amdgcn_s_barrier()
#define PG8_SCHED __builtin_amdgcn_sched_barrier(0)
    Unit cur, nxt; int ui = 0;
    if (!S.next(0, cur)) return;
    f32x4 acc[2][2][4][2];
#pragma unroll
    for (int a = 0; a < 2; ++a)
#pragma unroll
        for (int b = 0; b < 2; ++b)
#pragma unroll
            for (int m = 0; m < 4; ++m)
#pragma unroll
                for (int n = 0; n < 2; ++n) acc[a][b][m][n] = (f32x4){0.f, 0.f, 0.f, 0.f};
    bf16x8 At[4][2], B0[2][2], B1[2][2];
    const char* cA = (const char*)g.A + (size_t)cur.pm * tstep; const char* cB = (const char*)g.Bt + (size_t)cur.pn * tstep;
    S.a_ready(cur);
    if constexpr (SP2) {
        PG8_STAGE(PG8_SB(0, 0), cB, voffB); PG8_STAGE(PG8_SB(0, 1), cB + hstep, voffB); PG8_STAGE(PG8_SA(0, 0), cA, voffA); PG8_STAGE(PG8_SA(0, 1), cA + hstep, voffA);
        if (wr == 1) PG8_BAR;
        PG8_WAIT_V(2); PG8_BAR;
        PG8_STAGE(PG8_SB(1, 0), cB + kstep, voffB); PG8_STAGE(PG8_SA(1, 0), cA + kstep, voffA); PG8_STAGE(PG8_SB(1, 1), cB + hstep + kstep, voffB);
        PG8_WAIT_V(6); PG8_BAR;
    } else {
        PG8_STAGE(PG8_SB(0, 0), cB, voffB); PG8_STAGE(PG8_SA(0, 0), cA, voffA); PG8_STAGE(PG8_SB(0, 1), cB + hstep, voffB); PG8_STAGE(PG8_SA(0, 1), cA + hstep, voffA);
        if (wr == 1) PG8_BAR;
        PG8_WAIT_V(4); PG8_BAR;
        PG8_STAGE(PG8_SB(1, 0), cB + kstep, voffB); PG8_STAGE(PG8_SA(1, 0), cA + kstep, voffA); PG8_STAGE(PG8_SB(1, 1), cB + hstep + kstep, voffB);
        PG8_WAIT_V(6); PG8_BAR;
    }
    for (;;) {
        const bool has_next = S.next(ui + 1, nxt);
        const char* nA = has_next ? (const char*)g.A + (size_t)nxt.pm * tstep : cA; const char* nB = has_next ? (const char*)g.Bt + (size_t)nxt.pn * tstep : cB;
        for (int t = 0; t < nt; t += 2) {
            if constexpr (Epi::MIDK) { if (t == nt / 2) { PG8_SCHED; E.mid(acc, cur, wr, wc, fr, fq); PG8_SCHED; } }
            const bool last = (t == nt - 2);
            const char* a1 = cA + (size_t)(t + 1) * kstep;
            const char* a2 = last ? nA : cA + (size_t)(t + 2) * kstep; const char* b2 = last ? nB : cB + (size_t)(t + 2) * kstep;
            const char* a3 = a2 + kstep; const char* b3 = b2 + kstep;
            if (last && has_next) S.a_ready(nxt);
            if constexpr (SP2) {
            PG8_LDB(B0, 0, 0); PG8_LDB(B1, 0, 1); PG8_SCHED; PG8_LDA(At, 0, 0); PG8_STAGE(PG8_SA(1, 1), a1 + hstep, voffA);
            PG8_WAIT_V(8); PG8_WAIT_L(0); PG8_BAR; PG8_MMA(0, 0, At, B0); PG8_MMA(0, 1, At, B1); PG8_BAR; PG8_SCHED;
            PG8_LDA(At, 0, 1); PG8_STAGE(PG8_SB(0, 0), b2, voffB); PG8_STAGE(PG8_SB(0, 1), b2 + hstep, voffB); PG8_STAGE(PG8_SA(0, 0), a2, voffA);
            PG8_WAIT_V(8); PG8_WAIT_L(0); PG8_BAR; PG8_MMA(1, 0, At, B0); PG8_MMA(1, 1, At, B1); PG8_BAR; PG8_SCHED;
            PG8_LDB(B0, 1, 0); PG8_LDB(B1, 1, 1); PG8_SCHED; PG8_LDA(At, 1, 0); PG8_STAGE(PG8_SA(0, 1), a2 + hstep, voffA);
            PG8_WAIT_V(8); PG8_WAIT_L(0); PG8_BAR; PG8_MMA(0, 0, At, B0); PG8_MMA(0, 1, At, B1); PG8_BAR; PG8_SCHED;
            PG8_LDA(At, 1, 1); PG8_STAGE(PG8_SB(1, 0), b3, voffB); PG8_STAGE(PG8_SB(1, 1), b3 + hstep, voffB); PG8_STAGE(PG8_SA(1, 0), a3, voffA);
            PG8_WAIT_V(8); PG8_WAIT_L(0); PG8_BAR; PG8_MMA(1, 0, At, B0); PG8_MMA(1, 1, At, B1); PG8_BAR; PG8_SCHED;
            } else {
            PG8_LDB(B0, 0, 0); PG8_SCHED; PG8_LDA(At, 0, 0); PG8_STAGE(PG8_SA(1, 1), a1 + hstep, voffA);
            PG8_WAIT_L(8); PG8_BAR; PG8_WAIT_L(0); PG8_MMA(0, 0, At, B0); PG8_BAR; PG8_SCHED;
            PG8_LDB(B1, 0, 1); PG8_STAGE(PG8_SB(0, 0), b2, voffB);
            PG8_BAR; PG8_WAIT_L(0); PG8_MMA(0, 1, At, B1); PG8_BAR;
            PG8_LDA(At, 0, 1); PG8_STAGE(PG8_SA(0, 0), a2, voffA);
            PG8_BAR; PG8_WAIT_L(0); PG8_MMA(1, 0, At, B0); PG8_BAR; PG8_SCHED;
            PG8_STAGE(PG8_SB(0, 1), b2 + hstep, voffB);
            PG8_WAIT_V(6); PG8_BAR; PG8_MMA(1, 1, At, B1); PG8_BAR;
            PG8_LDB(B0, 1, 0); PG8_SCHED; PG8_LDA(At, 1, 0); PG8_STAGE(PG8_SA(0, 1), a2 + hstep, voffA);
            PG8_WAIT_L(8); PG8_BAR; PG8_WAIT_L(0); PG8_MMA(0, 0, At, B0); PG8_BAR; PG8_SCHED;
            PG8_LDB(B1, 1, 1); PG8_STAGE(PG8_SB(1, 0), b3, voffB);
            PG8_BAR; PG8_WAIT_L(0); PG8_MMA(0, 1, At, B1); PG8_BAR;
            PG8_LDA(At, 1, 1); PG8_STAGE(PG8_SA(1, 0), a3, voffA);
            PG8_BAR; PG8_WAIT_L(0); PG8_MMA(1, 0, At, B0); PG8_BAR; PG8_SCHED;
            PG8_STAGE(PG8_SB(1, 1), b3 + hstep, voffB);
            PG8_WAIT_V(6); PG8_BAR; PG8_MMA(1, 1, At, B1); PG8_BAR;
            }
        }
        if constexpr (ALIGN_EPI) { if (wr == 0) PG8_BAR; }
        if constexpr (!Epi::AFTER_DRAIN) { E(acc, cur, wr, wc, fr, fq); S.done(cur); }
        if (!has_next) break;
#pragma unroll
        for (int a = 0; a < 2; ++a)
#pragma unroll
            for (int b = 0; b < 2; ++b)
#pragma unroll
                for (int m = 0; m < 4; ++m)
#pragma unroll
                    for (int n = 0; n < 2; ++n) acc[a][b][m][n] = (f32x4){0.f, 0.f, 0.f, 0.f};
        cur = nxt; cA = nA; cB = nB; ++ui;
        if constexpr (ALIGN_EPI) { if (wr == 1) PG8_BAR; }
    }
    PG8_WAIT_V(0);
    if constexpr (!ALIGN_EPI) { if (wr == 0) PG8_BAR; }
    PG8_BAR;
    if constexpr (Epi::AFTER_DRAIN) { E.fused(acc, cur, wr, wc, fr, fq, lds, wid, lane); S.done(cur); }
#undef PG8_SA
#undef PG8_SB
#undef PG8_STAGE
#undef PG8_LDA
#undef PG8_LDB
#undef PG8_MMA
#undef PG8_WAIT_V
#undef PG8_WAIT_L
#undef PG8_BAR
#undef PG8_SCHED
}
}
namespace pg8 {
typedef unsigned u32x2 __attribute__((ext_vector_type(2)));
__device__ __forceinline__ u32x4 pack8(f32x4 a, f32x4 b) { u32x4 w; w.x = cvt_pk_bf16(a[0], a[1]); w.y = cvt_pk_bf16(a[2], a[3]); w.z = cvt_pk_bf16(b[0], b[1]); w.w = cvt_pk_bf16(b[2], b[3]); return w; }
__device__ __forceinline__ float bflo(unsigned w) { return __uint_as_float(w << 16); }
__device__ __forceinline__ float bfhi(unsigned w) { return __uint_as_float(w & 0xffff0000u); }
__device__ __forceinline__ void unpack8(u32x4 w, f32x4& a, f32x4& b) { a = (f32x4){bflo(w.x), bfhi(w.x), bflo(w.y), bfhi(w.y)}; b = (f32x4){bflo(w.z), bfhi(w.z), bflo(w.w), bfhi(w.w)}; }
__device__ __forceinline__ float fast_sigmoid(float z) { return __builtin_amdgcn_rcpf(1.f + __builtin_amdgcn_exp2f(-LOG2E * z)); }
__device__ __forceinline__ f32x4 sig4(f32x4 z) { return (f32x4){fast_sigmoid(z[0]), fast_sigmoid(z[1]), fast_sigmoid(z[2]), fast_sigmoid(z[3])}; }
__device__ __forceinline__ float logsig(float z) { return fminf(z, 0.f) - log1pf(expf(-fabsf(z))); }

struct EpiInProj {
    static constexpr bool PERM = true, AFTER_DRAIN = false, MIDK = false;
    bf16_t *GQ, *GK, *GV, *GR, *FQ, *FK, *FV, *SG, *SF; float *GLR, *LF2; const float *fb, *qg, *kg, *gate_b;
    __device__ __forceinline__ void operator()(const f32x4 (&acc)[2][2][4][2], const Unit& u, int wr, int wc, int fr, int fq) const {
        const int pn = u.pn; const size_t row0 = (size_t)u.pm * BM + wr * 64 + fr; const int qc = 64 * wc + 8 * fq;
        if (pn < 6 || pn == 10 || pn == 11) {
            bf16_t* base; int ld, col0; float sc = 1.f;
            if (pn == 0) { base = GQ; ld = 256; col0 = 0; sc = 0.125f; } else if (pn == 1) { base = GK; ld = 256; col0 = 0; }
            else if (pn < 4) { base = GV; ld = 512; col0 = 256 * (pn - 2); } else if (pn < 6) { base = GR; ld = 512; col0 = 256 * (pn - 4); } else { base = FV; ld = 512; col0 = 256 * (pn - 10); }
#pragma unroll
            for (int ai = 0; ai < 2; ++ai)
#pragma unroll
                for (int m = 0; m < 4; ++m) { bf16_t* rp = base + (row0 + ai * HALF + m * 16) * ld + col0 + qc;
#pragma unroll
                    for (int bj = 0; bj < 2; ++bj) *(u32x4*)(rp + 32 * bj) = pack8(acc[ai][bj][m][0] * sc, acc[ai][bj][m][1] * sc); }
        } else if (pn < 10) {
            const bool isq = pn < 8; bf16_t* base = isq ? FQ : FK; const float* g = isq ? qg : kg; const int head = 4 * ((pn - 6) & 1) + wc; const float osc = isq ? QSCALE2 : 1.f;
            f32x4 gv[2][2];
#pragma unroll
            for (int bj = 0; bj < 2; ++bj)
#pragma unroll
                for (int n = 0; n < 2; ++n) gv[bj][n] = *(const f32x4*)(g + 32 * bj + 8 * fq + 4 * n);
#pragma unroll
            for (int ai = 0; ai < 2; ++ai)
#pragma unroll
                for (int m = 0; m < 4; ++m) { float ss = 0.f;
#pragma unroll
                    for (int bj = 0; bj < 2; ++bj)
#pragma unroll
                        for (int n = 0; n < 2; ++n) { const f32x4 x = acc[ai][bj][m][n]; ss += (x[0] * x[0] + x[1] * x[1]) + (x[2] * x[2] + x[3] * x[3]); }
                    ss += __shfl_xor(ss, 16); ss += __shfl_xor(ss, 32);
                    const float rs = rsqrtf(ss * (1.f / 64.f) + 1e-6f) * osc;
                    bf16_t* rp = base + (row0 + ai * HALF + m * 16) * 512 + 64 * head + 8 * fq;
#pragma unroll
                    for (int bj = 0; bj < 2; ++bj) *(u32x4*)(rp + 32 * bj) = pack8(acc[ai][bj][m][0] * rs * gv[bj][0], acc[ai][bj][m][1] * rs * gv[bj][1]); }
        } else if (pn < 20) {
            const bool isg = pn < 16; bf16_t* base = isg ? SG : SF; const int col0 = 256 * ((pn - 12) & 3); const float* gb = gate_b + (isg ? 0 : 1024) + col0 + qc;
            f32x4 bv[2][2];
#pragma unroll
            for (int bj = 0; bj < 2; ++bj)
#pragma unroll
                for (int n = 0; n < 2; ++n) bv[bj][n] = *(const f32x4*)(gb + 32 * bj + 4 * n);
#pragma unroll
            for (int ai = 0; ai < 2; ++ai)
#pragma unroll
                for (int m = 0; m < 4; ++m) { bf16_t* rp = base + (row0 + ai * HALF + m * 16) * 1024 + col0 + qc;
#pragma unroll
                    for (int bj = 0; bj < 2; ++bj) *(u32x4*)(rp + 32 * bj) = pack8(sig4(acc[ai][bj][m][0] + bv[bj][0]), sig4(acc[ai][bj][m][1] + bv[bj][1])); }
        } else {
            if (wc == 0 && fq < 3) {
                const f32x4 f0 = *(const f32x4*)fb, f1 = *(const f32x4*)(fb + 4);
#pragma unroll
                for (int ai = 0; ai < 2; ++ai)
#pragma unroll
                    for (int m = 0; m < 4; ++m) { const size_t row = row0 + ai * HALF + m * 16; const f32x4 v0 = acc[ai][0][m][0], v1 = acc[ai][0][m][1];
                        if (fq < 2) { *(f32x4*)(GLR + row * 16 + 8 * fq) = v0; *(f32x4*)(GLR + row * 16 + 8 * fq + 4) = v1; }
                        else { f32x4 o0, o1;
#pragma unroll
                            for (int i = 0; i < 4; ++i) { o0[i] = logsig(v0[i] + f0[i]) * LOG2E; o1[i] = logsig(v1[i] + f1[i]) * LOG2E; }
                            *(f32x4*)(LF2 + row * 8) = o0; *(f32x4*)(LF2 + row * 8 + 4) = o1; } }
            }
        }
    }
};
struct EpiMerge {
    static constexpr bool PERM = true, AFTER_DRAIN = false, MIDK = true;
    const bf16_t *SG, *SF; bf16_t* Y;
    __device__ __forceinline__ void mid(f32x4 (&acc)[2][2][4][2], const Unit& u, int wr, int wc, int fr, int fq) const {
        asm volatile("" : "+v"(fr), "+v"(fq));
        const size_t row0 = (size_t)u.pm * BM + wr * 64 + fr; const int col = u.pn * BM + 64 * wc + 8 * fq;
#pragma unroll
        for (int ai = 0; ai < 2; ++ai)
#pragma unroll
            for (int m = 0; m < 4; ++m) { const size_t off = (row0 + ai * HALF + m * 16) * 1024 + col;
#pragma unroll
                for (int bj = 0; bj < 2; ++bj) { f32x4 g0, g1, s0, s1; unpack8(*(const u32x4*)(SG + off + 32 * bj), g0, g1); unpack8(*(const u32x4*)(SF + off + 32 * bj), s0, s1);
#pragma unroll
                    for (int i = 0; i < 4; ++i) { acc[ai][bj][m][0][i] *= g0[i] * __builtin_amdgcn_rcpf(s0[i]); acc[ai][bj][m][1][i] *= g1[i] * __builtin_amdgcn_rcpf(s1[i]); } }
                asm volatile("" : "+v"(acc[ai][0][m][0]), "+v"(acc[ai][0][m][1]), "+v"(acc[ai][1][m][0]), "+v"(acc[ai][1][m][1]));
                if (m & 1) asm volatile("" ::: "memory"); }
    }
    __device__ __forceinline__ void operator()(const f32x4 (&acc)[2][2][4][2], const Unit& u, int wr, int wc, int fr, int fq) const {
        const size_t row0 = (size_t)u.pm * BM + wr * 64 + fr; const int col = u.pn * BM + 64 * wc + 8 * fq;
#pragma unroll
        for (int ai = 0; ai < 2; ++ai)
#pragma unroll
            for (int m = 0; m < 4; ++m) { const size_t off = (row0 + ai * HALF + m * 16) * 1024 + col;
#pragma unroll
                for (int bj = 0; bj < 2; ++bj) { f32x4 s0, s1; unpack8(*(const u32x4*)(SF + off + 32 * bj), s0, s1); *(u32x4*)(Y + off + 32 * bj) = pack8(acc[ai][bj][m][0] * s0, acc[ai][bj][m][1] * s1); } }
    }
};
struct EpiResid {
    static constexpr bool PERM = true, AFTER_DRAIN = false, MIDK = false;
    const float* base; float* out;
    __device__ __forceinline__ void operator()(const f32x4 (&acc)[2][2][4][2], const Unit& u, int wr, int wc, int fr, int fq) const {
        const size_t row0 = (size_t)u.pm * BM + wr * 64 + fr; const int col = u.pn * BM + 64 * wc + 8 * fq;
#pragma unroll
        for (int ai = 0; ai < 2; ++ai)
#pragma unroll
            for (int m = 0; m < 4; ++m) { const size_t off = (row0 + ai * HALF + m * 16) * 1024 + col;
#pragma unroll
                for (int bj = 0; bj < 2; ++bj)
#pragma unroll
                    for (int n = 0; n < 2; ++n) { const f32x4 b = *(const f32x4*)(base + off + 32 * bj + 4 * n); *(f32x4*)(out + off + 32 * bj + 4 * n) = b + acc[ai][bj][m][n]; } }
    }
};
template <int CTRL> __device__ __forceinline__ float dppmov(float v) { return __builtin_bit_cast(float, __builtin_amdgcn_update_dpp(0, __builtin_bit_cast(int, v), CTRL, 0xf, 0xf, false)); }
__device__ __forceinline__ float gelu_tanh_fast(float x) { const float u = x * (1.f + 0.044715f * x * x); return x * __builtin_amdgcn_rcpf(1.f + __builtin_amdgcn_exp2f(-1.5957691216057308f * LOG2E * u)); }
struct EpiUp {
    static constexpr bool PERM = true, AFTER_DRAIN = false, MIDK = false;
    bf16_t* HM; float* EDGE; const float *cw, *cb;
    __device__ __forceinline__ void operator()(const f32x4 (&acc)[2][2][4][2], const Unit& u, int wr, int wc, int fr, int fq) const {
        const int ch0 = 128 * u.pn + 32 * wc + 8 * fq;
        f32x4 w0[2], w1[2], w2[2], bb[2];
#pragma unroll
        for (int n = 0; n < 2; ++n) { w0[n] = *(const f32x4*)(cw + ch0 + 4 * n); w1[n] = *(const f32x4*)(cw + 2816 + ch0 + 4 * n); w2[n] = *(const f32x4*)(cw + 5632 + ch0 + 4 * n); bb[n] = *(const f32x4*)(cb + ch0 + 4 * n); }
#pragma unroll
        for (int ai = 0; ai < 2; ++ai) {
            const size_t rowg = (size_t)u.pm * BM + ai * HALF + wr * 64;
            float* eg = EDGE + (rowg >> 6) * (size_t)(6 * 2816) + ch0;
            if (fr < 2) {
#pragma unroll
                for (int n = 0; n < 2; ++n) { *(f32x4*)(eg + fr * 2816 + 4 * n) = acc[ai][0][0][n]; *(f32x4*)(eg + (4 + fr) * 2816 + 4 * n) = acc[ai][1][0][n]; } }
            if (fr >= 14) {
#pragma unroll
                for (int n = 0; n < 2; ++n) *(f32x4*)(eg + (fr - 12) * 2816 + 4 * n) = acc[ai][0][3][n]; }
#pragma unroll
            for (int m = 0; m < 4; ++m) { f32x4 h[2];
#pragma unroll
                for (int n = 0; n < 2; ++n)
#pragma unroll
                    for (int i = 0; i < 4; ++i) { const float a0 = acc[ai][0][m][n][i];
                        float a1 = dppmov<0x111>(a0), a2 = dppmov<0x112>(a0);
                        if (m > 0) { const float p = acc[ai][0][m - 1][n][i]; const float p1 = dppmov<0x121>(p), p2 = dppmov<0x122>(p);
                            a1 = fr == 0 ? p1 : a1; a2 = fr < 2 ? p2 : a2; }
                        const float cv = bb[n][i] + w0[n][i] * a2 + w1[n][i] * a1 + w2[n][i] * a0;
                        h[n][i] = gelu_tanh_fast(cv) * acc[ai][1][m][n][i]; }
                *(u32x4*)(HM + (rowg + m * 16 + fr) * 2816 + ch0) = pack8(h[0], h[1]); }
        }
    }
};
}
#define GAS __attribute__((address_space(1)))
#define LAS __attribute__((address_space(3)))
typedef unsigned v4u __attribute__((ext_vector_type(4)));
typedef float f32x4 __attribute__((ext_vector_type(4)));
typedef short bf16x8 __attribute__((ext_vector_type(8)));
typedef GAS unsigned gu32;
typedef GAS unsigned long long gu64;
#define RLX_AGENT __ATOMIC_RELAXED, __HIP_MEMORY_SCOPE_AGENT
#define LDS_WAIT() asm volatile("s_waitcnt lgkmcnt(0)" ::: "memory")
#define VM_WAIT() asm volatile("s_waitcnt vmcnt(0)" ::: "memory")
__device__ __forceinline__ unsigned long long rt() { return __builtin_amdgcn_s_memrealtime(); }
__device__ __forceinline__ unsigned pk2(float lo, float hi) { return (unsigned)f2bf(lo) | ((unsigned)f2bf(hi) << 16); }
#define XB_TMO      128
#define XB_XCNT(j)  (256  + 64 * (j))
#define XB_XSUB(j)  (1280 + 64 * (j))
#define XB_XGEN(j)  (2304 + 64 * (j))
#define XB_TOP      3328
#define XB_TOPGEN   3392
#define XCD_BAR_WORDS 3456
#define XB_SPIN_CAP (1u << 18)

__device__ __forceinline__ unsigned xb_ld(unsigned* p)              { return __hip_atomic_load(p, __ATOMIC_RELAXED, __HIP_MEMORY_SCOPE_AGENT); }
__device__ __forceinline__ unsigned xb_add(unsigned* p, unsigned v) { return __hip_atomic_fetch_add(p, v, __ATOMIC_RELAXED, __HIP_MEMORY_SCOPE_AGENT); }
__device__ __forceinline__ unsigned xb_xcc_id() { return (unsigned)__builtin_amdgcn_s_getreg((3 << 11) | 20) & 0xFu; }
#define XB_SPIN(cond, bar) do { unsigned _sp = 0; while (cond) { __builtin_amdgcn_s_sleep(1); \
    if ((++_sp & 255u) == 0u) { if (xb_ld(&(bar)[XB_TMO])) break; if (_sp > XB_SPIN_CAP) { atomicAdd(&(bar)[XB_TMO], 1u); break; } } } } while (0)

struct XcdBarrier {
    unsigned* bar; unsigned x;
    volatile LAS unsigned* st;
};

__device__ __forceinline__ XcdBarrier xcd_barrier_post(unsigned* bar, volatile LAS unsigned* st) {
    XcdBarrier b; b.bar = bar; b.x = xb_xcc_id(); b.st = st;
    if (threadIdx.x == 0) (void)xb_add(&bar[XB_XCNT(b.x)], 1u);
    return b;
}
__device__ __forceinline__ void xcd_barrier_complete(unsigned* bar, unsigned x, unsigned& nloc, unsigned& nx) {
    const unsigned G = gridDim.x * gridDim.y * gridDim.z;
    unsigned sum, cnt, mine, sp = 0u;
    for (;;) {
        sum = 0u; cnt = 0u; mine = 0u;
#pragma unroll
        for (unsigned j = 0; j < 16; ++j) { const unsigned c = xb_ld(&bar[XB_XCNT(j)]); sum += c; cnt += (c > 0u) ? 1u : 0u; mine = (j == x) ? c : mine; }
        if (sum == G) break;
        __builtin_amdgcn_s_sleep(1);
        if ((++sp & 255u) == 0u) { if (xb_ld(&bar[XB_TMO])) break; if (sp > XB_SPIN_CAP) { atomicAdd(&bar[XB_TMO], 1u); break; } }
    }
    nloc = mine > 0u ? mine : 1u; nx = cnt > 0u ? cnt : 1u;
}

__device__ __forceinline__ void xcd_barrier(const XcdBarrier& b) {
    asm volatile("s_waitcnt vmcnt(0)" ::: "memory");
    __syncthreads();
    if (threadIdx.x == 0) {
        unsigned* bar = b.bar;
        __builtin_amdgcn_s_waitcnt(0);
        unsigned nloc = b.st[0], nx = b.st[1];
        if (nloc == 0u) { xcd_barrier_complete(bar, b.x, nloc, nx); b.st[0] = nloc; b.st[1] = nx; }
        const unsigned old = xb_add(&bar[XB_XSUB(b.x)], 1u);
        const unsigned gen = old / nloc;
        if (old + 1u == (gen + 1u) * nloc) {
            __builtin_amdgcn_fence(__ATOMIC_RELEASE, "agent");
            asm volatile("s_waitcnt vmcnt(0)" ::: "memory");
            const unsigned og = xb_add(&bar[XB_TOP], 1u);
            const unsigned tg = og / nx;
            if (og + 1u == (tg + 1u) * nx) xb_add(&bar[XB_TOPGEN], 1u);
            else XB_SPIN(xb_ld(&bar[XB_TOPGEN]) == tg, bar);
            __builtin_amdgcn_fence(__ATOMIC_ACQUIRE, "agent");
            xb_add(&bar[XB_XGEN(b.x)], 1u);
            asm volatile("s_waitcnt vmcnt(0)" ::: "memory");
        } else {
            XB_SPIN(xb_ld(&bar[XB_XGEN(b.x)]) == gen, bar);
            __builtin_amdgcn_fence(__ATOMIC_ACQUIRE, "agent");
            asm volatile("s_waitcnt vmcnt(0)" ::: "memory");
        }
    }
    __syncthreads();
}
namespace fox {
using bf16x8 = __attribute__((ext_vector_type(8))) short;
using s16x4 = __attribute__((ext_vector_type(4))) short;
using f32x16 = __attribute__((ext_vector_type(16))) float;
using f32x4 = __attribute__((ext_vector_type(4))) float;
using u32x4 = __attribute__((ext_vector_type(4))) unsigned;
constexpr int SEQL = 4096, PQ = 512, PO = 1024, QB = 256, KVBLK = 64, SLOTB = 8192;
constexpr int LDS_K = 0, LDS_V = 2 * SLOTB, LDS_WS = 4 * SLOTB, LDS_OST = LDS_WS + 8 * 64 * 4, LDS_C2 = LDS_OST + 8 * 4096, LDS_TOT = LDS_C2 + 4096 * 4 + 64;
static_assert(LDS_TOT <= 131072, "fox LDS");
__device__ __forceinline__ int crow(int r, int hi) { return (r & 3) + 8 * (r >> 2) + 4 * hi; }
#define FSBAR() __builtin_amdgcn_sched_barrier(0)
__device__ __forceinline__ void glds16(const void* gsrc, unsigned lds_dst) { unsigned keep;
    asm volatile("s_mov_b32 %0, m0\n\ts_mov_b32 m0, %2\n\ts_nop 0\n\tglobal_load_lds_dwordx4 %1, off\n\ts_mov_b32 m0, %0" : "=&s"(keep) : "v"(gsrc), "s"(lds_dst) : "memory"); }
typedef float f32x2_t __attribute__((ext_vector_type(2))); typedef __bf16 bf16x2_t __attribute__((ext_vector_type(2)));
__device__ __forceinline__ unsigned cvtpk_s(float lo, float hi) { f32x2_t v = {lo, hi}; bf16x2_t b = __builtin_convertvector(v, bf16x2_t); return __builtin_bit_cast(unsigned, b); }
#define FWAIT_BAR(N) asm volatile("s_waitcnt vmcnt(" #N ") lgkmcnt(0)\n\ts_barrier" ::: "memory")
typedef __attribute__((address_space(3))) const char* lds_cptr;
__device__ __forceinline__ void qkt(f32x16& p0, f32x16& p1, lds_cptr Kslot, const bf16x8* qr, const f32x16& c0, const f32x16& c1, int r32, int hi) {
    lds_cptr kb = Kslot + hi * 1024 + r32 * 16;
#pragma unroll
    for (int d0 = 0; d0 < 4; ++d0) {
        const bf16x8 b0 = *(const __attribute__((address_space(3))) bf16x8*)(kb + d0 * 2048);
        const bf16x8 b1 = *(const __attribute__((address_space(3))) bf16x8*)(kb + d0 * 2048 + 512);
        if (d0 == 0) { p0 = __builtin_amdgcn_mfma_f32_32x32x16_bf16(b0, qr[0], c0, 0, 0, 0); p1 = __builtin_amdgcn_mfma_f32_32x32x16_bf16(b1, qr[0], c1, 0, 0, 0); }
        else { p0 = __builtin_amdgcn_mfma_f32_32x32x16_bf16(b0, qr[d0], p0, 0, 0, 0); p1 = __builtin_amdgcn_mfma_f32_32x32x16_bf16(b1, qr[d0], p1, 0, 0, 0); } }
}
__device__ __forceinline__ void pv(f32x16* o, int vb, bf16x8 pa0, bf16x8 pa1, bf16x8 pa2, bf16x8 pa3) {
#pragma unroll
    for (int d0 = 0; d0 < 2; ++d0) { s16x4 lo[4], hi[4];
#pragma unroll
        for (int ks = 0; ks < 4; ++ks) {
            asm volatile("ds_read_b64_tr_b16 %0,%1 offset:%c2" : "=&v"(lo[ks]) : "v"(vb), "i"(d0 * 4096 + ks * 1024) : "memory");
            asm volatile("ds_read_b64_tr_b16 %0,%1 offset:%c2" : "=&v"(hi[ks]) : "v"(vb), "i"(d0 * 4096 + ks * 1024 + 512) : "memory"); }
        asm volatile("s_waitcnt lgkmcnt(0)" ::: "memory"); FSBAR();
#define FPK(k) (bf16x8){lo[k][0], lo[k][1], lo[k][2], lo[k][3], hi[k][0], hi[k][1], hi[k][2], hi[k][3]}
        o[d0] = __builtin_amdgcn_mfma_f32_32x32x16_bf16(pa0, FPK(0), o[d0], 0, 0, 0);
        o[d0] = __builtin_amdgcn_mfma_f32_32x32x16_bf16(pa1, FPK(1), o[d0], 0, 0, 0);
        o[d0] = __builtin_amdgcn_mfma_f32_32x32x16_bf16(pa2, FPK(2), o[d0], 0, 0, 0);
        o[d0] = __builtin_amdgcn_mfma_f32_32x32x16_bf16(pa3, FPK(3), o[d0], 0, 0, 0);
#undef FPK
    }
}
__device__ __forceinline__ void fox_cumsum(const float* LF2, int b, int h, char* shm) {
    float* c2s = (float*)(shm + LDS_C2); float* wtot = (float*)(shm + LDS_WS);
    const int tid = threadIdx.x, lane = tid & 63, wid = tid >> 6;
    const float* p = LF2 + ((size_t)b * SEQL + 8 * tid) * 8 + h;
    float v[8];
#pragma unroll
    for (int j = 0; j < 8; ++j) v[j] = p[8 * j];
#pragma unroll
    for (int j = 1; j < 8; ++j) v[j] += v[j - 1];
    float inc = v[7];
#pragma unroll
    for (int o = 1; o < 64; o <<= 1) { const float u = __shfl_up(inc, o); if (lane >= o) inc += u; }
    if (lane == 63) wtot[wid] = inc;
    __syncthreads();
    float base = inc - v[7];
    for (int w = 0; w < wid; ++w) base += wtot[w];
#pragma unroll
    for (int j = 0; j < 8; ++j) c2s[8 * tid + j] = base + v[j];
    __syncthreads();
}
__device__ __forceinline__ void fox_unit(int b, int h, int qb, const bf16_t* Q, const bf16_t* K, const bf16_t* V, bf16_t* O, char* shm) {
    const int tid = threadIdx.x, lane = tid & 63, r32 = lane & 31, hi = lane >> 5; const int wid = __builtin_amdgcn_readfirstlane(tid >> 6);
    const long rowbase = (long)b * SEQL; const int q0 = qb * QB;
    const bf16_t* Qw = Q + (rowbase + q0 + wid * 32) * PQ + h * 64;
    const bf16_t* Kh = K + rowbase * PQ + h * 64; const bf16_t* Vh = V + rowbase * PQ + h * 64;
    const unsigned lds0 = (unsigned)(uintptr_t)shm;
    float* wsf = (float*)(shm + LDS_WS) + wid * 64;
    const float* c2s = (const float*)(shm + LDS_C2);
    const bf16_t* ksrc = Kh + (long)lane * PQ + wid * 8;
    const bf16_t* vsrc = Vh + (long)(16 * (wid & 3) + (lane >> 2)) * PQ + (wid >> 2) * 32 + (lane & 3) * 8;
    const unsigned kdst = lds0 + LDS_K + wid * 1024, vdst = lds0 + LDS_V + wid * 1024;
#define DMA_K(t, slot) glds16(ksrc + (long)(t) * KVBLK * PQ, (unsigned)__builtin_amdgcn_readfirstlane(kdst + (slot)))
#define DMA_V(t, slot) glds16(vsrc + (long)(t) * KVBLK * PQ, (unsigned)__builtin_amdgcn_readfirstlane(vdst + (slot)))
    const int vb0 = (int)(lds0 + LDS_V) + ((lane >> 4) & 1) * 32 + (lane & 3) * 8 + (4 * hi + ((lane & 15) >> 2)) * 64;
    const lds_cptr shm3 = (lds_cptr)shm;
    const int NT = (q0 + QB) / KVBLK;
    DMA_K(0, 0); DMA_V(0, 0);
    bf16x8 qr[4];
#pragma unroll
    for (int d0 = 0; d0 < 4; ++d0) qr[d0] = *reinterpret_cast<const bf16x8*>(&Qw[(long)r32 * PQ + d0 * 16 + hi * 8]);
    const int qrel = wid * 32 + r32;
    const float ct = c2s[q0 + qrel];
    float l_reg = 0.f; f32x16 o[2]; o[0] = f32x16{}; o[1] = f32x16{};
    for (int t = 0; t < NT; ++t) {
        const int slot = (t & 1) * SLOTB;
        FWAIT_BAR(0);
        if (t + 1 < NT) { DMA_K(t + 1, slot ^ SLOTB); DMA_V(t + 1, slot ^ SLOTB); }
        f32x16 c0, c1;
        { const __attribute__((address_space(3))) float* cp = (const __attribute__((address_space(3))) float*)(shm3 + LDS_C2) + 64 * t + 4 * hi;
#pragma unroll
          for (int g = 0; g < 4; ++g) { const f32x4 a = *(const __attribute__((address_space(3))) f32x4*)(cp + 8 * g), bq = *(const __attribute__((address_space(3))) f32x4*)(cp + 32 + 8 * g);
#pragma unroll
            for (int i = 0; i < 4; ++i) { c0[4 * g + i] = ct - a[i]; c1[4 * g + i] = ct - bq[i]; } } }
        f32x16 p0, p1;
        qkt(p0, p1, shm3 + LDS_K + slot, qr, c0, c1, r32, hi);
        const int jb = t - (NT - 4);
        if (jb >= 0) { const int kb = 64 * jb + 4 * hi;
#pragma unroll
            for (int r = 0; r < 16; ++r) { const int kv = kb + (r & 3) + 8 * (r >> 2); if (kv > qrel) p0[r] = -INFINITY; if (kv + 32 > qrel) p1[r] = -INFINITY; } }
        float sacc = 0.f;
#pragma unroll
        for (int r = 0; r < 16; ++r) { p0[r] = __builtin_amdgcn_exp2f(p0[r]); p1[r] = __builtin_amdgcn_exp2f(p1[r]); sacc += p0[r] + p1[r]; }
        l_reg += sacc;
        u32x4 pw0, pw1, pw2, pw3;
        pw0 = (u32x4){cvtpk_s(p0[0], p0[1]), cvtpk_s(p0[2], p0[3]), cvtpk_s(p0[4], p0[5]), cvtpk_s(p0[6], p0[7])};
        pw1 = (u32x4){cvtpk_s(p0[8], p0[9]), cvtpk_s(p0[10], p0[11]), cvtpk_s(p0[12], p0[13]), cvtpk_s(p0[14], p0[15])};
        pw2 = (u32x4){cvtpk_s(p1[0], p1[1]), cvtpk_s(p1[2], p1[3]), cvtpk_s(p1[4], p1[5]), cvtpk_s(p1[6], p1[7])};
        pw3 = (u32x4){cvtpk_s(p1[8], p1[9]), cvtpk_s(p1[10], p1[11]), cvtpk_s(p1[12], p1[13]), cvtpk_s(p1[14], p1[15])};
        FSBAR();
        pv(o, vb0 + slot, __builtin_bit_cast(bf16x8, pw0), __builtin_bit_cast(bf16x8, pw1), __builtin_bit_cast(bf16x8, pw2), __builtin_bit_cast(bf16x8, pw3));
    }
    { auto rr = __builtin_amdgcn_permlane32_swap(__float_as_uint(l_reg), __float_as_uint(l_reg), false, false); l_reg = __uint_as_float(rr[0]) + __uint_as_float(rr[1]); }
    if (hi == 0) wsf[32 + r32] = l_reg; asm volatile("s_waitcnt lgkmcnt(0)" ::: "memory");
    float rli[16];
#pragma unroll
    for (int r = 0; r < 16; ++r) rli[r] = __builtin_amdgcn_rcpf(wsf[32 + crow(r, hi)]);
    bf16_t* Ow = O + (rowbase + q0 + wid * 32) * PO + 512 + h * 64;
    { bf16_t* stg = (bf16_t*)(shm + LDS_OST) + wid * 2048;
#pragma unroll
      for (int r = 0; r < 16; ++r) { const int orow = crow(r, hi);
#pragma unroll
          for (int d0 = 0; d0 < 2; ++d0) stg[orow * 64 + d0 * 32 + r32] = f2bf(o[d0][r] * rli[r]); }
      asm volatile("s_waitcnt lgkmcnt(0)" ::: "memory");
#pragma unroll
      for (int i = 0; i < 4; ++i) { const int row = i * 8 + (lane >> 3), ch = lane & 7; const u32x4 v = *(const u32x4*)(stg + row * 64 + ch * 8); *(u32x4*)(Ow + (long)row * PO + ch * 8) = v; } }
    asm volatile("s_waitcnt lgkmcnt(0)\n\ts_barrier" ::: "memory");
#undef DMA_K
#undef DMA_V
}
__device__ __forceinline__ void fox_phase(char* shm, int vcu, const bf16_t* Q, const bf16_t* K, const bf16_t* V, const float* LF2, bf16_t* O) {
    const int bh = vcu >> 1, s = vcu & 1, b = bh >> 3, h = bh & 7;
    if (bh >= 128) return;
    fox_cumsum(LF2, b, h, shm);
    for (int i = 0; i < 8; ++i) { const int pr = s + 2 * (i >> 1); const int qb = (i & 1) ? 15 - pr : pr; fox_unit(b, h, qb, Q, K, V, O, shm); }
}
#undef FSBAR
#undef FWAIT_BAR
}
namespace gla {
using bf16x8 = __attribute__((ext_vector_type(8))) short;
using s16x4 = __attribute__((ext_vector_type(4))) short;
using f32x4 = __attribute__((ext_vector_type(4))) float;
using u32x4 = __attribute__((ext_vector_type(4))) unsigned;
using u32x2 = __attribute__((ext_vector_type(2))) unsigned;
typedef short v4i16_t __attribute__((ext_vector_type(4)));
#define GLAS __attribute__((address_space(3)))
constexpr int G_GLR = 0, G_SEG = 4096, G_DEC = 6144, G_QE = 6400, G_KE = 15616, G_KDT = 24832, G_SC = 34048, G_V = 43264, G_O = 61696, G_END = 95488;
constexpr int RS = 144, VS = 288, OS = 528;
static_assert(G_END <= 131072, "gla LDS");
typedef float f32x2_t __attribute__((ext_vector_type(2))); typedef __bf16 bf16x2_t __attribute__((ext_vector_type(2)));
__device__ __forceinline__ unsigned pk(float lo, float hi) { f32x2_t v = {lo, hi}; bf16x2_t b = __builtin_convertvector(v, bf16x2_t); return __builtin_bit_cast(unsigned, b); }
__device__ __forceinline__ bf16_t cv1(float x) { return (bf16_t)(pk(x, 0.f) & 0xffffu); }
__device__ __forceinline__ float ex2(float x) { return __builtin_amdgcn_exp2f(x); }
__device__ __forceinline__ float logsig2(float z) { return fminf(z, 0.f) * LOG2E - __builtin_amdgcn_logf(1.f + ex2(-fabsf(z) * LOG2E)); }
__device__ __forceinline__ s16x4 vtr(const GLAS char* p) { return __builtin_bit_cast(s16x4, __builtin_amdgcn_ds_read_tr16_b64_v4i16((GLAS v4i16_t*)p)); }

__device__ __forceinline__ void gla_unit(int b, int h, const bf16_t* GQ, const bf16_t* GK, const bf16_t* GV, const bf16_t* GR, const float* GLR, const float* w2, const float* ba, const float* gn, bf16_t* OGF, GLAS char* sm) {
    const int tid = threadIdx.x, lane = tid & 63, g = lane >> 4, c = lane & 15; const int wid = __builtin_amdgcn_readfirstlane(tid >> 6);
    const int d = lane, seg = wid;
    float w2c[16];
#pragma unroll
    for (int r = 0; r < 16; ++r) w2c[r] = w2[r * 256 + h * 64 + d];
    const float bac = ba[h * 64 + d];
    f32x4 S[4];
#pragma unroll
    for (int mb = 0; mb < 4; ++mb) S[mb] = (f32x4){0.f, 0.f, 0.f, 0.f};
    const int el = tid >> 3, ej = tid & 7;
    for (int chunk = 0; chunk < 64; ++chunk) {
        const size_t m0 = (size_t)b * 4096 + 64 * chunk;
        if (tid < 256) { const f32x4 t = *(const f32x4*)(GLR + (m0 + (tid >> 2)) * 16 + 4 * (tid & 3)); *(GLAS f32x4*)(sm + G_GLR + tid * 16) = t; }
#pragma unroll
        for (int i = 0; i < 2; ++i) { const int p = tid + 512 * i, row = p >> 4, ch = p & 15; const u32x4 t = *(const u32x4*)(GV + (m0 + row) * 512 + h * 128 + 8 * ch); *(GLAS u32x4*)(sm + G_V + row * VS + ch * 16) = t; }
        float qv[8], kv[8];
#pragma unroll
        for (int i = 0; i < 8; ++i) { qv[i] = bf2f(GQ[(m0 + 8 * seg + i) * 256 + h * 64 + d]); kv[i] = bf2f(GK[(m0 + 8 * seg + i) * 256 + h * 64 + d]); }
        __syncthreads();
        float la[8];
#pragma unroll
        for (int i = 0; i < 8; ++i) { float z = bac; const GLAS f32x4* gp = (const GLAS f32x4*)(sm + G_GLR + (8 * seg + i) * 64);
#pragma unroll
            for (int r4 = 0; r4 < 4; ++r4) { const f32x4 t = gp[r4]; z += t[0] * w2c[4 * r4] + t[1] * w2c[4 * r4 + 1] + t[2] * w2c[4 * r4 + 2] + t[3] * w2c[4 * r4 + 3]; }
            la[i] = logsig2(z) * (1.f / 16.f); }
#pragma unroll
        for (int i = 1; i < 8; ++i) la[i] += la[i - 1];
        *(GLAS float*)(sm + G_SEG + (seg * 64 + d) * 4) = la[7];
        __syncthreads();
        float pre = 0.f, tot = 0.f;
#pragma unroll
        for (int s = 0; s < 8; ++s) { const float v = *(const GLAS float*)(sm + G_SEG + (s * 64 + d) * 4); tot += v; pre += (s < seg) ? v : 0.f; }
        { float kd[8];
#pragma unroll
          for (int i = 0; i < 8; ++i) { const float bb = la[i] + pre; const int l = 8 * seg + i;
              *(GLAS bf16_t*)(sm + G_QE + l * RS + d * 2) = cv1(qv[i] * ex2(bb)); *(GLAS bf16_t*)(sm + G_KE + l * RS + d * 2) = cv1(kv[i] * ex2(-bb)); kd[i] = kv[i] * ex2(tot - bb); }
          *(GLAS u32x4*)(sm + G_KDT + d * RS + seg * 16) = (u32x4){pk(kd[0], kd[1]), pk(kd[2], kd[3]), pk(kd[4], kd[5]), pk(kd[6], kd[7])};
          if (seg == 0) *(GLAS float*)(sm + G_DEC + d * 4) = ex2(tot); }
        __syncthreads();
        { const int lb = wid >> 1;
#pragma unroll
          for (int mm = 0; mm < 2; ++mm) { const int mbk = 2 * (wid & 1) + mm; f32x4 acc = {0.f, 0.f, 0.f, 0.f};
#pragma unroll
              for (int ks = 0; ks < 2; ++ks) { const bf16x8 a = *(const GLAS bf16x8*)(sm + G_KE + (16 * mbk + c) * RS + (32 * ks + 8 * g) * 2), bq = *(const GLAS bf16x8*)(sm + G_QE + (16 * lb + c) * RS + (32 * ks + 8 * g) * 2);
                  acc = __builtin_amdgcn_mfma_f32_16x16x32_bf16(a, bq, acc, 0, 0, 0); }
              const int l = 16 * lb + c, mq = 16 * mbk + 4 * g;
#pragma unroll
              for (int r = 0; r < 4; ++r) acc[r] = (l >= mq + r) ? acc[r] : 0.f;
              *(GLAS u32x2*)(sm + G_SC + l * RS + mq * 2) = (u32x2){pk(acc[0], acc[1]), pk(acc[2], acc[3])}; } }
        __syncthreads();
        bf16x8 vf[2], sf[2];
        { const int q = c >> 2, p = c & 3;
#pragma unroll
          for (int ks = 0; ks < 2; ++ks) { const GLAS char* ap = sm + G_V + (32 * ks + 8 * g + q) * VS + (16 * wid + 4 * p) * 2; const s16x4 r1 = vtr(ap), r2 = vtr(ap + 4 * VS);
              vf[ks] = (bf16x8){r1[0], r1[1], r1[2], r1[3], r2[0], r2[1], r2[2], r2[3]}; } }
#pragma unroll
        for (int s = 0; s < 2; ++s) { const u32x4 w = {pk(S[2 * s][0], S[2 * s][1]), pk(S[2 * s][2], S[2 * s][3]), pk(S[2 * s + 1][0], S[2 * s + 1][1]), pk(S[2 * s + 1][2], S[2 * s + 1][3])}; sf[s] = __builtin_bit_cast(bf16x8, w); }
        f32x4 oacc[4];
#pragma unroll
        for (int lb = 0; lb < 4; ++lb) { f32x4 acc = {0.f, 0.f, 0.f, 0.f};
#pragma unroll
            for (int ks = 0; ks < 2; ++ks) { const bf16x8 a = *(const GLAS bf16x8*)(sm + G_SC + (16 * lb + c) * RS + (32 * ks + 8 * g) * 2); acc = __builtin_amdgcn_mfma_f32_16x16x32_bf16(a, vf[ks], acc, 0, 0, 0); }
#pragma unroll
            for (int s = 0; s < 2; ++s) { const GLAS char* ap = sm + G_QE + (16 * lb + c) * RS + (32 * s + 4 * g) * 2; const s16x4 lo = *(const GLAS s16x4*)ap, hi = *(const GLAS s16x4*)(ap + 32);
                const bf16x8 a = {lo[0], lo[1], lo[2], lo[3], hi[0], hi[1], hi[2], hi[3]}; acc = __builtin_amdgcn_mfma_f32_16x16x32_bf16(a, sf[s], acc, 0, 0, 0); }
            oacc[lb] = acc; }
#pragma unroll
        for (int mb = 0; mb < 4; ++mb) { const f32x4 dec = *(const GLAS f32x4*)(sm + G_DEC + (16 * mb + 4 * g) * 4); f32x4 acc = S[mb] * dec;
#pragma unroll
            for (int ks = 0; ks < 2; ++ks) { const bf16x8 a = *(const GLAS bf16x8*)(sm + G_KDT + (16 * mb + c) * RS + (32 * ks + 8 * g) * 2); acc = __builtin_amdgcn_mfma_f32_16x16x32_bf16(a, vf[ks], acc, 0, 0, 0); }
            S[mb] = acc; }
#pragma unroll
        for (int lb = 0; lb < 4; ++lb)
#pragma unroll
            for (int r = 0; r < 4; ++r) *(GLAS float*)(sm + G_O + (16 * lb + 4 * g + r) * OS + (16 * wid + c) * 4) = oacc[lb][r];
        __syncthreads();
        { f32x4 o4[4]; float ss = 0.f;
#pragma unroll
          for (int j = 0; j < 4; ++j) { o4[j] = *(const GLAS f32x4*)(sm + G_O + el * OS + ej * 64 + j * 16); ss += (o4[j][0] * o4[j][0] + o4[j][1] * o4[j][1]) + (o4[j][2] * o4[j][2] + o4[j][3] * o4[j][3]); }
          ss += __shfl_xor(ss, 1); ss += __shfl_xor(ss, 2); ss += __shfl_xor(ss, 4);
          const float rs = rsqrtf(ss * (1.f / 128.f) + 1e-6f);
          const bf16_t* grp = GR + (m0 + el) * 512 + h * 128 + 16 * ej; const u32x4 g0 = *(const u32x4*)grp, g1 = *(const u32x4*)(grp + 8);
          const unsigned gw[8] = {g0.x, g0.y, g0.z, g0.w, g1.x, g1.y, g1.z, g1.w};
          const float* gnp = gn + h * 128 + 16 * ej; unsigned ow[8];
#pragma unroll
          for (int j = 0; j < 4; ++j) { const f32x4 gv = *(const f32x4*)(gnp + 4 * j); float r[4];
#pragma unroll
              for (int i = 0; i < 4; ++i) { const unsigned w = gw[2 * j + (i >> 1)]; const float gr = (i & 1) ? __uint_as_float(w & 0xffff0000u) : __uint_as_float(w << 16);
                  r[i] = o4[j][i] * rs * gv[i] * gr * __builtin_amdgcn_rcpf(1.f + ex2(-LOG2E * gr)); }
              ow[2 * j] = pk(r[0], r[1]); ow[2 * j + 1] = pk(r[2], r[3]); }
          bf16_t* op = OGF + (m0 + el) * 1024 + h * 128 + 16 * ej;
          *(u32x4*)op = (u32x4){ow[0], ow[1], ow[2], ow[3]}; *(u32x4*)(op + 8) = (u32x4){ow[4], ow[5], ow[6], ow[7]}; }
    }
}
__device__ __forceinline__ void gla_phase(GLAS char* sm, int vcu, const bf16_t* GQ, const bf16_t* GK, const bf16_t* GV, const bf16_t* GR, const float* GLR, const float* w2, const float* ba, const float* gn, bf16_t* OGF) {
    if (vcu < 64) gla_unit(vcu >> 2, vcu & 3, GQ, GK, GV, GR, GLR, w2, ba, gn, OGF, sm);
}
#undef GLAS
}
#define PHASE_GLA gla::gla_phase((__attribute__((address_space(3))) char*)(F.lds + RING_OFF), F.vcu, GQ, GK, GV, GR, GLR, args.in[3], args.in[4], args.in[5], A)
#define PHASE_FOX fox::fox_phase((char*)lds + RING_OFF, F.vcu, FQ, FK, FV, LF2, A)
constexpr int NWAVES = 8;
constexpr int RING_OFF = 0, RING_BYTES = 131072, LDSCTL_OFF = RING_BYTES, MISC_OFF = LDSCTL_OFF + 320, LDS_BYTES = 147456;
constexpr size_t CTL_ZERO_BYTES = 1 * MiB;
constexpr int CW_TMO = 0, CW_CODE = 1, CW_BAR = 4096;
constexpr int N_PHASES = 12;
constexpr size_t WS_WIN = WS_W, WS_WGF = WS_WIN + (size_t)5376 * 1024 * 2, WS_WOUT = WS_WGF + 2 * MiB, WS_WUP = WS_WOUT + 2 * MiB, WS_WDN = WS_WUP + (size_t)5632 * 1024 * 2;
static_assert(WS_WDN + (size_t)1024 * 2816 * 2 <= WS_A, "weights fit below WS_A");
constexpr size_t WS_EDGE = WS_C;

struct Frame {
    LAS unsigned char* lds; volatile LAS unsigned* MISC; gu32* ctl;
    int tid, lane, wave, vcu, G;
};
__device__ __forceinline__ float wave_sum(float v) {
#pragma unroll
    for (int o = 1; o < 64; o <<= 1) v += __shfl_xor(v, o);
    return v;
}
__device__ __forceinline__ void p0_xpose(const float* colp, int ldw, bf16_t* dst, int ldd, LAS float* scr, int lane) {
#pragma unroll 8
    for (int i = 0; i < 32; ++i) { const int kk = 2 * i + (lane >> 5); scr[kk * 33 + (lane & 31)] = colp ? colp[(size_t)kk * ldw] : 0.f; }
    LDS_WAIT(); asm volatile("" ::: "memory");
    const int c = lane & 7;
#pragma unroll
    for (int j = 0; j < 4; ++j) { const int n = (lane >> 3) + 8 * j; const LAS float* s = scr + (8 * c) * 33 + n;
        v4u o; o.x = pk2(s[0 * 33], s[1 * 33]); o.y = pk2(s[2 * 33], s[3 * 33]); o.z = pk2(s[4 * 33], s[5 * 33]); o.w = pk2(s[6 * 33], s[7 * 33]);
        *(GAS v4u*)(dst + (size_t)n * ldd + 8 * c) = o; }
    LDS_WAIT(); asm volatile("" ::: "memory");
}
__device__ __forceinline__ int inproj_base(int pn) { return pn < 6 ? 256 * pn : (pn < 12 ? 1552 + 256 * (pn - 6) : 3096 + 256 * (pn - 12)); }
struct Args { const float* in[19]; float* out; unsigned char* ws; int ph_lo, ph_hi, li, pad; };

__device__ __forceinline__ void p0_weights(Frame& F, const Args& a) {
    LAS float* scr = (LAS float*)(F.lds + RING_OFF + F.wave * 16384);
    const int gw = F.vcu * NWAVES + F.wave, NGW = F.G * NWAVES, lane = F.lane, c = lane & 31;
    constexpr int I_IN = 16 * 168, I_GF = 16 * 32, I_OUT = 16 * 32, I_UP = 16 * 176, I_DN = 44 * 32, NITEMS = I_IN + I_GF + I_OUT + I_UP + I_DN;
    unsigned char* ws = a.ws;
    for (int it = gw; it < NITEMS; it += NGW) {
        int r = it; const float* colp; int ldw, ldd; bf16_t* dst;
        if (r < I_IN) { const int kb = r / 168, nb = r % 168, pn = nb >> 3, pb = nb & 7, q0 = 64 * (pb & 3) + 32 * (pb >> 2);
            int col; if (pn < 20) col = inproj_base(pn) + q0 + c; else col = (q0 == 0) ? (c < 16 ? 1536 + c : (c < 24 ? 3088 + c - 16 : -1)) : -1;
            ldw = INC; ldd = 1024; colp = col >= 0 ? a.in[2] + (size_t)(64 * kb) * INC + col : nullptr; dst = (bf16_t*)(ws + WS_WIN) + (size_t)(32 * nb) * 1024 + 64 * kb;
        } else if ((r -= I_IN) < I_GF) { const int kb = r / 32, nb = r % 32, pn = nb >> 3, pb = nb & 7, col = 256 * pn + 64 * (pb & 3) + 32 * (pb >> 2) + c;
            ldw = 1024; ldd = 1024; colp = (kb < 8 ? a.in[10] + (size_t)(64 * kb) * 1024 : a.in[11] + (size_t)(64 * (kb - 8)) * 1024) + col; dst = (bf16_t*)(ws + WS_WGF) + (size_t)(32 * nb) * 1024 + 64 * kb;
        } else if ((r -= I_GF) < I_OUT) { const int kb = r / 32, nb = r % 32, pn = nb >> 3, pb = nb & 7, col = 256 * pn + 64 * (pb & 3) + 32 * (pb >> 2) + c;
            ldw = 1024; ldd = 1024; colp = a.in[12] + (size_t)(64 * kb) * 1024 + col; dst = (bf16_t*)(ws + WS_WOUT) + (size_t)(32 * nb) * 1024 + 64 * kb;
        } else if ((r -= I_OUT) < I_UP) { const int kb = r / 176, nb = r % 176, pn = nb >> 3, pb = nb & 7, col = (pb >> 2) * 2816 + 128 * pn + 32 * (pb & 3) + c;
            ldw = 5632; ldd = 1024; colp = a.in[14] + (size_t)(64 * kb) * 5632 + col; dst = (bf16_t*)(ws + WS_WUP) + (size_t)(32 * nb) * 1024 + 64 * kb;
        } else { r -= I_UP; const int kb = r / 32, nb = r % 32, pn = nb >> 3, pb = nb & 7, col = 256 * pn + 64 * (pb & 3) + 32 * (pb >> 2) + c;
            ldw = 1024; ldd = 2816; colp = a.in[17] + (size_t)(64 * kb) * 1024 + col; dst = (bf16_t*)(ws + WS_WDN) + (size_t)(32 * nb) * 2816 + 64 * kb; }
        p0_xpose(colp, ldw, dst, ldd, scr, lane);
    }
}
__device__ __forceinline__ void rms_rows_bf16(Frame& F, const float* x, const float* g, bf16_t* out) {
    const int gw = F.vcu * NWAVES + F.wave, NGW = F.G * NWAVES;
    f32x4 gv[4];
#pragma unroll
    for (int j = 0; j < 4; ++j) gv[j] = ((const GAS f32x4*)g)[F.lane + 64 * j];
    for (int m = gw; m < M_TOK; m += NGW) {
        const GAS f32x4* xr = (const GAS f32x4*)(x + (size_t)m * 1024) + F.lane;
        f32x4 v[4]; float s = 0.f;
#pragma unroll
        for (int j = 0; j < 4; ++j) { v[j] = xr[64 * j]; s += (v[j].x * v[j].x + v[j].y * v[j].y) + (v[j].z * v[j].z + v[j].w * v[j].w); }
        const float rs = rsqrtf(wave_sum(s) * (1.f / 1024.f) + 1e-6f);
        GAS unsigned long long* o8 = (GAS unsigned long long*)(out + (size_t)m * 1024) + F.lane;
#pragma unroll
        for (int j = 0; j < 4; ++j) { const f32x4 y = v[j] * rs * gv[j]; o8[64 * j] = (unsigned long long)pk2(y.x, y.y) | ((unsigned long long)pk2(y.z, y.w) << 32); }
    }
}
__device__ __forceinline__ void rms_rows_f32(Frame& F, float* x, const float* g) {
    const int gw = F.vcu * NWAVES + F.wave, NGW = F.G * NWAVES;
    f32x4 gv[4];
#pragma unroll
    for (int j = 0; j < 4; ++j) gv[j] = ((const GAS f32x4*)g)[F.lane + 64 * j];
    for (int m = gw; m < M_TOK; m += NGW) {
        GAS f32x4* xr = (GAS f32x4*)(x + (size_t)m * 1024) + F.lane;
        f32x4 v[4]; float s = 0.f;
#pragma unroll
        for (int j = 0; j < 4; ++j) { v[j] = xr[64 * j]; s += (v[j].x * v[j].x + v[j].y * v[j].y) + (v[j].z * v[j].z + v[j].w * v[j].w); }
        const float rs = rsqrtf(wave_sum(s) * (1.f / 1024.f) + 1e-6f);
#pragma unroll
        for (int j = 0; j < 4; ++j) xr[64 * j] = v[j] * rs * gv[j];
    }
}
__device__ __forceinline__ void conv_fixup(Frame& F, const float* EDGE, const float* cw, const float* cb, bf16_t* HM) {
    const int gt = (F.vcu * NWAVES + F.wave) * 64 + F.lane, NT = F.G * NWAVES * 64;
    constexpr int NQ = 2816 / 4, TOTAL = 1024 * 2 * NQ;
    for (int it = gt; it < TOTAL; it += NT) {
        const int q = it % NQ, j = (it / NQ) & 1, g = it / (2 * NQ); const int c = 4 * q;
        const bool prev = ((g * 64) & 4095) != 0;
        const float* eg = EDGE + (size_t)g * (6 * 2816) + c; const float* ep = eg - 6 * 2816;
        const f32x4 z = {0.f, 0.f, 0.f, 0.f};
        const f32x4 a0 = *(const f32x4*)(eg + j * 2816);
        const f32x4 a1 = j ? *(const f32x4*)(eg) : (prev ? *(const f32x4*)(ep + 3 * 2816) : z);
        const f32x4 a2 = j ? (prev ? *(const f32x4*)(ep + 3 * 2816) : z) : (prev ? *(const f32x4*)(ep + 2 * 2816) : z);
        const f32x4 vl = *(const f32x4*)(eg + (4 + j) * 2816);
        const f32x4 w0 = *(const f32x4*)(cw + c), w1 = *(const f32x4*)(cw + 2816 + c), w2 = *(const f32x4*)(cw + 5632 + c), b = *(const f32x4*)(cb + c);
        const f32x4 cv = b + w0 * a2 + w1 * a1 + w2 * a0;
        unsigned long long o = (unsigned long long)pk2(pg8::gelu_tanh_fast(cv.x) * vl.x, pg8::gelu_tanh_fast(cv.y) * vl.y) | ((unsigned long long)pk2(pg8::gelu_tanh_fast(cv.z) * vl.z, pg8::gelu_tanh_fast(cv.w) * vl.w) << 32);
        *(unsigned long long*)(HM + ((size_t)g * 64 + j) * 2816 + c) = o;
    }
}

__global__ void __launch_bounds__(NWAVES * 64, 2) skel_fwd(Args args) {
    extern __shared__ __attribute__((aligned(16))) unsigned char lds[];
    Frame F;
    F.lds = (LAS unsigned char*)lds; F.MISC = (volatile LAS unsigned*)(F.lds + MISC_OFF);
    F.tid = threadIdx.x; F.lane = F.tid & 63; F.wave = __builtin_amdgcn_readfirstlane(F.tid >> 6);
    F.G = gridDim.x; { const int bx = blockIdx.x; F.vcu = (F.G % 8 == 0) ? (bx % 8) * (F.G / 8) + bx / 8 : bx; }
    unsigned char* ws = args.ws;
    F.ctl = (gu32*)(ws + WS_CTL);
    for (int u = F.tid; u < (LDS_BYTES - LDSCTL_OFF) / 4; u += NWAVES * 64) ((LAS unsigned*)(F.lds + LDSCTL_OFF))[u] = 0u;
    __syncthreads();
    XcdBarrier bar = xcd_barrier_post((unsigned*)(F.ctl + CW_BAR) + args.li * XCD_BAR_WORDS, F.MISC + 8);
#define GRID_BAR() xcd_barrier(bar)
    const int lo = args.ph_lo, hi = args.ph_hi;
#define IN(k) (lo <= (k) && (k) < hi)
#define BOTH(k) (IN(k) && IN((k) + 1))
    bf16_t* const A = (bf16_t*)(ws + WS_A);
    bf16_t *GQ = (bf16_t*)(ws + WS_GQ), *GK = (bf16_t*)(ws + WS_GK), *GV = (bf16_t*)(ws + WS_GV), *GR = (bf16_t*)(ws + WS_GR), *FQ = (bf16_t*)(ws + WS_FQ), *FK = (bf16_t*)(ws + WS_FK), *FV = (bf16_t*)(ws + WS_FV);
    bf16_t *SG = (bf16_t*)(ws + WS_SG), *SF = (bf16_t*)(ws + WS_SF), *Y = (bf16_t*)(ws + WS_Y), *HM = (bf16_t*)(ws + WS_HM);
    float *GLR = (float*)(ws + WS_GLR), *LF2 = (float*)(ws + WS_LF2), *EDGE = (float*)(ws + WS_EDGE);

    if (IN(0)) { p0_weights(F, args); if (BOTH(0)) GRID_BAR(); }
    if (IN(1)) { rms_rows_bf16(F, args.in[0], args.in[1], A); if (BOTH(1)) GRID_BAR(); }
    if (IN(2)) {
        pg8::Gemm g{A, (const bf16_t*)(ws + WS_WIN), M_TOK, 5376, 1024}; pg8::StaticOrder S; S.init(M_TOK, 5376, F.G, (int)blockIdx.x);
        pg8::EpiInProj E{GQ, GK, GV, GR, FQ, FK, FV, SG, SF, GLR, LF2, args.in[6], args.in[7], args.in[8], args.in[9]};
        pg8::gemm_phase<pg8::EpiInProj, pg8::StaticOrder, true, true>(F.lds + RING_OFF, g, S, E);
        if (BOTH(2)) GRID_BAR();
    }
    if (IN(3)) { PHASE_GLA; if (BOTH(3)) GRID_BAR(); }
    if (IN(4)) { PHASE_FOX; if (BOTH(4)) GRID_BAR(); }
    if (IN(5)) {
        pg8::Gemm g{A, (const bf16_t*)(ws + WS_WGF), M_TOK, 1024, 1024}; pg8::StaticOrder S; S.init(M_TOK, 1024, F.G, (int)blockIdx.x);
        pg8::EpiMerge E{SG, SF, Y};
        pg8::gemm_phase<pg8::EpiMerge, pg8::StaticOrder, true, true>(F.lds + RING_OFF, g, S, E);
        if (BOTH(5)) GRID_BAR();
    }
    if (IN(6)) {
        pg8::Gemm g{Y, (const bf16_t*)(ws + WS_WOUT), M_TOK, 1024, 1024}; pg8::StaticOrder S; S.init(M_TOK, 1024, F.G, (int)blockIdx.x);
        pg8::EpiResid E{args.in[0], args.out};
        pg8::gemm_phase<pg8::EpiResid, pg8::StaticOrder, true, true>(F.lds + RING_OFF, g, S, E);
        if (BOTH(6)) GRID_BAR();
    }
    if (IN(7)) { rms_rows_bf16(F, args.out, args.in[13], A); if (BOTH(7)) GRID_BAR(); }
    if (IN(8)) {
        pg8::Gemm g{A, (const bf16_t*)(ws + WS_WUP), M_TOK, 5632, 1024}; pg8::StaticOrder S; S.init(M_TOK, 5632, F.G, (int)blockIdx.x);
        pg8::EpiUp E{HM, EDGE, args.in[15], args.in[16]};
        pg8::gemm_phase<pg8::EpiUp, pg8::StaticOrder, true, true>(F.lds + RING_OFF, g, S, E);
        if (BOTH(8)) GRID_BAR();
    }
    if (IN(9)) { conv_fixup(F, EDGE, args.in[15], args.in[16], HM); if (BOTH(9)) GRID_BAR(); }
    if (IN(10)) {
        pg8::Gemm g{HM, (const bf16_t*)(ws + WS_WDN), M_TOK, 1024, 2816}; pg8::StaticOrder S; S.init(M_TOK, 1024, F.G, (int)blockIdx.x);
        pg8::EpiResid E{args.out, args.out};
        pg8::gemm_phase<pg8::EpiResid, pg8::StaticOrder, true, true>(F.lds + RING_OFF, g, S, E);
        if (BOTH(10)) GRID_BAR();
    }
    if (IN(11)) { rms_rows_f32(F, args.out, args.in[18]); }
#undef IN
#undef BOTH
}
static const int ST_PH_LO[10] = {1, 2, 3, 4, 5, 6, 7, 8, 10, 11}, ST_PH_HI[10] = {2, 3, 4, 5, 6, 7, 8, 10, 11, 12};
#ifndef OPT_MASK
#define OPT_MASK 0x3F3
#endif
extern "C" void kernel_launch(void* const* d_in, const int* in_sizes, int n_in, void* d_out, int out_size, void* d_ws, size_t ws_size, hipStream_t stream) {
    static int grid = 0;
    if (grid == 0) {
        if (n_in != 19 || out_size != M_TOK * DM || ws_size < WS_END) { fprintf(stderr, "kernel_launch: unexpected shapes (n_in %d out %d ws %zu)\n", n_in, out_size, ws_size); grid = -1; return; }
        int dev = 0, cus = 0, per_cu = 0;
        if (hipGetDevice(&dev) != hipSuccess || hipDeviceGetAttribute(&cus, hipDeviceAttributeMultiprocessorCount, dev) != hipSuccess) { grid = -1; return; }
        if (hipFuncSetAttribute((const void*)skel_fwd, hipFuncAttributeMaxDynamicSharedMemorySize, LDS_BYTES) != hipSuccess) { fprintf(stderr, "kernel_launch: hipFuncSetAttribute failed\n"); grid = -1; return; }
        if (hipOccupancyMaxActiveBlocksPerMultiprocessor(&per_cu, (const void*)skel_fwd, NWAVES * 64, LDS_BYTES) != hipSuccess || per_cu < 1) fprintf(stderr, "kernel_launch: occupancy query reports %d\n", per_cu);
        (void)hipGetLastError();
        grid = cus;
    }
    if (grid < 0) return;
    (void)hipMemsetAsync((char*)d_ws + WS_CTL, 0, CTL_ZERO_BYTES, stream);
    Args a{};
    for (int i = 0; i < 19; ++i) a.in[i] = (const float*)d_in[i];
    a.out = (float*)d_out; a.ws = (unsigned char*)d_ws;
    int li = 0;
    auto launch = [&](int lo, int hi) { a.ph_lo = lo; a.ph_hi = hi; a.li = li++; hipLaunchKernelGGL(skel_fwd, dim3(grid), dim3(NWAVES * 64), LDS_BYTES, stream, a); };
    const unsigned mask = OPT_MASK;
    int pend_lo = 0, pend_hi = 1;
    for (int s = 0; s < 10; ++s) {
#ifdef DBG_G1MASK
        if (s == 1 && (mask & 2u)) { launch(pend_lo, ST_PH_HI[1]); pend_lo = pend_hi = 0; gold_forward(d_in, (float*)d_out, (unsigned char*)d_ws, stream, 1, 2, DBG_G1MASK); continue; }
#endif
        if (mask & (1u << s)) { if (pend_hi == ST_PH_LO[s]) pend_hi = ST_PH_HI[s]; else { if (pend_hi > pend_lo) launch(pend_lo, pend_hi); pend_lo = ST_PH_LO[s]; pend_hi = ST_PH_HI[s]; } }
        else { if (pend_hi > pend_lo) launch(pend_lo, pend_hi); pend_lo = pend_hi = 0; gold_forward(d_in, (float*)d_out, (unsigned char*)d_ws, stream, s, s + 1); }
    }
    if (pend_hi > pend_lo) launch(pend_lo, pend_hi);
}
```

```cpp
#include <hip/hip_runtime.h>
#include <hip/hip_bf16.h>
#include <cstdint>
#include <cstdio>
#include <cmath>

typedef unsigned short bf16_t;
__device__ __forceinline__ float bf2f(bf16_t v) { return __uint_as_float(((unsigned)v) << 16); }
__device__ __forceinline__ bf16_t f2bf(float f) { unsigned u = __float_as_uint(f); return (bf16_t)((u + 0x7fffu + ((u >> 16) & 1u)) >> 16); }
#define LOG2E 1.4426950408889634f
#define QSCALE2 (0.125f * 1.4426950408889634f)

constexpr int M_TOK = 65536, DM = 1024, SEQ = 4096, NB = 16, DFF = 2816, INC = 5144;
constexpr size_t MiB = 1u << 20;
constexpr size_t WS_CTL = 0;
constexpr size_t WS_W = 1 * MiB;
constexpr size_t WS_A = 32 * MiB;
constexpr size_t WS_GQ = 160 * MiB, WS_GK = 192 * MiB, WS_GV = 224 * MiB, WS_GR = 288 * MiB, WS_FQ = 352 * MiB, WS_FK = 416 * MiB, WS_FV = 480 * MiB;
constexpr size_t WS_SG = 544 * MiB, WS_SF = 672 * MiB;
constexpr size_t WS_GLR = 800 * MiB, WS_LF2 = 804 * MiB, WS_C2S = 806 * MiB;
constexpr size_t WS_Y = 160 * MiB;
constexpr size_t WS_HM = 160 * MiB;
constexpr size_t WS_C = 832 * MiB;
constexpr size_t WS_END = 1008 * MiB;
#define OPT_MASK 0x3FF
namespace gold {
__device__ __forceinline__ float wsum(float v) {
#pragma unroll
    for (int o = 1; o < 64; o <<= 1) v += __shfl_xor(v, o);
    return v;
}
__device__ __forceinline__ float logsigmoidf_(float z) { return fminf(z, 0.f) - log1pf(expf(-fabsf(z))); }
__device__ __forceinline__ float sigmoidf_(float z) { return 1.f / (1.f + expf(-z)); }

__global__ void __launch_bounds__(256) k_rmsnorm_bf16(const float* x, const float* g, bf16_t* out, int rows) {
    const int w = (blockIdx.x * 256 + threadIdx.x) >> 6, lane = threadIdx.x & 63;
    if (w >= rows) return;
    const float* xr = x + (size_t)w * 1024;
    float v[16]; float s = 0.f;
#pragma unroll
    for (int j = 0; j < 16; ++j) { v[j] = xr[lane + 64 * j]; s += v[j] * v[j]; }
    s = wsum(s); const float rs = rsqrtf(s * (1.f / 1024.f) + 1e-6f);
#pragma unroll
    for (int j = 0; j < 16; ++j) out[(size_t)w * 1024 + lane + 64 * j] = f2bf(v[j] * rs * g[lane + 64 * j]);
}
__global__ void __launch_bounds__(256) k_rmsnorm_f32(float* x, const float* g, int rows) {
    const int w = (blockIdx.x * 256 + threadIdx.x) >> 6, lane = threadIdx.x & 63;
    if (w >= rows) return;
    float* xr = x + (size_t)w * 1024;
    float v[16]; float s = 0.f;
#pragma unroll
    for (int j = 0; j < 16; ++j) { v[j] = xr[lane + 64 * j]; s += v[j] * v[j]; }
    s = wsum(s); const float rs = rsqrtf(s * (1.f / 1024.f) + 1e-6f);
#pragma unroll
    for (int j = 0; j < 16; ++j) xr[lane + 64 * j] = v[j] * rs * g[lane + 64 * j];
}
__global__ void __launch_bounds__(256) k_gemm(const bf16_t* A, int lda, const float* W, int ldw, float* C, int ldc, int N, int K) {
    __shared__ float As[16][68]; __shared__ float Bs[16][68];
    const int t = threadIdx.x, tx = t & 15, ty = t >> 4;
    const int m0 = blockIdx.y * 64, n0 = blockIdx.x * 64;
    float acc[4][4];
#pragma unroll
    for (int i = 0; i < 4; ++i)
#pragma unroll
        for (int j = 0; j < 4; ++j) acc[i][j] = 0.f;
    const int ar = t >> 2, ak = (t & 3) * 4, bk = t >> 4, bn = (t & 15) * 4;
    for (int k0 = 0; k0 < K; k0 += 16) {
        const bf16_t* ap = A + (size_t)(m0 + ar) * lda + k0 + ak;
#pragma unroll
        for (int i = 0; i < 4; ++i) As[ak + i][ar] = bf2f(ap[i]);
        const float* wp = W + (size_t)(k0 + bk) * ldw + n0 + bn;
#pragma unroll
        for (int i = 0; i < 4; ++i) Bs[bk][bn + i] = (n0 + bn + i < N) ? wp[i] : 0.f;
        __syncthreads();
#pragma unroll
        for (int kk = 0; kk < 16; ++kk) {
            float a[4], b[4];
#pragma unroll
            for (int i = 0; i < 4; ++i) { a[i] = As[kk][ty * 4 + i]; b[i] = Bs[kk][tx * 4 + i]; }
#pragma unroll
            for (int i = 0; i < 4; ++i)
#pragma unroll
                for (int j = 0; j < 4; ++j) acc[i][j] += a[i] * b[j];
        }
        __syncthreads();
    }
#pragma unroll
    for (int i = 0; i < 4; ++i)
#pragma unroll
        for (int j = 0; j < 4; ++j) if (n0 + tx * 4 + j < N) C[(size_t)(m0 + ty * 4 + i) * ldc + n0 + tx * 4 + j] = acc[i][j];
}
__global__ void __launch_bounds__(256) k_inproj_epi(const float* P, int row0, const float* fb, const float* qg, const float* kg, const float* gate_b,
                                                    bf16_t* GQ, bf16_t* GK, bf16_t* GV, bf16_t* GR, float* GLR, bf16_t* FQ, bf16_t* FK, bf16_t* FV, float* LF2, bf16_t* SG, bf16_t* SF, int gm) {
    const int r = blockIdx.x, t = threadIdx.x; const float* p = P + (size_t)r * 5144; const size_t m = (size_t)row0 + r;
    if (gm & 1) { GQ[m * 256 + t] = f2bf(p[t] * 0.125f); GK[m * 256 + t] = f2bf(p[256 + t]); }
    if (gm & 1)
#pragma unroll
    for (int j = 0; j < 2; ++j) { const int c = t + 256 * j; GV[m * 512 + c] = f2bf(p[512 + c]); GR[m * 512 + c] = f2bf(p[1024 + c]); FV[m * 512 + c] = f2bf(p[2576 + c]); }
    if ((gm & 2) && t < 16) GLR[m * 16 + t] = p[1536 + t];
    if ((gm & 2) && t < 8) LF2[m * 8 + t] = logsigmoidf_(p[3088 + t] + fb[t]) * LOG2E;
    if (gm & 4)
#pragma unroll
    for (int j = 0; j < 2; ++j) { const int c = t + 256 * j;
        float v = p[1552 + c]; float rs = rsqrtf(wsum(v * v) * (1.f / 64.f) + 1e-6f); FQ[m * 512 + c] = f2bf(v * rs * qg[c & 63] * QSCALE2);
        v = p[2064 + c]; rs = rsqrtf(wsum(v * v) * (1.f / 64.f) + 1e-6f); FK[m * 512 + c] = f2bf(v * rs * kg[c & 63]); }
    if (gm & 8)
#pragma unroll
    for (int j = 0; j < 4; ++j) { const int c = t + 256 * j; SG[m * 1024 + c] = f2bf(sigmoidf_(p[3096 + c] + gate_b[c])); SF[m * 1024 + c] = f2bf(sigmoidf_(p[4120 + c] + gate_b[1024 + c])); }
}
__global__ void __launch_bounds__(256) k_gla(const bf16_t* GQ, const bf16_t* GK, const bf16_t* GV, const bf16_t* GR, const float* GLR, const float* w2, const float* ba, const float* gn, bf16_t* OGF) {
    __shared__ float sa[64], sq[64], sk[64], so[2][128], sred[4];
    const int bh = blockIdx.x, b = bh >> 2, h = bh & 3, t = threadIdx.x, dv = t & 127, dh = t >> 7;
    float S[32];
#pragma unroll
    for (int i = 0; i < 32; ++i) S[i] = 0.f;
    float w2c[16]; float bac = 0.f;
#pragma unroll
    for (int r = 0; r < 16; ++r) w2c[r] = (t < 64) ? w2[r * 256 + h * 64 + t] : 0.f;
    if (t < 64) bac = ba[h * 64 + t];
    const float gnv = gn[h * 128 + dv];
    for (int tok = 0; tok < 4096; ++tok) {
        const size_t m = (size_t)b * 4096 + tok;
        if (t < 64) { float z = bac;
#pragma unroll
            for (int r = 0; r < 16; ++r) z += GLR[m * 16 + r] * w2c[r];
            sa[t] = expf(logsigmoidf_(z) * (1.f / 16.f)); sq[t] = bf2f(GQ[m * 256 + h * 64 + t]); sk[t] = bf2f(GK[m * 256 + h * 64 + t]); }
        __syncthreads();
        const float v = bf2f(GV[m * 512 + h * 128 + dv]); float op = 0.f;
#pragma unroll
        for (int i = 0; i < 32; ++i) { const int d = 32 * dh + i; S[i] = sa[d] * S[i] + sk[d] * v; op += sq[d] * S[i]; }
        so[dh][dv] = op;
        __syncthreads();
        const float o = so[0][dv] + so[1][dv]; const float ss = wsum(o * o);
        if ((t & 63) == 0) sred[t >> 6] = ss;
        __syncthreads();
        const float tot = sred[0] + sred[1]; const float rs = rsqrtf(tot * (1.f / 128.f) + 1e-6f);
        if (dh == 0) { const float gr = bf2f(GR[m * 512 + h * 128 + dv]); OGF[m * 1024 + h * 128 + dv] = f2bf(o * rs * gnv * gr * sigmoidf_(gr)); }
    }
}
__global__ void __launch_bounds__(64) k_cumsum(const float* LF2, float* C2S) {
    const int bh = blockIdx.x, b = bh >> 3, h = bh & 7, lane = threadIdx.x;
    float s = 0.f;
    for (int i = 0; i < 64; ++i) s += LF2[((size_t)b * 4096 + lane * 64 + i) * 8 + h];
    float inc = s;
#pragma unroll
    for (int o = 1; o < 64; o <<= 1) { const float u = __shfl_up(inc, o); if (lane >= o) inc += u; }
    float run = inc - s;
    for (int i = 0; i < 64; ++i) { run += LF2[((size_t)b * 4096 + lane * 64 + i) * 8 + h]; C2S[(size_t)bh * 4096 + lane * 64 + i] = run; }
}
__global__ void __launch_bounds__(256) k_fox(const bf16_t* FQ, const bf16_t* FK, const bf16_t* FV, const float* C2S, bf16_t* OGF) {
    __shared__ float sk[64][64], sv[64][64], sc[64];
    const int qb = blockIdx.x, bh = blockIdx.y, b = bh >> 3, h = bh & 7, t = threadIdx.x, tq = qb * 256 + t;
    const size_t mq = (size_t)b * 4096 + tq;
    float q[64], o[64];
#pragma unroll
    for (int d = 0; d < 64; ++d) { q[d] = bf2f(FQ[mq * 512 + h * 64 + d]); o[d] = 0.f; }
    const float ct = C2S[(size_t)bh * 4096 + tq];
    float mr = -INFINITY, l = 0.f;
    const int ntile = (qb * 256 + 256) / 64;
    for (int kt = 0; kt < ntile; ++kt) {
        __syncthreads();
        for (int e = t; e < 4096; e += 256) { const int j = e >> 6, d = e & 63; const size_t mk = (size_t)b * 4096 + kt * 64 + j; sk[j][d] = bf2f(FK[mk * 512 + h * 64 + d]); sv[j][d] = bf2f(FV[mk * 512 + h * 64 + d]); }
        if (t < 64) sc[t] = C2S[(size_t)bh * 4096 + kt * 64 + t];
        __syncthreads();
        for (int j = 0; j < 64; ++j) {
            const int s = kt * 64 + j;
            if (s <= tq) {
                float dot = 0.f;
#pragma unroll
                for (int d = 0; d < 64; ++d) dot += q[d] * sk[j][d];
                const float lg = dot + ct - sc[j];
                const float mn = fmaxf(mr, lg), sc_ = exp2f(mr - mn), p = exp2f(lg - mn);
                l = l * sc_ + p;
#pragma unroll
                for (int d = 0; d < 64; ++d) o[d] = o[d] * sc_ + p * sv[j][d];
                mr = mn;
            }
        }
    }
    const float il = 1.f / l;
#pragma unroll
    for (int d = 0; d < 64; ++d) OGF[mq * 1024 + 512 + h * 64 + d] = f2bf(o[d] * il);
}
__global__ void __launch_bounds__(256) k_merge(const float* C1, const float* C2, const bf16_t* SG, const bf16_t* SF, bf16_t* Y, int row0, int n) {
    const int i = blockIdx.x * 256 + threadIdx.x; if (i >= n) return; const size_t g = (size_t)row0 * 1024 + i;
    Y[g] = f2bf(bf2f(SG[g]) * C1[i] + bf2f(SF[g]) * C2[i]);
}
__global__ void __launch_bounds__(256) k_resid(const float* base, const float* C, float* out, int row0, int n) {
    const int i = blockIdx.x * 256 + threadIdx.x; if (i >= n) return; const size_t g = (size_t)row0 * 1024 + i;
    out[g] = base[g] + C[i];
}
__device__ __forceinline__ float gelu_tanh_(float x) { return 0.5f * x * (1.f + tanhf(0.7978845608028654f * (x + 0.044715f * x * x * x))); }
__global__ void __launch_bounds__(256) k_conv_gelu(const float* U, int row0, int rows, const float* cw, const float* cb, bf16_t* HM) {
    const size_t i = (size_t)blockIdx.x * 256 + threadIdx.x; if (i >= (size_t)rows * 2816) return;
    const int r = (int)(i / 2816), c = (int)(i % 2816); const int tok = (row0 + r) & 4095;
    const float a0 = U[(size_t)r * 5632 + c], a1 = tok >= 1 ? U[(size_t)(r - 1) * 5632 + c] : 0.f, a2 = tok >= 2 ? U[(size_t)(r - 2) * 5632 + c] : 0.f;
    const float cv = cb[c] + cw[c] * a2 + cw[2816 + c] * a1 + cw[2 * 2816 + c] * a0;
    HM[((size_t)row0 + r) * 2816 + c] = f2bf(gelu_tanh_(cv) * U[(size_t)r * 5632 + 2816 + c]);
}
}
static void gold_forward(void* const* d_in, float* out, unsigned char* ws, hipStream_t st, int s_lo, int s_hi, int gm1 = 15) {
    const float* x = (const float*)d_in[0];
    bf16_t* A = (bf16_t*)(ws + WS_A); bf16_t *GQ = (bf16_t*)(ws + WS_GQ), *GK = (bf16_t*)(ws + WS_GK), *GV = (bf16_t*)(ws + WS_GV), *GR = (bf16_t*)(ws + WS_GR);
    bf16_t *FQ = (bf16_t*)(ws + WS_FQ), *FK = (bf16_t*)(ws + WS_FK), *FV = (bf16_t*)(ws + WS_FV), *SG = (bf16_t*)(ws + WS_SG), *SF = (bf16_t*)(ws + WS_SF);
    float *GLR = (float*)(ws + WS_GLR), *LF2 = (float*)(ws + WS_LF2), *C2S = (float*)(ws + WS_C2S), *C1 = (float*)(ws + WS_C), *C2 = (float*)(ws + WS_C + 32 * MiB);
    bf16_t *Y = (bf16_t*)(ws + WS_Y), *HM = (bf16_t*)(ws + WS_HM);
    const int CH = 8192, NCH = M_TOK / CH;
#define ST(k) (s_lo <= (k) && (k) < s_hi)
    if (ST(0)) gold::k_rmsnorm_bf16<<<M_TOK / 4, 256, 0, st>>>(x, (const float*)d_in[1], A, M_TOK);
    if (ST(1)) for (int c = 0; c < NCH; ++c) {
        gold::k_gemm<<<dim3((INC + 63) / 64, CH / 64), 256, 0, st>>>(A + (size_t)c * CH * 1024, 1024, (const float*)d_in[2], INC, C1, INC, INC, 1024);
        gold::k_inproj_epi<<<CH, 256, 0, st>>>(C1, c * CH, (const float*)d_in[6], (const float*)d_in[7], (const float*)d_in[8], (const float*)d_in[9], GQ, GK, GV, GR, GLR, FQ, FK, FV, LF2, SG, SF, gm1);
    }
    if (ST(2)) gold::k_gla<<<64, 256, 0, st>>>(GQ, GK, GV, GR, GLR, (const float*)d_in[3], (const float*)d_in[4], (const float*)d_in[5], A);
    if (ST(3)) { gold::k_cumsum<<<128, 64, 0, st>>>(LF2, C2S); gold::k_fox<<<dim3(16, 128), 256, 0, st>>>(FQ, FK, FV, C2S, A); }
    if (ST(4)) for (int c = 0; c < NCH; ++c) {
        gold::k_gemm<<<dim3(16, CH / 64), 256, 0, st>>>(A + (size_t)c * CH * 1024, 1024, (const float*)d_in[10], 1024, C1, 1024, 1024, 512);
        gold::k_gemm<<<dim3(16, CH / 64), 256, 0, st>>>(A + (size_t)c * CH * 1024 + 512, 1024, (const float*)d_in[11], 1024, C2, 1024, 1024, 512);
        gold::k_merge<<<CH * 1024 / 256, 256, 0, st>>>(C1, C2, SG, SF, Y, c * CH, CH * 1024);
    }
    if (ST(5)) for (int c = 0; c < NCH; ++c) {
        gold::k_gemm<<<dim3(16, CH / 64), 256, 0, st>>>(Y + (size_t)c * CH * 1024, 1024, (const float*)d_in[12], 1024, C1, 1024, 1024, 1024);
        gold::k_resid<<<CH * 1024 / 256, 256, 0, st>>>(x, C1, out, c * CH, CH * 1024);
    }
    if (ST(6)) gold::k_rmsnorm_bf16<<<M_TOK / 4, 256, 0, st>>>(out, (const float*)d_in[13], A, M_TOK);
    if (ST(7)) for (int c = 0; c < NCH; ++c) {
        gold::k_gemm<<<dim3(5632 / 64, CH / 64), 256, 0, st>>>(A + (size_t)c * CH * 1024, 1024, (const float*)d_in[14], 5632, C1, 5632, 5632, 1024);
        gold::k_conv_gelu<<<(unsigned)(((size_t)CH * 2816 + 255) / 256), 256, 0, st>>>(C1, c * CH, CH, (const float*)d_in[15], (const float*)d_in[16], HM);
    }
    if (ST(8)) for (int c = 0; c < NCH; ++c) {
        gold::k_gemm<<<dim3(16, CH / 64), 256, 0, st>>>(HM + (size_t)c * CH * 2816, 2816, (const float*)d_in[17], 1024, C1, 1024, 1024, 2816);
        gold::k_resid<<<CH * 1024 / 256, 256, 0, st>>>(out, C1, out, c * CH, CH * 1024);
    }
    if (ST(9)) gold::k_rmsnorm_f32<<<M_TOK / 4, 256, 0, st>>>(out, (const float*)d_in[18], M_TOK);
#undef ST
}
namespace pg8 {
#define PG8_LAS __attribute__((address_space(3)))
typedef unsigned short bf16_t;
typedef short bf16x8 __attribute__((ext_vector_type(8)));
typedef float f32x4 __attribute__((ext_vector_type(4)));
typedef unsigned u32x4 __attribute__((ext_vector_type(4)));
constexpr int BM = 256, BK = 64, HALF = 128, HTB = HALF * BK * 2  , STAGE_BYTES = 8 * HTB, NXCD = 8, WGM = 8;

__host__ __device__ __forceinline__ int lds_byte(int r, int c) { const int st = (r >> 4) * 2 + (c >> 5), rr = r & 15, cc = c & 31, ob = rr * 64 + cc * 2; return st * 1024 + (ob ^ (((ob >> 9) & 1) << 5)); }
__host__ __device__ __forceinline__ void stage_rc(int b, int& R, int& C) { const int st = b / 1024, sb = b % 1024, swz = sb ^ (((sb >> 9) & 1) << 5); R = (st >> 1) * 16 + swz / 64; C = (st & 1) * 32 + (swz % 64) / 2; }
__host__ __device__ __forceinline__ int perm32(int rho) { const int n = rho >> 4, i = rho & 15; return 8 * (i >> 2) + 4 * n + (i & 3); }

struct Unit { int pm, pn; };
struct Gemm { const bf16_t* A; const bf16_t* Bt; int M, N, K; };

struct StaticOrder {
    int nM, nN, nwg, G, c;
    __host__ __device__ void init(int M, int N, int G_, int c_) { nM = M / BM; nN = N / BM; nwg = nM * nN; G = G_; c = c_; }
    __host__ __device__ bool next(int i, Unit& u) const {
        const long L = (long)i * G + c; if (L >= nwg) return false;
        int wgid = (int)L; { const int q = nwg / NXCD, r = nwg % NXCD, xcd = wgid % NXCD, off = wgid / NXCD; wgid = (xcd < r ? xcd * (q + 1) : r * (q + 1) + (xcd - r) * q) + off; }
        const int nig = WGM * nN, gid = wgid / nig, fm = gid * WGM, gsz = (nM - fm) < WGM ? (nM - fm) : WGM;
        u.pm = fm + ((wgid % nig) % gsz); u.pn = (wgid % nig) / gsz; return true;
    }
    __device__ __forceinline__ void a_ready(const Unit&) const {}
    __device__ __forceinline__ void done(const Unit&) const {}
};

typedef float f32x2 __attribute__((ext_vector_type(2))); typedef __bf16 bf16x2_t __attribute__((ext_vector_type(2)));
__device__ __forceinline__ unsigned cvt_pk_bf16(float lo, float hi) { f32x2 v = {lo, hi}; bf16x2_t b = __builtin_convertvector(v, bf16x2_t); return __builtin_bit_cast(unsigned, b); }
template <class Epi, class Sched, bool ALIGN_EPI = false, bool SP2 = false>
__device__ __forceinline__ void gemm_phase(PG8_LAS unsigned char* lds, const Gemm g, const Sched& S, const Epi& E) {
    const int tid = threadIdx.x, wid = __builtin_amdgcn_readfirstlane(tid >> 6), lane = tid & 63, wr = wid >> 2, wc = wid & 3, fr = lane & 15, fq = lane >> 4;
    const int K = g.K, nt = K / BK;
    unsigned voffA[2], voffB[2];
#pragma unroll
    for (int i = 0; i < 2; ++i) { int R, C; stage_rc(tid * 16 + i * 8192, R, C); const int Rb = Epi::PERM ? ((R & ~31) + perm32(R & 31)) : R;
        voffA[i] = (unsigned)(R * K + C) * 2u; voffB[i] = (unsigned)(Rb * K + C) * 2u; }
    const size_t kstep = (size_t)(BK * 2);
    const size_t hstep = (size_t)HALF * K * 2;
    const size_t tstep = 2 * hstep;
    const unsigned ldsw = (unsigned)wid * 1024u;
    const int aoff = lds_byte(wr * 64 + fr, fq * 8), boff = lds_byte(wc * 32 + fr, fq * 8);
#define PG8_SA(b, h) (((b) * 2 + (h)) * HTB)
#define PG8_SB(b, h) ((4 + (b) * 2 + (h)) * HTB)
#define PG8_STAGE(bufoff, gbase, voff) do { _Pragma("unroll") for (int _i = 0; _i < 2; ++_i) \
        __builtin_amdgcn_global_load_lds((const unsigned*)((const char*)(gbase) + (voff)[_i]), (PG8_LAS unsigned*)(lds + (bufoff) + ldsw + _i * 8192), 16, 0, 0); } while (0)
#define PG8_LDA(dst, b, h) do { _Pragma("unroll") for (int m = 0; m < 4; ++m) _Pragma("unroll") for (int k = 0; k < 2; ++k) dst[m][k] = *(const PG8_LAS bf16x8*)(lds + PG8_SA(b, h) + aoff + m * 2048 + k * 1024); } while (0)
#define PG8_LDB(dst, b, h) do { _Pragma("unroll") for (int n = 0; n < 2; ++n) _Pragma("unroll") for (int k = 0; k < 2; ++k) dst[n][k] = *(const PG8_LAS bf16x8*)(lds + PG8_SB(b, h) + boff + n * 2048 + k * 1024); } while (0)
#define PG8_MMA(ai, bj, At, Bt) do { __builtin_amdgcn_s_setprio(1); _Pragma("unroll") for (int m = 0; m < 4; ++m) _Pragma("unroll") for (int n = 0; n < 2; ++n) _Pragma("unroll") for (int k = 0; k < 2; ++k) \
        acc[ai][bj][m][n] = __builtin_amdgcn_mfma_f32_16x16x32_bf16(Bt[n][k], At[m][k], acc[ai][bj][m][n], 0, 0, 0); __builtin_amdgcn_s_setprio(0); } while (0)
#define PG8_WAIT_V(n) asm volatile("s_waitcnt vmcnt(" #n ")" ::: "memory")
#define PG8_WAIT_L(n) asm volatile("s_waitcnt lgkmcnt(" #n ")" ::: "memory")
#define PG8_BAR __builtin_amdgcn_s_barrier()
#define PG8_SCHED __builtin_amdgcn_sched_barrier(0)
    Unit cur, nxt; int ui = 0;
    if (!S.next(0, cur)) return;
    f32x4 acc[2][2][4][2];
#pragma unroll
    for (int a = 0; a < 2; ++a)
#pragma unroll
        for (int b = 0; b < 2; ++b)
#pragma unroll
            for (int m = 0; m < 4; ++m)
#pragma unroll
                for (int n = 0; n < 2; ++n) acc[a][b][m][n] = (f32x4){0.f, 0.f, 0.f, 0.f};
    bf16x8 At[4][2], B0[2][2], B1[2][2];
    const char* cA = (const char*)g.A + (size_t)cur.pm * tstep; const char* cB = (const char*)g.Bt + (size_t)cur.pn * tstep;
    S.a_ready(cur);
    if constexpr (SP2) {
        PG8_STAGE(PG8_SB(0, 0), cB, voffB); PG8_STAGE(PG8_SB(0, 1), cB + hstep, voffB); PG8_STAGE(PG8_SA(0, 0), cA, voffA); PG8_STAGE(PG8_SA(0, 1), cA + hstep, voffA);
        if (wr == 1) PG8_BAR;
        PG8_WAIT_V(2); PG8_BAR;
        PG8_STAGE(PG8_SB(1, 0), cB + kstep, voffB); PG8_STAGE(PG8_SA(1, 0), cA + kstep, voffA); PG8_STAGE(PG8_SB(1, 1), cB + hstep + kstep, voffB);
        PG8_WAIT_V(6); PG8_BAR;
    } else {
        PG8_STAGE(PG8_SB(0, 0), cB, voffB); PG8_STAGE(PG8_SA(0, 0), cA, voffA); PG8_STAGE(PG8_SB(0, 1), cB + hstep, voffB); PG8_STAGE(PG8_SA(0, 1), cA + hstep, voffA);
        if (wr == 1) PG8_BAR;
        PG8_WAIT_V(4); PG8_BAR;
        PG8_STAGE(PG8_SB(1, 0), cB + kstep, voffB); PG8_STAGE(PG8_SA(1, 0), cA + kstep, voffA); PG8_STAGE(PG8_SB(1, 1), cB + hstep + kstep, voffB);
        PG8_WAIT_V(6); PG8_BAR;
    }
    for (;;) {
        const bool has_next = S.next(ui + 1, nxt);
        const char* nA = has_next ? (const char*)g.A + (size_t)nxt.pm * tstep : cA; const char* nB = has_next ? (const char*)g.Bt + (size_t)nxt.pn * tstep : cB;
        for (int t = 0; t < nt; t += 2) {
            if constexpr (Epi::MIDK) { if (t == nt / 2) { PG8_SCHED; E.mid(acc, cur, wr, wc, fr, fq); PG8_SCHED; } }
            const bool last = (t == nt - 2);
            const char* a1 = cA + (size_t)(t + 1) * kstep;
            const char* a2 = last ? nA : cA + (size_t)(t + 2) * kstep; const char* b2 = last ? nB : cB + (size_t)(t + 2) * kstep;
            const char* a3 = a2 + kstep; const char* b3 = b2 + kstep;
            if (last && has_next) S.a_ready(nxt);
            if constexpr (SP2) {
            PG8_LDB(B0, 0, 0); PG8_LDB(B1, 0, 1); PG8_SCHED; PG8_LDA(At, 0, 0); PG8_STAGE(PG8_SA(1, 1), a1 + hstep, voffA);
            PG8_WAIT_V(8); PG8_WAIT_L(0); PG8_BAR; PG8_MMA(0, 0, At, B0); PG8_MMA(0, 1, At, B1); PG8_BAR; PG8_SCHED;
            PG8_LDA(At, 0, 1); PG8_STAGE(PG8_SB(0, 0), b2, voffB); PG8_STAGE(PG8_SB(0, 1), b2 + hstep, voffB); PG8_STAGE(PG8_SA(0, 0), a2, voffA);
            PG8_WAIT_V(8); PG8_WAIT_L(0); PG8_BAR; PG8_MMA(1, 0, At, B0); PG8_MMA(1, 1, At, B1); PG8_BAR; PG8_SCHED;
            PG8_LDB(B0, 1, 0); PG8_LDB(B1, 1, 1); PG8_SCHED; PG8_LDA(At, 1, 0); PG8_STAGE(PG8_SA(0, 1), a2 + hstep, voffA);
            PG8_WAIT_V(8); PG8_WAIT_L(0); PG8_BAR; PG8_MMA(0, 0, At, B0); PG8_MMA(0, 1, At, B1); PG8_BAR; PG8_SCHED;
            PG8_LDA(At, 1, 1); PG8_STAGE(PG8_SB(1, 0), b3, voffB); PG8_STAGE(PG8_SB(1, 1), b3 + hstep, voffB); PG8_STAGE(PG8_SA(1, 0), a3, voffA);
            PG8_WAIT_V(8); PG8_WAIT_L(0); PG8_BAR; PG8_MMA(1, 0, At, B0); PG8_MMA(1, 1, At, B1); PG8_BAR; PG8_SCHED;
            } else {
            PG8_LDB(B0, 0, 0); PG8_SCHED; PG8_LDA(At, 0, 0); PG8_STAGE(PG8_SA(1, 1), a1 + hstep, voffA);
            PG8_WAIT_L(8); PG8_BAR; PG8_WAIT_L(0); PG8_MMA(0, 0, At, B0); PG8_BAR; PG8_SCHED;
            PG8_LDB(B1, 0, 1); PG8_STAGE(PG8_SB(0, 0), b2, voffB);
            PG8_BAR; PG8_WAIT_L(0); PG8_MMA(0, 1, At, B1); PG8_BAR;
            PG8_LDA(At, 0, 1); PG8_STAGE(PG8_SA(0, 0), a2, voffA);
            PG8_BAR; PG8_WAIT_L(0); PG8_MMA(1, 0, At, B0); PG8_BAR; PG8_SCHED;
            PG8_STAGE(PG8_SB(0, 1), b2 + hstep, voffB);
            PG8_WAIT_V(6); PG8_BAR; PG8_MMA(1, 1, At, B1); PG8_BAR;
            PG8_LDB(B0, 1, 0); PG8_SCHED; PG8_LDA(At, 1, 0); PG8_STAGE(PG8_SA(0, 1), a2 + hstep, voffA);
            PG8_WAIT_L(8); PG8_BAR; PG8_WAIT_L(0); PG8_MMA(0, 0, At, B0); PG8_BAR; PG8_SCHED;
            PG8_LDB(B1, 1, 1); PG8_STAGE(PG8_SB(1, 0), b3, voffB);
            PG8_BAR; PG8_WAIT_L(0); PG8_MMA(0, 1, At, B1); PG8_BAR;
            PG8_LDA(At, 1, 1); PG8_STAGE(PG8_SA(1, 0), a3, voffA);
            PG8_BAR; PG8_WAIT_L(0); PG8_MMA(1, 0, At, B0); PG8_BAR; PG8_SCHED;
            PG8_STAGE(PG8_SB(1, 1), b3 + hstep, voffB);
            PG8_WAIT_V(6); PG8_BAR; PG8_MMA(1, 1, At, B1); PG8_BAR;
            }
        }
        if constexpr (ALIGN_EPI) { if (wr == 0) PG8_BAR; }
        if constexpr (!Epi::AFTER_DRAIN) { E(acc, cur, wr, wc, fr, fq); S.done(cur); }
        if (!has_next) break;
#pragma unroll
        for (int a = 0; a < 2; ++a)
#pragma unroll
            for (int b = 0; b < 2; ++b)
#pragma unroll
                for (int m = 0; m < 4; ++m)
#pragma unroll
                    for (int n = 0; n < 2; ++n) acc[a][b][m][n] = (f32x4){0.f, 0.f, 0.f, 0.f};
        cur = nxt; cA = nA; cB = nB; ++ui;
        if constexpr (ALIGN_EPI) { if (wr == 1) PG8_BAR; }
    }
    PG8_WAIT_V(0);
    if constexpr (!ALIGN_EPI) { if (wr == 0) PG8_BAR; }
    PG8_BAR;
    if constexpr (Epi::AFTER_DRAIN) { E.fused(acc, cur, wr, wc, fr, fq, lds, wid, lane); S.done(cur); }
#undef PG8_SA
#undef PG8_SB
#undef PG8_STAGE
#undef PG8_LDA
#undef PG8_LDB
#undef PG8_MMA
#undef PG8_WAIT_V
#undef PG8_WAIT_L
#undef PG8_BAR
#undef PG8_SCHED
}
}
namespace pg8 {
typedef unsigned u32x2 __attribute__((ext_vector_type(2)));
__device__ __forceinline__ u32x4 pack8(f32x4 a, f32x4 b) { u32x4 w; w.x = cvt_pk_bf16(a[0], a[1]); w.y = cvt_pk_bf16(a[2], a[3]); w.z = cvt_pk_bf16(b[0], b[1]); w.w = cvt_pk_bf16(b[2], b[3]); return w; }
__device__ __forceinline__ float bflo(unsigned w) { return __uint_as_float(w << 16); }
__device__ __forceinline__ float bfhi(unsigned w) { return __uint_as_float(w & 0xffff0000u); }
__device__ __forceinline__ void unpack8(u32x4 w, f32x4& a, f32x4& b) { a = (f32x4){bflo(w.x), bfhi(w.x), bflo(w.y), bfhi(w.y)}; b = (f32x4){bflo(w.z), bfhi(w.z), bflo(w.w), bfhi(w.w)}; }
__device__ __forceinline__ float fast_sigmoid(float z) { return __builtin_amdgcn_rcpf(1.f + __builtin_amdgcn_exp2f(-LOG2E * z)); }
__device__ __forceinline__ f32x4 sig4(f32x4 z) { return (f32x4){fast_sigmoid(z[0]), fast_sigmoid(z[1]), fast_sigmoid(z[2]), fast_sigmoid(z[3])}; }
__device__ __forceinline__ float logsig(float z) { return fminf(z, 0.f) - log1pf(expf(-fabsf(z))); }

struct EpiInProj {
    static constexpr bool PERM = true, AFTER_DRAIN = false, MIDK = false;
    bf16_t *GQ, *GK, *GV, *GR, *FQ, *FK, *FV, *SG, *SF; float *GLR, *LF2; const float *fb, *qg, *kg, *gate_b;
    __device__ __forceinline__ void operator()(const f32x4 (&acc)[2][2][4][2], const Unit& u, int wr, int wc, int fr, int fq) const {
        const int pn = u.pn; const size_t row0 = (size_t)u.pm * BM + wr * 64 + fr; const int qc = 64 * wc + 8 * fq;
        if (pn < 6 || pn == 10 || pn == 11) {
            bf16_t* base; int ld, col0; float sc = 1.f;
            if (pn == 0) { base = GQ; ld = 256; col0 = 0; sc = 0.125f; } else if (pn == 1) { base = GK; ld = 256; col0 = 0; }
            else if (pn < 4) { base = GV; ld = 512; col0 = 256 * (pn - 2); } else if (pn < 6) { base = GR; ld = 512; col0 = 256 * (pn - 4); } else { base = FV; ld = 512; col0 = 256 * (pn - 10); }
#pragma unroll
            for (int ai = 0; ai < 2; ++ai)
#pragma unroll
                for (int m = 0; m < 4; ++m) { bf16_t* rp = base + (row0 + ai * HALF + m * 16) * ld + col0 + qc;
#pragma unroll
                    for (int bj = 0; bj < 2; ++bj) *(u32x4*)(rp + 32 * bj) = pack8(acc[ai][bj][m][0] * sc, acc[ai][bj][m][1] * sc); }
        } else if (pn < 10) {
            const bool isq = pn < 8; bf16_t* base = isq ? FQ : FK; const float* g = isq ? qg : kg; const int head = 4 * ((pn - 6) & 1) + wc; const float osc = isq ? QSCALE2 : 1.f;
            f32x4 gv[2][2];
#pragma unroll
            for (int bj = 0; bj < 2; ++bj)
#pragma unroll
                for (int n = 0; n < 2; ++n) gv[bj][n] = *(const f32x4*)(g + 32 * bj + 8 * fq + 4 * n);
#pragma unroll
            for (int ai = 0; ai < 2; ++ai)
#pragma unroll
                for (int m = 0; m < 4; ++m) { float ss = 0.f;
#pragma unroll
                    for (int bj = 0; bj < 2; ++bj)
#pragma unroll
                        for (int n = 0; n < 2; ++n) { const f32x4 x = acc[ai][bj][m][n]; ss += (x[0] * x[0] + x[1] * x[1]) + (x[2] * x[2] + x[3] * x[3]); }
                    ss += __shfl_xor(ss, 16); ss += __shfl_xor(ss, 32);
                    const float rs = rsqrtf(ss * (1.f / 64.f) + 1e-6f) * osc;
                    bf16_t* rp = base + (row0 + ai * HALF + m * 16) * 512 + 64 * head + 8 * fq;
#pragma unroll
                    for (int bj = 0; bj < 2; ++bj) *(u32x4*)(rp + 32 * bj) = pack8(acc[ai][bj][m][0] * rs * gv[bj][0], acc[ai][bj][m][1] * rs * gv[bj][1]); }
        } else if (pn < 20) {
            const bool isg = pn < 16; bf16_t* base = isg ? SG : SF; const int col0 = 256 * ((pn - 12) & 3); const float* gb = gate_b + (isg ? 0 : 1024) + col0 + qc;
            f32x4 bv[2][2];
#pragma unroll
            for (int bj = 0; bj < 2; ++bj)
#pragma unroll
                for (int n = 0; n < 2; ++n) bv[bj][n] = *(const f32x4*)(gb + 32 * bj + 4 * n);
#pragma unroll
            for (int ai = 0; ai < 2; ++ai)
#pragma unroll
                for (int m = 0; m < 4; ++m) { bf16_t* rp = base + (row0 + ai * HALF + m * 16) * 1024 + col0 + qc;
#pragma unroll
                    for (int bj = 0; bj < 2; ++bj) *(u32x4*)(rp + 32 * bj) = pack8(sig4(acc[ai][bj][m][0] + bv[bj][0]), sig4(acc[ai][bj][m][1] + bv[bj][1])); }
        } else {
            if (wc == 0 && fq < 3) {
                const f32x4 f0 = *(const f32x4*)fb, f1 = *(const f32x4*)(fb + 4);
#pragma unroll
                for (int ai = 0; ai < 2; ++ai)
#pragma unroll
                    for (int m = 0; m < 4; ++m) { const size_t row = row0 + ai * HALF + m * 16; const f32x4 v0 = acc[ai][0][m][0], v1 = acc[ai][0][m][1];
                        if (fq < 2) { *(f32x4*)(GLR + row * 16 + 8 * fq) = v0; *(f32x4*)(GLR + row * 16 + 8 * fq + 4) = v1; }
                        else { f32x4 o0, o1;
#pragma unroll
                            for (int i = 0; i < 4; ++i) { o0[i] = logsig(v0[i] + f0[i]) * LOG2E; o1[i] = logsig(v1[i] + f1[i]) * LOG2E; }
                            *(f32x4*)(LF2 + row * 8) = o0; *(f32x4*)(LF2 + row * 8 + 4) = o1; } }
            }
        }
    }
};
struct EpiMerge {
    static constexpr bool PERM = true, AFTER_DRAIN = false, MIDK = true;
    const bf16_t *SG, *SF; bf16_t* Y;
    __device__ __forceinline__ void mid(f32x4 (&acc)[2][2][4][2], const Unit& u, int wr, int wc, int fr, int fq) const {
        asm volatile("" : "+v"(fr), "+v"(fq));
        const size_t row0 = (size_t)u.pm * BM + wr * 64 + fr; const int col = u.pn * BM + 64 * wc + 8 * fq;
#pragma unroll
        for (int ai = 0; ai < 2; ++ai)
#pragma unroll
            for (int m = 0; m < 4; ++m) { const size_t off = (row0 + ai * HALF + m * 16) * 1024 + col;
#pragma unroll
                for (int bj = 0; bj < 2; ++bj) { f32x4 g0, g1, s0, s1; unpack8(*(const u32x4*)(SG + off + 32 * bj), g0, g1); unpack8(*(const u32x4*)(SF + off + 32 * bj), s0, s1);
#pragma unroll
                    for (int i = 0; i < 4; ++i) { acc[ai][bj][m][0][i] *= g0[i] * __builtin_amdgcn_rcpf(s0[i]); acc[ai][bj][m][1][i] *= g1[i] * __builtin_amdgcn_rcpf(s1[i]); } }
                asm volatile("" : "+v"(acc[ai][0][m][0]), "+v"(acc[ai][0][m][1]), "+v"(acc[ai][1][m][0]), "+v"(acc[ai][1][m][1]));
                if (m & 1) asm volatile("" ::: "memory"); }
    }
    __device__ __forceinline__ void operator()(const f32x4 (&acc)[2][2][4][2], const Unit& u, int wr, int wc, int fr, int fq) const {
        const size_t row0 = (size_t)u.pm * BM + wr * 64 + fr; const int col = u.pn * BM + 64 * wc + 8 * fq;
#pragma unroll
        for (int ai = 0; ai < 2; ++ai)
#pragma unroll
            for (int m = 0; m < 4; ++m) { const size_t off = (row0 + ai * HALF + m * 16) * 1024 + col;
#pragma unroll
                for (int bj = 0; bj < 2; ++bj) { f32x4 s0, s1; unpack8(*(const u32x4*)(SF + off + 32 * bj), s0, s1); *(u32x4*)(Y + off + 32 * bj) = pack8(acc[ai][bj][m][0] * s0, acc[ai][bj][m][1] * s1); } }
    }
};
struct EpiResid {
    static constexpr bool PERM = true, AFTER_DRAIN = false, MIDK = false;
    const float* base; float* out;
    __device__ __forceinline__ void operator()(const f32x4 (&acc)[2][2][4][2], const Unit& u, int wr, int wc, int fr, int fq) const {
        const size_t row0 = (size_t)u.pm * BM + wr * 64 + fr; const int col = u.pn * BM + 64 * wc + 8 * fq;
#pragma unroll
        for (int ai = 0; ai < 2; ++ai)
#pragma unroll
            for (int m = 0; m < 4; ++m) { const size_t off = (row0 + ai * HALF + m * 16) * 1024 + col;
#pragma unroll
                for (int bj = 0; bj < 2; ++bj)
#pragma unroll
                    for (int n = 0; n < 2; ++n) { const f32x4 b = *(const f32x4*)(base + off + 32 * bj + 4 * n); *(f32x4*)(out + off + 32 * bj + 4 * n) = b + acc[ai][bj][m][n]; } }
    }
};
template <int CTRL> __device__ __forceinline__ float dppmov(float v) { return __builtin_bit_cast(float, __builtin_amdgcn_update_dpp(0, __builtin_bit_cast(int, v), CTRL, 0xf, 0xf, false)); }
__device__ __forceinline__ float gelu_tanh_fast(float x) { const float u = x * (1.f + 0.044715f * x * x); return x * __builtin_amdgcn_rcpf(1.f + __builtin_amdgcn_exp2f(-1.5957691216057308f * LOG2E * u)); }
struct EpiUp {
    static constexpr bool PERM = true, AFTER_DRAIN = false, MIDK = false;
    bf16_t* HM; float* EDGE; const float *cw, *cb;
    __device__ __forceinline__ void operator()(const f32x4 (&acc)[2][2][4][2], const Unit& u, int wr, int wc, int fr, int fq) const {
        const int ch0 = 128 * u.pn + 32 * wc + 8 * fq;
        f32x4 w0[2], w1[2], w2[2], bb[2];
#pragma unroll
        for (int n = 0; n < 2; ++n) { w0[n] = *(const f32x4*)(cw + ch0 + 4 * n); w1[n] = *(const f32x4*)(cw + 2816 + ch0 + 4 * n); w2[n] = *(const f32x4*)(cw + 5632 + ch0 + 4 * n); bb[n] = *(const f32x4*)(cb + ch0 + 4 * n); }
#pragma unroll
        for (int ai = 0; ai < 2; ++ai) {
            const size_t rowg = (size_t)u.pm * BM + ai * HALF + wr * 64;
            float* eg = EDGE + (rowg >> 6) * (size_t)(6 * 2816) + ch0;
            if (fr < 2) {
#pragma unroll
                for (int n = 0; n < 2; ++n) { *(f32x4*)(eg + fr * 2816 + 4 * n) = acc[ai][0][0][n]; *(f32x4*)(eg + (4 + fr) * 2816 + 4 * n) = acc[ai][1][0][n]; } }
            if (fr >= 14) {
#pragma unroll
                for (int n = 0; n < 2; ++n) *(f32x4*)(eg + (fr - 12) * 2816 + 4 * n) = acc[ai][0][3][n]; }
#pragma unroll
            for (int m = 0; m < 4; ++m) { f32x4 h[2];
#pragma unroll
                for (int n = 0; n < 2; ++n)
#pragma unroll
                    for (int i = 0; i < 4; ++i) { const float a0 = acc[ai][0][m][n][i];
                        float a1 = dppmov<0x111>(a0), a2 = dppmov<0x112>(a0);
                        if (m > 0) { const float p = acc[ai][0][m - 1][n][i]; const float p1 = dppmov<0x121>(p), p2 = dppmov<0x122>(p);
                            a1 = fr == 0 ? p1 : a1; a2 = fr < 2 ? p2 : a2; }
                        const float cv = bb[n][i] + w0[n][i] * a2 + w1[n][i] * a1 + w2[n][i] * a0;
                        h[n][i] = gelu_tanh_fast(cv) * acc[ai][1][m][n][i]; }
                *(u32x4*)(HM + (rowg + m * 16 + fr) * 2816 + ch0) = pack8(h[0], h[1]); }
        }
    }
};
}
#define GAS __attribute__((address_space(1)))
#define LAS __attribute__((address_space(3)))
typedef unsigned v4u __attribute__((ext_vector_type(4)));
typedef float f32x4 __attribute__((ext_vector_type(4)));
typedef short bf16x8 __attribute__((ext_vector_type(8)));
typedef GAS unsigned gu32;
typedef GAS unsigned long long gu64;
#define RLX_AGENT __ATOMIC_RELAXED, __HIP_MEMORY_SCOPE_AGENT
#define LDS_WAIT() asm volatile("s_waitcnt lgkmcnt(0)" ::: "memory")
#define VM_WAIT() asm volatile("s_waitcnt vmcnt(0)" ::: "memory")
__device__ __forceinline__ unsigned long long rt() { return __builtin_amdgcn_s_memrealtime(); }
__device__ __forceinline__ unsigned pk2(float lo, float hi) { return (unsigned)f2bf(lo) | ((unsigned)f2bf(hi) << 16); }
#define XB_TMO      128
#define XB_XCNT(j)  (256  + 64 * (j))
#define XB_XSUB(j)  (1280 + 64 * (j))
#define XB_XGEN(j)  (2304 + 64 * (j))
#define XB_TOP      3328
#define XB_TOPGEN   3392
#define XCD_BAR_WORDS 3456
#define XB_SPIN_CAP (1u << 18)

__device__ __forceinline__ unsigned xb_ld(unsigned* p)              { return __hip_atomic_load(p, __ATOMIC_RELAXED, __HIP_MEMORY_SCOPE_AGENT); }
__device__ __forceinline__ unsigned xb_add(unsigned* p, unsigned v) { return __hip_atomic_fetch_add(p, v, __ATOMIC_RELAXED, __HIP_MEMORY_SCOPE_AGENT); }
__device__ __forceinline__ unsigned xb_xcc_id() { return (unsigned)__builtin_amdgcn_s_getreg((3 << 11) | 20) & 0xFu; }
#define XB_SPIN(cond, bar) do { unsigned _sp = 0; while (cond) { __builtin_amdgcn_s_sleep(1); \
    if ((++_sp & 255u) == 0u) { if (xb_ld(&(bar)[XB_TMO])) break; if (_sp > XB_SPIN_CAP) { atomicAdd(&(bar)[XB_TMO], 1u); break; } } } } while (0)

struct XcdBarrier {
    unsigned* bar; unsigned x;
    volatile LAS unsigned* st;
};

__device__ __forceinline__ XcdBarrier xcd_barrier_post(unsigned* bar, volatile LAS unsigned* st) {
    XcdBarrier b; b.bar = bar; b.x = xb_xcc_id(); b.st = st;
    if (threadIdx.x == 0) (void)xb_add(&bar[XB_XCNT(b.x)], 1u);
    return b;
}
__device__ __forceinline__ void xcd_barrier_complete(unsigned* bar, unsigned x, unsigned& nloc, unsigned& nx) {
    const unsigned G = gridDim.x * gridDim.y * gridDim.z;
    unsigned sum, cnt, mine, sp = 0u;
    for (;;) {
        sum = 0u; cnt = 0u; mine = 0u;
#pragma unroll
        for (unsigned j = 0; j < 16; ++j) { const unsigned c = xb_ld(&bar[XB_XCNT(j)]); sum += c; cnt += (c > 0u) ? 1u : 0u; mine = (j == x) ? c : mine; }
        if (sum == G) break;
        __builtin_amdgcn_s_sleep(1);
        if ((++sp & 255u) == 0u) { if (xb_ld(&bar[XB_TMO])) break; if (sp > XB_SPIN_CAP) { atomicAdd(&bar[XB_TMO], 1u); break; } }
    }
    nloc = mine > 0u ? mine : 1u; nx = cnt > 0u ? cnt : 1u;
}

__device__ __forceinline__ void xcd_barrier(const XcdBarrier& b) {
    asm volatile("s_waitcnt vmcnt(0)" ::: "memory");
    __syncthreads();
    if (threadIdx.x == 0) {
        unsigned* bar = b.bar;
        __builtin_amdgcn_s_waitcnt(0);
        unsigned nloc = b.st[0], nx = b.st[1];
        if (nloc == 0u) { xcd_barrier_complete(bar, b.x, nloc, nx); b.st[0] = nloc; b.st[1] = nx; }
        const unsigned old = xb_add(&bar[XB_XSUB(b.x)], 1u);
        const unsigned gen = old / nloc;
        if (old + 1u == (gen + 1u) * nloc) {
            __builtin_amdgcn_fence(__ATOMIC_RELEASE, "agent");
            asm volatile("s_waitcnt vmcnt(0)" ::: "memory");
            const unsigned og = xb_add(&bar[XB_TOP], 1u);
            const unsigned tg = og / nx;
            if (og + 1u == (tg + 1u) * nx) xb_add(&bar[XB_TOPGEN], 1u);
            else XB_SPIN(xb_ld(&bar[XB_TOPGEN]) == tg, bar);
            __builtin_amdgcn_fence(__ATOMIC_ACQUIRE, "agent");
            xb_add(&bar[XB_XGEN(b.x)], 1u);
            asm volatile("s_waitcnt vmcnt(0)" ::: "memory");
        } else {
            XB_SPIN(xb_ld(&bar[XB_XGEN(b.x)]) == gen, bar);
            __builtin_amdgcn_fence(__ATOMIC_ACQUIRE, "agent");
            asm volatile("s_waitcnt vmcnt(0)" ::: "memory");
        }
    }
    __syncthreads();
}
namespace fox {
using bf16x8 = __attribute__((ext_vector_type(8))) short;
using s16x4 = __attribute__((ext_vector_type(4))) short;
using f32x16 = __attribute__((ext_vector_type(16))) float;
using f32x4 = __attribute__((ext_vector_type(4))) float;
using u32x4 = __attribute__((ext_vector_type(4))) unsigned;
constexpr int SEQL = 4096, PQ = 512, PO = 1024, QB = 256, KVBLK = 64, SLOTB = 8192;
constexpr int LDS_K = 0, LDS_V = 2 * SLOTB, LDS_WS = 4 * SLOTB, LDS_OST = LDS_WS + 8 * 64 * 4, LDS_C2 = LDS_OST + 8 * 4096, LDS_TOT = LDS_C2 + 4096 * 4 + 64;
static_assert(LDS_TOT <= 131072, "fox LDS");
__device__ __forceinline__ int crow(int r, int hi) { return (r & 3) + 8 * (r >> 2) + 4 * hi; }
#define FSBAR() __builtin_amdgcn_sched_barrier(0)
__device__ __forceinline__ void glds16(const void* gsrc, unsigned lds_dst) { unsigned keep;
    asm volatile("s_mov_b32 %0, m0\n\ts_mov_b32 m0, %2\n\ts_nop 0\n\tglobal_load_lds_dwordx4 %1, off\n\ts_mov_b32 m0, %0" : "=&s"(keep) : "v"(gsrc), "s"(lds_dst) : "memory"); }
typedef float f32x2_t __attribute__((ext_vector_type(2))); typedef __bf16 bf16x2_t __attribute__((ext_vector_type(2)));
__device__ __forceinline__ unsigned cvtpk_s(float lo, float hi) { f32x2_t v = {lo, hi}; bf16x2_t b = __builtin_convertvector(v, bf16x2_t); return __builtin_bit_cast(unsigned, b); }
#define FWAIT_BAR(N) asm volatile("s_waitcnt vmcnt(" #N ") lgkmcnt(0)\n\ts_barrier" ::: "memory")
typedef __attribute__((address_space(3))) const char* lds_cptr;
__device__ __forceinline__ void qkt(f32x16& p0, f32x16& p1, lds_cptr Kslot, const bf16x8* qr, const f32x16& c0, const f32x16& c1, int r32, int hi) {
    lds_cptr kb = Kslot + hi * 1024 + r32 * 16;
#pragma unroll
    for (int d0 = 0; d0 < 4; ++d0) {
        const bf16x8 b0 = *(const __attribute__((address_space(3))) bf16x8*)(kb + d0 * 2048);
        const bf16x8 b1 = *(const __attribute__((address_space(3))) bf16x8*)(kb + d0 * 2048 + 512);
        if (d0 == 0) { p0 = __builtin_amdgcn_mfma_f32_32x32x16_bf16(b0, qr[0], c0, 0, 0, 0); p1 = __builtin_amdgcn_mfma_f32_32x32x16_bf16(b1, qr[0], c1, 0, 0, 0); }
        else { p0 = __builtin_amdgcn_mfma_f32_32x32x16_bf16(b0, qr[d0], p0, 0, 0, 0); p1 = __builtin_amdgcn_mfma_f32_32x32x16_bf16(b1, qr[d0], p1, 0, 0, 0); } }
}
__device__ __forceinline__ void pv(f32x16* o, int vb, bf16x8 pa0, bf16x8 pa1, bf16x8 pa2, bf16x8 pa3) {
#pragma unroll
    for (int d0 = 0; d0 < 2; ++d0) { s16x4 lo[4], hi[4];
#pragma unroll
        for (int ks = 0; ks < 4; ++ks) {
            asm volatile("ds_read_b64_tr_b16 %0,%1 offset:%c2" : "=&v"(lo[ks]) : "v"(vb), "i"(d0 * 4096 + ks * 1024) : "memory");
            asm volatile("ds_read_b64_tr_b16 %0,%1 offset:%c2" : "=&v"(hi[ks]) : "v"(vb), "i"(d0 * 4096 + ks * 1024 + 512) : "memory"); }
        asm volatile("s_waitcnt lgkmcnt(0)" ::: "memory"); FSBAR();
#define FPK(k) (bf16x8){lo[k][0], lo[k][1], lo[k][2], lo[k][3], hi[k][0], hi[k][1], hi[k][2], hi[k][3]}
        o[d0] = __builtin_amdgcn_mfma_f32_32x32x16_bf16(pa0, FPK(0), o[d0], 0, 0, 0);
        o[d0] = __builtin_amdgcn_mfma_f32_32x32x16_bf16(pa1, FPK(1), o[d0], 0, 0, 0);
        o[d0] = __builtin_amdgcn_mfma_f32_32x32x16_bf16(pa2, FPK(2), o[d0], 0, 0, 0);
        o[d0] = __builtin_amdgcn_mfma_f32_32x32x16_bf16(pa3, FPK(3), o[d0], 0, 0, 0);
#undef FPK
    }
}
__device__ __forceinline__ void fox_cumsum(const float* LF2, int b, int h, char* shm) {
    float* c2s = (float*)(shm + LDS_C2); float* wtot = (float*)(shm + LDS_WS);
    const int tid = threadIdx.x, lane = tid & 63, wid = tid >> 6;
    const float* p = LF2 + ((size_t)b * SEQL + 8 * tid) * 8 + h;
    float v[8];
#pragma unroll
    for (int j = 0; j < 8; ++j) v[j] = p[8 * j];
#pragma unroll
    for (int j = 1; j < 8; ++j) v[j] += v[j - 1];
    float inc = v[7];
#pragma unroll
    for (int o = 1; o < 64; o <<= 1) { const float u = __shfl_up(inc, o); if (lane >= o) inc += u; }
    if (lane == 63) wtot[wid] = inc;
    __syncthreads();
    float base = inc - v[7];
    for (int w = 0; w < wid; ++w) base += wtot[w];
#pragma unroll
    for (int j = 0; j < 8; ++j) c2s[8 * tid + j] = base + v[j];
    __syncthreads();
}
__device__ __forceinline__ void fox_unit(int b, int h, int qb, const bf16_t* Q, const bf16_t* K, const bf16_t* V, bf16_t* O, char* shm) {
    const int tid = threadIdx.x, lane = tid & 63, r32 = lane & 31, hi = lane >> 5; const int wid = __builtin_amdgcn_readfirstlane(tid >> 6);
    const long rowbase = (long)b * SEQL; const int q0 = qb * QB;
    const bf16_t* Qw = Q + (rowbase + q0 + wid * 32) * PQ + h * 64;
    const bf16_t* Kh = K + rowbase * PQ + h * 64; const bf16_t* Vh = V + rowbase * PQ + h * 64;
    const unsigned lds0 = (unsigned)(uintptr_t)shm;
    float* wsf = (float*)(shm + LDS_WS) + wid * 64;
    const float* c2s = (const float*)(shm + LDS_C2);
    const bf16_t* ksrc = Kh + (long)lane * PQ + wid * 8;
    const bf16_t* vsrc = Vh + (long)(16 * (wid & 3) + (lane >> 2)) * PQ + (wid >> 2) * 32 + (lane & 3) * 8;
    const unsigned kdst = lds0 + LDS_K + wid * 1024, vdst = lds0 + LDS_V + wid * 1024;
#define DMA_K(t, slot) glds16(ksrc + (long)(t) * KVBLK * PQ, (unsigned)__builtin_amdgcn_readfirstlane(kdst + (slot)))
#define DMA_V(t, slot) glds16(vsrc + (long)(t) * KVBLK * PQ, (unsigned)__builtin_amdgcn_readfirstlane(vdst + (slot)))
    const int vb0 = (int)(lds0 + LDS_V) + ((lane >> 4) & 1) * 32 + (lane & 3) * 8 + (4 * hi + ((lane & 15) >> 2)) * 64;
    const lds_cptr shm3 = (lds_cptr)shm;
    const int NT = (q0 + QB) / KVBLK;
    DMA_K(0, 0); DMA_V(0, 0);
    bf16x8 qr[4];
#pragma unroll
    for (int d0 = 0; d0 < 4; ++d0) qr[d0] = *reinterpret_cast<const bf16x8*>(&Qw[(long)r32 * PQ + d0 * 16 + hi * 8]);
    const int qrel = wid * 32 + r32;
    const float ct = c2s[q0 + qrel];
    float l_reg = 0.f; f32x16 o[2]; o[0] = f32x16{}; o[1] = f32x16{};
    for (int t = 0; t < NT; ++t) {
        const int slot = (t & 1) * SLOTB;
        FWAIT_BAR(0);
        if (t + 1 < NT) { DMA_K(t + 1, slot ^ SLOTB); DMA_V(t + 1, slot ^ SLOTB); }
        f32x16 c0, c1;
        { const __attribute__((address_space(3))) float* cp = (const __attribute__((address_space(3))) float*)(shm3 + LDS_C2) + 64 * t + 4 * hi;
#pragma unroll
          for (int g = 0; g < 4; ++g) { const f32x4 a = *(const __attribute__((address_space(3))) f32x4*)(cp + 8 * g), bq = *(const __attribute__((address_space(3))) f32x4*)(cp + 32 + 8 * g);
#pragma unroll
            for (int i = 0; i < 4; ++i) { c0[4 * g + i] = ct - a[i]; c1[4 * g + i] = ct - bq[i]; } } }
        f32x16 p0, p1;
        qkt(p0, p1, shm3 + LDS_K + slot, qr, c0, c1, r32, hi);
        const int jb = t - (NT - 4);
        if (jb >= 0) { const int kb = 64 * jb + 4 * hi;
#pragma unroll
            for (int r = 0; r < 16; ++r) { const int kv = kb + (r & 3) + 8 * (r >> 2); if (kv > qrel) p0[r] = -INFINITY; if (kv + 32 > qrel) p1[r] = -INFINITY; } }
        float sacc = 0.f;
#pragma unroll
        for (int r = 0; r < 16; ++r) { p0[r] = __builtin_amdgcn_exp2f(p0[r]); p1[r] = __builtin_amdgcn_exp2f(p1[r]); sacc += p0[r] + p1[r]; }
        l_reg += sacc;
        u32x4 pw0, pw1, pw2, pw3;
        pw0 = (u32x4){cvtpk_s(p0[0], p0[1]), cvtpk_s(p0[2], p0[3]), cvtpk_s(p0[4], p0[5]), cvtpk_s(p0[6], p0[7])};
        pw1 = (u32x4){cvtpk_s(p0[8], p0[9]), cvtpk_s(p0[10], p0[11]), cvtpk_s(p0[12], p0[13]), cvtpk_s(p0[14], p0[15])};
        pw2 = (u32x4){cvtpk_s(p1[0], p1[1]), cvtpk_s(p1[2], p1[3]), cvtpk_s(p1[4], p1[5]), cvtpk_s(p1[6], p1[7])};
        pw3 = (u32x4){cvtpk_s(p1[8], p1[9]), cvtpk_s(p1[10], p1[11]), cvtpk_s(p1[12], p1[13]), cvtpk_s(p1[14], p1[15])};
        FSBAR();
        pv(o, vb0 + slot, __builtin_bit_cast(bf16x8, pw0), __builtin_bit_cast(bf16x8, pw1), __builtin_bit_cast(bf16x8, pw2), __builtin_bit_cast(bf16x8, pw3));
    }
    { auto rr = __builtin_amdgcn_permlane32_swap(__float_as_uint(l_reg), __float_as_uint(l_reg), false, false); l_reg = __uint_as_float(rr[0]) + __uint_as_float(rr[1]); }
    if (hi == 0) wsf[32 + r32] = l_reg; asm volatile("s_waitcnt lgkmcnt(0)" ::: "memory");
    float rli[16];
#pragma unroll
    for (int r = 0; r < 16; ++r) rli[r] = __builtin_amdgcn_rcpf(wsf[32 + crow(r, hi)]);
    bf16_t* Ow = O + (rowbase + q0 + wid * 32) * PO + 512 + h * 64;
    { bf16_t* stg = (bf16_t*)(shm + LDS_OST) + wid * 2048;
#pragma unroll
      for (int r = 0; r < 16; ++r) { const int orow = crow(r, hi);
#pragma unroll
          for (int d0 = 0; d0 < 2; ++d0) stg[orow * 64 + d0 * 32 + r32] = f2bf(o[d0][r] * rli[r]); }
      asm volatile("s_waitcnt lgkmcnt(0)" ::: "memory");
#pragma unroll
      for (int i = 0; i < 4; ++i) { const int row = i * 8 + (lane >> 3), ch = lane & 7; const u32x4 v = *(const u32x4*)(stg + row * 64 + ch * 8); *(u32x4*)(Ow + (long)row * PO + ch * 8) = v; } }
    asm volatile("s_waitcnt lgkmcnt(0)\n\ts_barrier" ::: "memory");
#undef DMA_K
#undef DMA_V
}
__device__ __forceinline__ void fox_phase192(char* shm, int fcu, const bf16_t* Q, const bf16_t* K, const bf16_t* V, const float* LF2, bf16_t* O) {
    const int trio = fcu / 3, r = fcu - 3 * trio, bh0 = 2 * trio, bh1 = bh0 + 1;
    if (trio >= 64) return;
    if (r == 0) { fox_cumsum(LF2, bh0 >> 3, bh0 & 7, shm); for (int qb = 15; qb >= 9; --qb) fox_unit(bh0 >> 3, bh0 & 7, qb, Q, K, V, O, shm); }
    else if (r == 1) { fox_cumsum(LF2, bh0 >> 3, bh0 & 7, shm); for (int qb = 8; qb >= 0; --qb) fox_unit(bh0 >> 3, bh0 & 7, qb, Q, K, V, O, shm);
        fox_cumsum(LF2, bh1 >> 3, bh1 & 7, shm); for (int i = 0; i < 4; ++i) fox_unit(bh1 >> 3, bh1 & 7, i < 3 ? 15 - i : 0, Q, K, V, O, shm); }
    else { fox_cumsum(LF2, bh1 >> 3, bh1 & 7, shm); for (int qb = 12; qb >= 1; --qb) fox_unit(bh1 >> 3, bh1 & 7, qb, Q, K, V, O, shm); }
}
#undef FSBAR
#undef FWAIT_BAR
}
namespace gla {
using bf16x8 = __attribute__((ext_vector_type(8))) short;
using s16x4 = __attribute__((ext_vector_type(4))) short;
using f32x4 = __attribute__((ext_vector_type(4))) float;
using u32x4 = __attribute__((ext_vector_type(4))) unsigned;
using u32x2 = __attribute__((ext_vector_type(2))) unsigned;
typedef short v4i16_t __attribute__((ext_vector_type(4)));
#define GLAS __attribute__((address_space(3)))
constexpr int G_GLR = 0, G_SEG = 4096, G_DEC = 6144, G_QE = 6400, G_KE = 15616, G_KDT = 24832, G_SC = 34048, G_V = 43264, G_O = 61696, G_END = 95488;
constexpr int RS = 144, VS = 288, OS = 528;
static_assert(G_END <= 131072, "gla LDS");
typedef float f32x2_t __attribute__((ext_vector_type(2))); typedef __bf16 bf16x2_t __attribute__((ext_vector_type(2)));
__device__ __forceinline__ unsigned pk(float lo, float hi) { f32x2_t v = {lo, hi}; bf16x2_t b = __builtin_convertvector(v, bf16x2_t); return __builtin_bit_cast(unsigned, b); }
__device__ __forceinline__ bf16_t cv1(float x) { return (bf16_t)(pk(x, 0.f) & 0xffffu); }
__device__ __forceinline__ float ex2(float x) { return __builtin_amdgcn_exp2f(x); }
__device__ __forceinline__ float logsig2(float z) { return fminf(z, 0.f) * LOG2E - __builtin_amdgcn_logf(1.f + ex2(-fabsf(z) * LOG2E)); }
__device__ __forceinline__ s16x4 vtr(const GLAS char* p) { return __builtin_bit_cast(s16x4, __builtin_amdgcn_ds_read_tr16_b64_v4i16((GLAS v4i16_t*)p)); }

__device__ __forceinline__ void gla_unit(int b, int h, const bf16_t* GQ, const bf16_t* GK, const bf16_t* GV, const bf16_t* GR, const float* GLR, const float* w2, const float* ba, const float* gn, bf16_t* OGF, GLAS char* sm) {
    const int tid = threadIdx.x, lane = tid & 63, g = lane >> 4, c = lane & 15; const int wid = __builtin_amdgcn_readfirstlane(tid >> 6);
    const int d = lane, seg = wid;
    float w2c[16];
#pragma unroll
    for (int r = 0; r < 16; ++r) w2c[r] = w2[r * 256 + h * 64 + d];
    const float bac = ba[h * 64 + d];
    f32x4 S[4];
#pragma unroll
    for (int mb = 0; mb < 4; ++mb) S[mb] = (f32x4){0.f, 0.f, 0.f, 0.f};
    const int el = tid >> 3, ej = tid & 7;
    f32x4 pf_glr = {0.f, 0.f, 0.f, 0.f}; u32x4 pf_v[2], pf_gr[2]; unsigned short pf_q[8], pf_k[8];
#define GLA_PREFETCH(CH) do { const size_t mm_ = (size_t)b * 4096 + 64 * (CH); \
        if (tid < 256) pf_glr = *(const f32x4*)(GLR + (mm_ + (tid >> 2)) * 16 + 4 * (tid & 3)); \
        _Pragma("unroll") for (int i = 0; i < 2; ++i) { const int p = tid + 512 * i, row = p >> 4, ch = p & 15; pf_v[i] = *(const u32x4*)(GV + (mm_ + row) * 512 + h * 128 + 8 * ch); } \
        _Pragma("unroll") for (int i = 0; i < 8; ++i) { pf_q[i] = GQ[(mm_ + 8 * seg + i) * 256 + h * 64 + d]; pf_k[i] = GK[(mm_ + 8 * seg + i) * 256 + h * 64 + d]; } \
        { const bf16_t* grp = GR + (mm_ + el) * 512 + h * 128 + 16 * ej; pf_gr[0] = *(const u32x4*)grp; pf_gr[1] = *(const u32x4*)(grp + 8); } } while (0)
    GLA_PREFETCH(0);
    f32x4 gnv[4];
#pragma unroll
    for (int j = 0; j < 4; ++j) gnv[j] = *(const f32x4*)(gn + h * 128 + 16 * ej + 4 * j);
    for (int chunk = 0; chunk < 64; ++chunk) {
        const size_t m0 = (size_t)b * 4096 + 64 * chunk;
        if (tid < 256) *(GLAS f32x4*)(sm + G_GLR + tid * 16) = pf_glr;
#pragma unroll
        for (int i = 0; i < 2; ++i) { const int p = tid + 512 * i, row = p >> 4, ch = p & 15; *(GLAS u32x4*)(sm + G_V + row * VS + ch * 16) = pf_v[i]; }
        float qv[8], kv[8];
#pragma unroll
        for (int i = 0; i < 8; ++i) { qv[i] = bf2f(pf_q[i]); kv[i] = bf2f(pf_k[i]); }
        const u32x4 g0 = pf_gr[0], g1 = pf_gr[1];
        if (chunk + 1 < 64) GLA_PREFETCH(chunk + 1);
        __syncthreads();
        float la[8];
#pragma unroll
        for (int i = 0; i < 8; ++i) { float z = bac; const GLAS f32x4* gp = (const GLAS f32x4*)(sm + G_GLR + (8 * seg + i) * 64);
#pragma unroll
            for (int r4 = 0; r4 < 4; ++r4) { const f32x4 t = gp[r4]; z += t[0] * w2c[4 * r4] + t[1] * w2c[4 * r4 + 1] + t[2] * w2c[4 * r4 + 2] + t[3] * w2c[4 * r4 + 3]; }
            la[i] = logsig2(z) * (1.f / 16.f); }
#pragma unroll
        for (int i = 1; i < 8; ++i) la[i] += la[i - 1];
        *(GLAS float*)(sm + G_SEG + (seg * 64 + d) * 4) = la[7];
        __syncthreads();
        float pre = 0.f, tot = 0.f;
#pragma unroll
        for (int s = 0; s < 8; ++s) { const float v = *(const GLAS float*)(sm + G_SEG + (s * 64 + d) * 4); tot += v; pre += (s < seg) ? v : 0.f; }
        { float kd[8];
#pragma unroll
          for (int i = 0; i < 8; ++i) { const float bb = la[i] + pre; const int l = 8 * seg + i;
              *(GLAS bf16_t*)(sm + G_QE + l * RS + d * 2) = cv1(qv[i] * ex2(bb)); *(GLAS bf16_t*)(sm + G_KE + l * RS + d * 2) = cv1(kv[i] * ex2(-bb)); kd[i] = kv[i] * ex2(tot - bb); }
          *(GLAS u32x4*)(sm + G_KDT + d * RS + seg * 16) = (u32x4){pk(kd[0], kd[1]), pk(kd[2], kd[3]), pk(kd[4], kd[5]), pk(kd[6], kd[7])};
          if (seg == 0) *(GLAS float*)(sm + G_DEC + d * 4) = ex2(tot); }
        __syncthreads();
        { const int lb = wid >> 1;
#pragma unroll
          for (int mm = 0; mm < 2; ++mm) { const int mbk = 2 * (wid & 1) + mm; f32x4 acc = {0.f, 0.f, 0.f, 0.f};
#pragma unroll
              for (int ks = 0; ks < 2; ++ks) { const bf16x8 a = *(const GLAS bf16x8*)(sm + G_KE + (16 * mbk + c) * RS + (32 * ks + 8 * g) * 2), bq = *(const GLAS bf16x8*)(sm + G_QE + (16 * lb + c) * RS + (32 * ks + 8 * g) * 2);
                  acc = __builtin_amdgcn_mfma_f32_16x16x32_bf16(a, bq, acc, 0, 0, 0); }
              const int l = 16 * lb + c, mq = 16 * mbk + 4 * g;
#pragma unroll
              for (int r = 0; r < 4; ++r) acc[r] = (l >= mq + r) ? acc[r] : 0.f;
              *(GLAS u32x2*)(sm + G_SC + l * RS + mq * 2) = (u32x2){pk(acc[0], acc[1]), pk(acc[2], acc[3])}; } }
        __syncthreads();
        bf16x8 vf[2], sf[2];
        { const int q = c >> 2, p = c & 3;
#pragma unroll
          for (int ks = 0; ks < 2; ++ks) { const GLAS char* ap = sm + G_V + (32 * ks + 8 * g + q) * VS + (16 * wid + 4 * p) * 2; const s16x4 r1 = vtr(ap), r2 = vtr(ap + 4 * VS);
              vf[ks] = (bf16x8){r1[0], r1[1], r1[2], r1[3], r2[0], r2[1], r2[2], r2[3]}; } }
#pragma unroll
        for (int s = 0; s < 2; ++s) { const u32x4 w = {pk(S[2 * s][0], S[2 * s][1]), pk(S[2 * s][2], S[2 * s][3]), pk(S[2 * s + 1][0], S[2 * s + 1][1]), pk(S[2 * s + 1][2], S[2 * s + 1][3])}; sf[s] = __builtin_bit_cast(bf16x8, w); }
        f32x4 oacc[4];
#pragma unroll
        for (int lb = 0; lb < 4; ++lb) { f32x4 acc = {0.f, 0.f, 0.f, 0.f};
#pragma unroll
            for (int ks = 0; ks < 2; ++ks) { const bf16x8 a = *(const GLAS bf16x8*)(sm + G_SC + (16 * lb + c) * RS + (32 * ks + 8 * g) * 2); acc = __builtin_amdgcn_mfma_f32_16x16x32_bf16(a, vf[ks], acc, 0, 0, 0); }
#pragma unroll
            for (int s = 0; s < 2; ++s) { const GLAS char* ap = sm + G_QE + (16 * lb + c) * RS + (32 * s + 4 * g) * 2; const s16x4 lo = *(const GLAS s16x4*)ap, hi = *(const GLAS s16x4*)(ap + 32);
                const bf16x8 a = {lo[0], lo[1], lo[2], lo[3], hi[0], hi[1], hi[2], hi[3]}; acc = __builtin_amdgcn_mfma_f32_16x16x32_bf16(a, sf[s], acc, 0, 0, 0); }
            oacc[lb] = acc; }
#pragma unroll
        for (int mb = 0; mb < 4; ++mb) { const f32x4 dec = *(const GLAS f32x4*)(sm + G_DEC + (16 * mb + 4 * g) * 4); f32x4 acc = S[mb] * dec;
#pragma unroll
            for (int ks = 0; ks < 2; ++ks) { const bf16x8 a = *(const GLAS bf16x8*)(sm + G_KDT + (16 * mb + c) * RS + (32 * ks + 8 * g) * 2); acc = __builtin_amdgcn_mfma_f32_16x16x32_bf16(a, vf[ks], acc, 0, 0, 0); }
            S[mb] = acc; }
#pragma unroll
        for (int lb = 0; lb < 4; ++lb)
#pragma unroll
            for (int r = 0; r < 4; ++r) *(GLAS float*)(sm + G_O + (16 * lb + 4 * g + r) * OS + (16 * wid + c) * 4) = oacc[lb][r];
        __syncthreads();
        { f32x4 o4[4]; float ss = 0.f;
#pragma unroll
          for (int j = 0; j < 4; ++j) { o4[j] = *(const GLAS f32x4*)(sm + G_O + el * OS + ej * 64 + j * 16); ss += (o4[j][0] * o4[j][0] + o4[j][1] * o4[j][1]) + (o4[j][2] * o4[j][2] + o4[j][3] * o4[j][3]); }
          ss += __shfl_xor(ss, 1); ss += __shfl_xor(ss, 2); ss += __shfl_xor(ss, 4);
          const float rs = rsqrtf(ss * (1.f / 128.f) + 1e-6f);
          const unsigned gw[8] = {g0.x, g0.y, g0.z, g0.w, g1.x, g1.y, g1.z, g1.w};
          unsigned ow[8];
#pragma unroll
          for (int j = 0; j < 4; ++j) { const f32x4 gv = gnv[j]; float r[4];
#pragma unroll
              for (int i = 0; i < 4; ++i) { const unsigned w = gw[2 * j + (i >> 1)]; const float gr = (i & 1) ? __uint_as_float(w & 0xffff0000u) : __uint_as_float(w << 16);
                  r[i] = o4[j][i] * rs * gv[i] * gr * __builtin_amdgcn_rcpf(1.f + ex2(-LOG2E * gr)); }
              ow[2 * j] = pk(r[0], r[1]); ow[2 * j + 1] = pk(r[2], r[3]); }
          bf16_t* op = OGF + (m0 + el) * 1024 + h * 128 + 16 * ej;
          *(u32x4*)op = (u32x4){ow[0], ow[1], ow[2], ow[3]}; *(u32x4*)(op + 8) = (u32x4){ow[4], ow[5], ow[6], ow[7]}; }
    }
}
__device__ __forceinline__ void gla_phase(GLAS char* sm, int vcu, const bf16_t* GQ, const bf16_t* GK, const bf16_t* GV, const bf16_t* GR, const float* GLR, const float* w2, const float* ba, const float* gn, bf16_t* OGF) {
    if (vcu < 64) gla_unit(vcu >> 2, vcu & 3, GQ, GK, GV, GR, GLR, w2, ba, gn, OGF, sm);
}
#undef GLA_PREFETCH
#undef GLAS
}
#define PHASE_GLA do { if (F.vcu < 64) gla::gla_phase((__attribute__((address_space(3))) char*)(F.lds + RING_OFF), F.vcu, GQ, GK, GV, GR, GLR, args.in[3], args.in[4], args.in[5], A); \
    else fox::fox_phase192((char*)lds + RING_OFF, F.vcu - 64, FQ, FK, FV, LF2, A); } while (0)
#define PHASE_FOX do {} while (0)
constexpr int NWAVES = 8;
constexpr int RING_OFF = 0, RING_BYTES = 131072, LDSCTL_OFF = RING_BYTES, MISC_OFF = LDSCTL_OFF + 320, LDS_BYTES = 147456;
constexpr size_t CTL_ZERO_BYTES = 1 * MiB;
constexpr int CW_TMO = 0, CW_CODE = 1, CW_BAR = 4096;
constexpr int N_PHASES = 12;
constexpr size_t WS_WIN = WS_W, WS_WGF = WS_WIN + (size_t)5376 * 1024 * 2, WS_WOUT = WS_WGF + 2 * MiB, WS_WUP = WS_WOUT + 2 * MiB, WS_WDN = WS_WUP + (size_t)5632 * 1024 * 2;
static_assert(WS_WDN + (size_t)1024 * 2816 * 2 <= WS_A, "weights fit below WS_A");
constexpr size_t WS_EDGE = WS_C;

struct Frame {
    LAS unsigned char* lds; volatile LAS unsigned* MISC; gu32* ctl;
    int tid, lane, wave, vcu, G;
};
__device__ __forceinline__ float wave_sum(float v) {
#pragma unroll
    for (int o = 1; o < 64; o <<= 1) v += __shfl_xor(v, o);
    return v;
}
__device__ __forceinline__ void p0_xpose(const float* colp, int ldw, bf16_t* dst, int ldd, LAS float* scr, int lane) {
#pragma unroll 8
    for (int i = 0; i < 32; ++i) { const int kk = 2 * i + (lane >> 5); scr[kk * 33 + (lane & 31)] = colp ? colp[(size_t)kk * ldw] : 0.f; }
    LDS_WAIT(); asm volatile("" ::: "memory");
    const int c = lane & 7;
#pragma unroll
    for (int j = 0; j < 4; ++j) { const int n = (lane >> 3) + 8 * j; const LAS float* s = scr + (8 * c) * 33 + n;
        v4u o; o.x = pk2(s[0 * 33], s[1 * 33]); o.y = pk2(s[2 * 33], s[3 * 33]); o.z = pk2(s[4 * 33], s[5 * 33]); o.w = pk2(s[6 * 33], s[7 * 33]);
        *(GAS v4u*)(dst + (size_t)n * ldd + 8 * c) = o; }
    LDS_WAIT(); asm volatile("" ::: "memory");
}
__device__ __forceinline__ int inproj_base(int pn) { return pn < 6 ? 256 * pn : (pn < 12 ? 1552 + 256 * (pn - 6) : 3096 + 256 * (pn - 12)); }
struct Args { const float* in[19]; float* out; unsigned char* ws; int ph_lo, ph_hi, li, pad; };

__device__ __forceinline__ void p0_weights(Frame& F, const Args& a) {
    LAS float* scr = (LAS float*)(F.lds + RING_OFF + F.wave * 16384);
    const int gw = F.vcu * NWAVES + F.wave, NGW = F.G * NWAVES, lane = F.lane, c = lane & 31;
    constexpr int I_IN = 16 * 168, I_GF = 16 * 32, I_OUT = 16 * 32, I_UP = 16 * 176, I_DN = 44 * 32, NITEMS = I_IN + I_GF + I_OUT + I_UP + I_DN;
    unsigned char* ws = a.ws;
    for (int it = gw; it < NITEMS; it += NGW) {
        int r = it; const float* colp; int ldw, ldd; bf16_t* dst;
        if (r < I_IN) { const int kb = r / 168, nb = r % 168, pn = nb >> 3, pb = nb & 7, q0 = 64 * (pb & 3) + 32 * (pb >> 2);
            int col; if (pn < 20) col = inproj_base(pn) + q0 + c; else col = (q0 == 0) ? (c < 16 ? 1536 + c : (c < 24 ? 3088 + c - 16 : -1)) : -1;
            ldw = INC; ldd = 1024; colp = col >= 0 ? a.in[2] + (size_t)(64 * kb) * INC + col : nullptr; dst = (bf16_t*)(ws + WS_WIN) + (size_t)(32 * nb) * 1024 + 64 * kb;
        } else if ((r -= I_IN) < I_GF) { const int kb = r / 32, nb = r % 32, pn = nb >> 3, pb = nb & 7, col = 256 * pn + 64 * (pb & 3) + 32 * (pb >> 2) + c;
            ldw = 1024; ldd = 1024; colp = (kb < 8 ? a.in[10] + (size_t)(64 * kb) * 1024 : a.in[11] + (size_t)(64 * (kb - 8)) * 1024) + col; dst = (bf16_t*)(ws + WS_WGF) + (size_t)(32 * nb) * 1024 + 64 * kb;
        } else if ((r -= I_GF) < I_OUT) { const int kb = r / 32, nb = r % 32, pn = nb >> 3, pb = nb & 7, col = 256 * pn + 64 * (pb & 3) + 32 * (pb >> 2) + c;
            ldw = 1024; ldd = 1024; colp = a.in[12] + (size_t)(64 * kb) * 1024 + col; dst = (bf16_t*)(ws + WS_WOUT) + (size_t)(32 * nb) * 1024 + 64 * kb;
        } else if ((r -= I_OUT) < I_UP) { const int kb = r / 176, nb = r % 176, pn = nb >> 3, pb = nb & 7, col = (pb >> 2) * 2816 + 128 * pn + 32 * (pb & 3) + c;
            ldw = 5632; ldd = 1024; colp = a.in[14] + (size_t)(64 * kb) * 5632 + col; dst = (bf16_t*)(ws + WS_WUP) + (size_t)(32 * nb) * 1024 + 64 * kb;
        } else { r -= I_UP; const int kb = r / 32, nb = r % 32, pn = nb >> 3, pb = nb & 7, col = 256 * pn + 64 * (pb & 3) + 32 * (pb >> 2) + c;
            ldw = 1024; ldd = 2816; colp = a.in[17] + (size_t)(64 * kb) * 1024 + col; dst = (bf16_t*)(ws + WS_WDN) + (size_t)(32 * nb) * 2816 + 64 * kb; }
        p0_xpose(colp, ldw, dst, ldd, scr, lane);
    }
}
__device__ __forceinline__ void rms_rows_bf16(Frame& F, const float* x, const float* g, bf16_t* out) {
    const int gw = F.vcu * NWAVES + F.wave, NGW = F.G * NWAVES;
    f32x4 gv[4];
#pragma unroll
    for (int j = 0; j < 4; ++j) gv[j] = ((const GAS f32x4*)g)[F.lane + 64 * j];
    for (int m = gw; m < M_TOK; m += NGW) {
        const GAS f32x4* xr = (const GAS f32x4*)(x + (size_t)m * 1024) + F.lane;
        f32x4 v[4]; float s = 0.f;
#pragma unroll
        for (int j = 0; j < 4; ++j) { v[j] = xr[64 * j]; s += (v[j].x * v[j].x + v[j].y * v[j].y) + (v[j].z * v[j].z + v[j].w * v[j].w); }
        const float rs = rsqrtf(wave_sum(s) * (1.f / 1024.f) + 1e-6f);
        GAS unsigned long long* o8 = (GAS unsigned long long*)(out + (size_t)m * 1024) + F.lane;
#pragma unroll
        for (int j = 0; j < 4; ++j) { const f32x4 y = v[j] * rs * gv[j]; o8[64 * j] = (unsigned long long)pk2(y.x, y.y) | ((unsigned long long)pk2(y.z, y.w) << 32); }
    }
}
__device__ __forceinline__ void rms_rows_f32(Frame& F, float* x, const float* g) {
    const int gw = F.vcu * NWAVES + F.wave, NGW = F.G * NWAVES;
    f32x4 gv[4];
#pragma unroll
    for (int j = 0; j < 4; ++j) gv[j] = ((const GAS f32x4*)g)[F.lane + 64 * j];
    for (int m = gw; m < M_TOK; m += NGW) {
        GAS f32x4* xr = (GAS f32x4*)(x + (size_t)m * 1024) + F.lane;
        f32x4 v[4]; float s = 0.f;
#pragma unroll
        for (int j = 0; j < 4; ++j) { v[j] = xr[64 * j]; s += (v[j].x * v[j].x + v[j].y * v[j].y) + (v[j].z * v[j].z + v[j].w * v[j].w); }
        const float rs = rsqrtf(wave_sum(s) * (1.f / 1024.f) + 1e-6f);
#pragma unroll
        for (int j = 0; j < 4; ++j) xr[64 * j] = v[j] * rs * gv[j];
    }
}
__device__ __forceinline__ void conv_fixup(Frame& F, const float* EDGE, const float* cw, const float* cb, bf16_t* HM) {
    const int gt = (F.vcu * NWAVES + F.wave) * 64 + F.lane, NT = F.G * NWAVES * 64;
    constexpr int NQ = 2816 / 4, TOTAL = 1024 * 2 * NQ;
    for (int it = gt; it < TOTAL; it += NT) {
        const int q = it % NQ, j = (it / NQ) & 1, g = it / (2 * NQ); const int c = 4 * q;
        const bool prev = ((g * 64) & 4095) != 0;
        const float* eg = EDGE + (size_t)g * (6 * 2816) + c; const float* ep = eg - 6 * 2816;
        const f32x4 z = {0.f, 0.f, 0.f, 0.f};
        const f32x4 a0 = *(const f32x4*)(eg + j * 2816);
        const f32x4 a1 = j ? *(const f32x4*)(eg) : (prev ? *(const f32x4*)(ep + 3 * 2816) : z);
        const f32x4 a2 = j ? (prev ? *(const f32x4*)(ep + 3 * 2816) : z) : (prev ? *(const f32x4*)(ep + 2 * 2816) : z);
        const f32x4 vl = *(const f32x4*)(eg + (4 + j) * 2816);
        const f32x4 w0 = *(const f32x4*)(cw + c), w1 = *(const f32x4*)(cw + 2816 + c), w2 = *(const f32x4*)(cw + 5632 + c), b = *(const f32x4*)(cb + c);
        const f32x4 cv = b + w0 * a2 + w1 * a1 + w2 * a0;
        unsigned long long o = (unsigned long long)pk2(pg8::gelu_tanh_fast(cv.x) * vl.x, pg8::gelu_tanh_fast(cv.y) * vl.y) | ((unsigned long long)pk2(pg8::gelu_tanh_fast(cv.z) * vl.z, pg8::gelu_tanh_fast(cv.w) * vl.w) << 32);
        *(unsigned long long*)(HM + ((size_t)g * 64 + j) * 2816 + c) = o;
    }
}

#ifndef REP0
#define REP0 1
#endif
#ifndef REP1
#define REP1 1
#endif
#ifndef REP2
#define REP2 1
#endif
#ifndef REP3
#define REP3 1
#endif
#ifndef REP4
#define REP4 1
#endif
#ifndef REP5
#define REP5 1
#endif
#ifndef REP6
#define REP6 1
#endif
#ifndef REP7
#define REP7 1
#endif
#ifndef REP8
#define REP8 1
#endif
#ifndef REP9
#define REP9 1
#endif
#ifndef REP10
#define REP10 1
#endif
#ifndef REP11
#define REP11 1
#endif
__global__ void __launch_bounds__(NWAVES * 64, 2) skel_fwd(Args args) {
    extern __shared__ __attribute__((aligned(16))) unsigned char lds[];
    Frame F;
    F.lds = (LAS unsigned char*)lds; F.MISC = (volatile LAS unsigned*)(F.lds + MISC_OFF);
    F.tid = threadIdx.x; F.lane = F.tid & 63; F.wave = __builtin_amdgcn_readfirstlane(F.tid >> 6);
    F.G = gridDim.x; { const int bx = blockIdx.x; F.vcu = (F.G % 8 == 0) ? (bx % 8) * (F.G / 8) + bx / 8 : bx; }
    unsigned char* ws = args.ws;
    F.ctl = (gu32*)(ws + WS_CTL);
    for (int u = F.tid; u < (LDS_BYTES - LDSCTL_OFF) / 4; u += NWAVES * 64) ((LAS unsigned*)(F.lds + LDSCTL_OFF))[u] = 0u;
    __syncthreads();
    XcdBarrier bar = xcd_barrier_post((unsigned*)(F.ctl + CW_BAR) + args.li * XCD_BAR_WORDS, F.MISC + 8);
#define GRID_BAR() xcd_barrier(bar)
    const int lo = args.ph_lo, hi = args.ph_hi;
#define IN(k) (lo <= (k) && (k) < hi)
#define BOTH(k) (IN(k) && IN((k) + 1))
    bf16_t* const A = (bf16_t*)(ws + WS_A);
    bf16_t *GQ = (bf16_t*)(ws + WS_GQ), *GK = (bf16_t*)(ws + WS_GK), *GV = (bf16_t*)(ws + WS_GV), *GR = (bf16_t*)(ws + WS_GR), *FQ = (bf16_t*)(ws + WS_FQ), *FK = (bf16_t*)(ws + WS_FK), *FV = (bf16_t*)(ws + WS_FV);
    bf16_t *SG = (bf16_t*)(ws + WS_SG), *SF = (bf16_t*)(ws + WS_SF), *Y = (bf16_t*)(ws + WS_Y), *HM = (bf16_t*)(ws + WS_HM);
    float *GLR = (float*)(ws + WS_GLR), *LF2 = (float*)(ws + WS_LF2), *EDGE = (float*)(ws + WS_EDGE);

    if (IN(0)) { for (int rp_ = 0; rp_ < REP0; ++rp_) { p0_weights(F, args); if (rp_ + 1 < REP0) GRID_BAR(); } if (BOTH(0)) GRID_BAR(); }
    if (IN(1)) { for (int rp_ = 0; rp_ < REP1; ++rp_) { rms_rows_bf16(F, args.in[0], args.in[1], A); if (rp_ + 1 < REP1) GRID_BAR(); } if (BOTH(1)) GRID_BAR(); }
    if (IN(2)) { for (int rp_ = 0; rp_ < REP2; ++rp_) {
        pg8::Gemm g{A, (const bf16_t*)(ws + WS_WIN), M_TOK, 5376, 1024}; pg8::StaticOrder S; S.init(M_TOK, 5376, F.G, (int)blockIdx.x);
        pg8::EpiInProj E{GQ, GK, GV, GR, FQ, FK, FV, SG, SF, GLR, LF2, args.in[6], args.in[7], args.in[8], args.in[9]};
        pg8::gemm_phase<pg8::EpiInProj, pg8::StaticOrder, true, true>(F.lds + RING_OFF, g, S, E);
        if (rp_ + 1 < REP2) GRID_BAR(); } if (BOTH(2)) GRID_BAR();
    }
    if (IN(3)) { for (int rp_ = 0; rp_ < REP3; ++rp_) { PHASE_GLA; if (rp_ + 1 < REP3) GRID_BAR(); } if (BOTH(3)) GRID_BAR(); }
    if (IN(5)) { for (int rp_ = 0; rp_ < REP5; ++rp_) {
        pg8::Gemm g{A, (const bf16_t*)(ws + WS_WGF), M_TOK, 1024, 1024}; pg8::StaticOrder S; S.init(M_TOK, 1024, F.G, (int)blockIdx.x);
        pg8::EpiMerge E{SG, SF, Y};
        pg8::gemm_phase<pg8::EpiMerge, pg8::StaticOrder, true, true>(F.lds + RING_OFF, g, S, E);
        if (rp_ + 1 < REP5) GRID_BAR(); } if (BOTH(5)) GRID_BAR();
    }
    if (IN(6)) { for (int rp_ = 0; rp_ < REP6; ++rp_) {
        pg8::Gemm g{Y, (const bf16_t*)(ws + WS_WOUT), M_TOK, 1024, 1024}; pg8::StaticOrder S; S.init(M_TOK, 1024, F.G, (int)blockIdx.x);
        pg8::EpiResid E{args.in[0], args.out};
        pg8::gemm_phase<pg8::EpiResid, pg8::StaticOrder, true, true>(F.lds + RING_OFF, g, S, E);
        if (rp_ + 1 < REP6) GRID_BAR(); } if (BOTH(6)) GRID_BAR();
    }
    if (IN(7)) { for (int rp_ = 0; rp_ < REP7; ++rp_) { rms_rows_bf16(F, args.out, args.in[13], A); if (rp_ + 1 < REP7) GRID_BAR(); } if (BOTH(7)) GRID_BAR(); }
    if (IN(8)) { for (int rp_ = 0; rp_ < REP8; ++rp_) {
        pg8::Gemm g{A, (const bf16_t*)(ws + WS_WUP), M_TOK, 5632, 1024}; pg8::StaticOrder S; S.init(M_TOK, 5632, F.G, (int)blockIdx.x);
        pg8::EpiUp E{HM, EDGE, args.in[15], args.in[16]};
        pg8::gemm_phase<pg8::EpiUp, pg8::StaticOrder, true, true>(F.lds + RING_OFF, g, S, E);
        if (rp_ + 1 < REP8) GRID_BAR(); } if (BOTH(8)) GRID_BAR();
    }
    if (IN(9)) { for (int rp_ = 0; rp_ < REP9; ++rp_) { conv_fixup(F, EDGE, args.in[15], args.in[16], HM); if (rp_ + 1 < REP9) GRID_BAR(); } if (BOTH(9)) GRID_BAR(); }
    if (IN(10)) { for (int rp_ = 0; rp_ < REP10; ++rp_) {
        pg8::Gemm g{HM, (const bf16_t*)(ws + WS_WDN), M_TOK, 1024, 2816}; pg8::StaticOrder S; S.init(M_TOK, 1024, F.G, (int)blockIdx.x);
        pg8::EpiResid E{args.out, args.out};
        pg8::gemm_phase<pg8::EpiResid, pg8::StaticOrder, true, true>(F.lds + RING_OFF, g, S, E);
        if (rp_ + 1 < REP10) GRID_BAR(); } if (BOTH(10)) GRID_BAR();
    }
    if (IN(11)) { for (int rp_ = 0; rp_ < REP11; ++rp_) { rms_rows_f32(F, args.out, args.in[18]); } }
#undef IN
#undef BOTH
}
static const int ST_PH_LO[10] = {1, 2, 3, 4, 5, 6, 7, 8, 10, 11}, ST_PH_HI[10] = {2, 3, 4, 5, 6, 7, 8, 10, 11, 12};
#ifndef OPT_MASK
#define OPT_MASK 0x3F3
#endif
extern "C" void kernel_launch(void* const* d_in, const int* in_sizes, int n_in, void* d_out, int out_size, void* d_ws, size_t ws_size, hipStream_t stream) {
    static int grid = 0;
    if (grid == 0) {
        if (n_in != 19 || out_size != M_TOK * DM || ws_size < WS_END) { fprintf(stderr, "kernel_launch: unexpected shapes (n_in %d out %d ws %zu)\n", n_in, out_size, ws_size); grid = -1; return; }
        int dev = 0, cus = 0, per_cu = 0;
        if (hipGetDevice(&dev) != hipSuccess || hipDeviceGetAttribute(&cus, hipDeviceAttributeMultiprocessorCount, dev) != hipSuccess) { grid = -1; return; }
        if (hipFuncSetAttribute((const void*)skel_fwd, hipFuncAttributeMaxDynamicSharedMemorySize, LDS_BYTES) != hipSuccess) { fprintf(stderr, "kernel_launch: hipFuncSetAttribute failed\n"); grid = -1; return; }
        if (hipOccupancyMaxActiveBlocksPerMultiprocessor(&per_cu, (const void*)skel_fwd, NWAVES * 64, LDS_BYTES) != hipSuccess || per_cu < 1) fprintf(stderr, "kernel_launch: occupancy query reports %d\n", per_cu);
        (void)hipGetLastError();
        grid = cus;
    }
    if (grid < 0) return;
    (void)hipMemsetAsync((char*)d_ws + WS_CTL, 0, CTL_ZERO_BYTES, stream);
    Args a{};
    for (int i = 0; i < 19; ++i) a.in[i] = (const float*)d_in[i];
    a.out = (float*)d_out; a.ws = (unsigned char*)d_ws;
    int li = 0;
    auto launch = [&](int lo, int hi) { a.ph_lo = lo; a.ph_hi = hi; a.li = li++; hipLaunchKernelGGL(skel_fwd, dim3(grid), dim3(NWAVES * 64), LDS_BYTES, stream, a); };
    const unsigned mask = OPT_MASK;
    int pend_lo = 0, pend_hi = 1;
    for (int s = 0; s < 10; ++s) {
#ifdef DBG_G1MASK
        if (s == 1 && (mask & 2u)) { launch(pend_lo, ST_PH_HI[1]); pend_lo = pend_hi = 0; gold_forward(d_in, (float*)d_out, (unsigned char*)d_ws, stream, 1, 2, DBG_G1MASK); continue; }
#endif
        if (mask & (1u << s)) { if (pend_hi == ST_PH_LO[s]) pend_hi = ST_PH_HI[s]; else { if (pend_hi > pend_lo) launch(pend_lo, pend_hi); pend_lo = ST_PH_LO[s]; pend_hi = ST_PH_HI[s]; } }
        else { if (pend_hi > pend_lo) launch(pend_lo, pend_hi); pend_lo = pend_hi = 0; gold_forward(d_in, (float*)d_out, (unsigned char*)d_ws, stream, s, s + 1); }
    }
    if (pend_hi > pend_lo) launch(pend_lo, pend_hi);
#ifdef PROBE_EXTRA
    launch(PROBE_EXTRA, PROBE_EXTRA + 1);
#endif
}
```

```cpp
#include <hip/hip_runtime.h>
#include <hip/hip_bf16.h>
#include <cstdint>
#include <cstdio>
#include <cmath>

typedef unsigned short bf16_t;
__device__ __forceinline__ float bf2f(bf16_t v) { return __uint_as_float(((unsigned)v) << 16); }
__device__ __forceinline__ bf16_t f2bf(float f) { unsigned u = __float_as_uint(f); return (bf16_t)((u + 0x7fffu + ((u >> 16) & 1u)) >> 16); }
#define LOG2E 1.4426950408889634f
#define QSCALE2 (0.125f * 1.4426950408889634f)

constexpr int M_TOK = 65536, DM = 1024, SEQ = 4096, NB = 16, DFF = 2816, INC = 5144;
constexpr size_t MiB = 1u << 20;
constexpr size_t WS_CTL = 0;
constexpr size_t WS_W = 1 * MiB;
constexpr size_t WS_A = 32 * MiB;
constexpr size_t WS_GQ = 160 * MiB, WS_GK = 192 * MiB, WS_GV = 224 * MiB, WS_GR = 288 * MiB, WS_FQ = 352 * MiB, WS_FK = 416 * MiB, WS_FV = 480 * MiB;
constexpr size_t WS_SG = 544 * MiB, WS_SF = 672 * MiB;
constexpr size_t WS_GLR = 800 * MiB, WS_LF2 = 804 * MiB, WS_C2S = 806 * MiB;
constexpr size_t WS_Y = 160 * MiB;
constexpr size_t WS_HM = 160 * MiB;
constexpr size_t WS_SS = 512 * 1024;
constexpr size_t WS_C = 832 * MiB;
constexpr size_t WS_END = 1008 * MiB;
#define OPT_MASK 0x3FF
namespace gold {
__device__ __forceinline__ float wsum(float v) {
#pragma unroll
    for (int o = 1; o < 64; o <<= 1) v += __shfl_xor(v, o);
    return v;
}
__device__ __forceinline__ float logsigmoidf_(float z) { return fminf(z, 0.f) - log1pf(expf(-fabsf(z))); }
__device__ __forceinline__ float sigmoidf_(float z) { return 1.f / (1.f + expf(-z)); }

__global__ void __launch_bounds__(256) k_rmsnorm_bf16(const float* x, const float* g, bf16_t* out, int rows) {
    const int w = (blockIdx.x * 256 + threadIdx.x) >> 6, lane = threadIdx.x & 63;
    if (w >= rows) return;
    const float* xr = x + (size_t)w * 1024;
    float v[16]; float s = 0.f;
#pragma unroll
    for (int j = 0; j < 16; ++j) { v[j] = xr[lane + 64 * j]; s += v[j] * v[j]; }
    s = wsum(s); const float rs = rsqrtf(s * (1.f / 1024.f) + 1e-6f);
#pragma unroll
    for (int j = 0; j < 16; ++j) out[(size_t)w * 1024 + lane + 64 * j] = f2bf(v[j] * rs * g[lane + 64 * j]);
}
__global__ void __launch_bounds__(256) k_rmsnorm_f32(float* x, const float* g, int rows) {
    const int w = (blockIdx.x * 256 + threadIdx.x) >> 6, lane = threadIdx.x & 63;
    if (w >= rows) return;
    float* xr = x + (size_t)w * 1024;
    float v[16]; float s = 0.f;
#pragma unroll
    for (int j = 0; j < 16; ++j) { v[j] = xr[lane + 64 * j]; s += v[j] * v[j]; }
    s = wsum(s); const float rs = rsqrtf(s * (1.f / 1024.f) + 1e-6f);
#pragma unroll
    for (int j = 0; j < 16; ++j) xr[lane + 64 * j] = v[j] * rs * g[lane + 64 * j];
}
__global__ void __launch_bounds__(256) k_gemm(const bf16_t* A, int lda, const float* W, int ldw, float* C, int ldc, int N, int K) {
    __shared__ float As[16][68]; __shared__ float Bs[16][68];
    const int t = threadIdx.x, tx = t & 15, ty = t >> 4;
    const int m0 = blockIdx.y * 64, n0 = blockIdx.x * 64;
    float acc[4][4];
#pragma unroll
    for (int i = 0; i < 4; ++i)
#pragma unroll
        for (int j = 0; j < 4; ++j) acc[i][j] = 0.f;
    const int ar = t >> 2, ak = (t & 3) * 4, bk = t >> 4, bn = (t & 15) * 4;
    for (int k0 = 0; k0 < K; k0 += 16) {
        const bf16_t* ap = A + (size_t)(m0 + ar) * lda + k0 + ak;
#pragma unroll
        for (int i = 0; i < 4; ++i) As[ak + i][ar] = bf2f(ap[i]);
        const float* wp = W + (size_t)(k0 + bk) * ldw + n0 + bn;
#pragma unroll
        for (int i = 0; i < 4; ++i) Bs[bk][bn + i] = (n0 + bn + i < N) ? wp[i] : 0.f;
        __syncthreads();
#pragma unroll
        for (int kk = 0; kk < 16; ++kk) {
            float a[4], b[4];
#pragma unroll
            for (int i = 0; i < 4; ++i) { a[i] = As[kk][ty * 4 + i]; b[i] = Bs[kk][tx * 4 + i]; }
#pragma unroll
            for (int i = 0; i < 4; ++i)
#pragma unroll
                for (int j = 0; j < 4; ++j) acc[i][j] += a[i] * b[j];
        }
        __syncthreads();
    }
#pragma unroll
    for (int i = 0; i < 4; ++i)
#pragma unroll
        for (int j = 0; j < 4; ++j) if (n0 + tx * 4 + j < N) C[(size_t)(m0 + ty * 4 + i) * ldc + n0 + tx * 4 + j] = acc[i][j];
}
__global__ void __launch_bounds__(256) k_inproj_epi(const float* P, int row0, const float* fb, const float* qg, const float* kg, const float* gate_b,
                                                    bf16_t* GQ, bf16_t* GK, bf16_t* GV, bf16_t* GR, float* GLR, bf16_t* FQ, bf16_t* FK, bf16_t* FV, float* LF2, bf16_t* SG, bf16_t* SF, int gm) {
    const int r = blockIdx.x, t = threadIdx.x; const float* p = P + (size_t)r * 5144; const size_t m = (size_t)row0 + r;
    if (gm & 1) { GQ[m * 256 + t] = f2bf(p[t] * 0.125f); GK[m * 256 + t] = f2bf(p[256 + t]); }
    if (gm & 1)
#pragma unroll
    for (int j = 0; j < 2; ++j) { const int c = t + 256 * j; GV[m * 512 + c] = f2bf(p[512 + c]); GR[m * 512 + c] = f2bf(p[1024 + c]); FV[m * 512 + c] = f2bf(p[2576 + c]); }
    if ((gm & 2) && t < 16) GLR[m * 16 + t] = p[1536 + t];
    if ((gm & 2) && t < 8) LF2[m * 8 + t] = logsigmoidf_(p[3088 + t] + fb[t]) * LOG2E;
    if (gm & 4)
#pragma unroll
    for (int j = 0; j < 2; ++j) { const int c = t + 256 * j;
        float v = p[1552 + c]; float rs = rsqrtf(wsum(v * v) * (1.f / 64.f) + 1e-6f); FQ[m * 512 + c] = f2bf(v * rs * qg[c & 63] * QSCALE2);
        v = p[2064 + c]; rs = rsqrtf(wsum(v * v) * (1.f / 64.f) + 1e-6f); FK[m * 512 + c] = f2bf(v * rs * kg[c & 63]); }
    if (gm & 8)
#pragma unroll
    for (int j = 0; j < 4; ++j) { const int c = t + 256 * j; const float sf_ = sigmoidf_(p[4120 + c] + gate_b[1024 + c]); SG[m * 1024 + c] = f2bf(sigmoidf_(p[3096 + c] + gate_b[c]) / sf_); SF[m * 1024 + c] = f2bf(sf_); }
}
__global__ void __launch_bounds__(256) k_gla(const bf16_t* GQ, const bf16_t* GK, const bf16_t* GV, const bf16_t* GR, const float* GLR, const float* w2, const float* ba, const float* gn, bf16_t* OGF) {
    __shared__ float sa[64], sq[64], sk[64], so[2][128], sred[4];
    const int bh = blockIdx.x, b = bh >> 2, h = bh & 3, t = threadIdx.x, dv = t & 127, dh = t >> 7;
    float S[32];
#pragma unroll
    for (int i = 0; i < 32; ++i) S[i] = 0.f;
    float w2c[16]; float bac = 0.f;
#pragma unroll
    for (int r = 0; r < 16; ++r) w2c[r] = (t < 64) ? w2[r * 256 + h * 64 + t] : 0.f;
    if (t < 64) bac = ba[h * 64 + t];
    const float gnv = gn[h * 128 + dv];
    for (int tok = 0; tok < 4096; ++tok) {
        const size_t m = (size_t)b * 4096 + tok;
        if (t < 64) { float z = bac;
#pragma unroll
            for (int r = 0; r < 16; ++r) z += GLR[m * 16 + r] * w2c[r];
            sa[t] = expf(logsigmoidf_(z) * (1.f / 16.f)); sq[t] = bf2f(GQ[m * 256 + h * 64 + t]); sk[t] = bf2f(GK[m * 256 + h * 64 + t]); }
        __syncthreads();
        const float v = bf2f(GV[m * 512 + h * 128 + dv]); float op = 0.f;
#pragma unroll
        for (int i = 0; i < 32; ++i) { const int d = 32 * dh + i; S[i] = sa[d] * S[i] + sk[d] * v; op += sq[d] * S[i]; }
        so[dh][dv] = op;
        __syncthreads();
        const float o = so[0][dv] + so[1][dv]; const float ss = wsum(o * o);
        if ((t & 63) == 0) sred[t >> 6] = ss;
        __syncthreads();
        const float tot = sred[0] + sred[1]; const float rs = rsqrtf(tot * (1.f / 128.f) + 1e-6f);
        if (dh == 0) { const float gr = bf2f(GR[m * 512 + h * 128 + dv]); OGF[m * 1024 + h * 128 + dv] = f2bf(o * rs * gnv * gr * sigmoidf_(gr)); }
    }
}
__global__ void __launch_bounds__(64) k_cumsum(const float* LF2, float* C2S) {
    const int bh = blockIdx.x, b = bh >> 3, h = bh & 7, lane = threadIdx.x;
    float s = 0.f;
    for (int i = 0; i < 64; ++i) s += LF2[((size_t)b * 4096 + lane * 64 + i) * 8 + h];
    float inc = s;
#pragma unroll
    for (int o = 1; o < 64; o <<= 1) { const float u = __shfl_up(inc, o); if (lane >= o) inc += u; }
    float run = inc - s;
    for (int i = 0; i < 64; ++i) { run += LF2[((size_t)b * 4096 + lane * 64 + i) * 8 + h]; C2S[(size_t)bh * 4096 + lane * 64 + i] = run; }
}
__global__ void __launch_bounds__(256) k_fox(const bf16_t* FQ, const bf16_t* FK, const bf16_t* FV, const float* C2S, bf16_t* OGF) {
    __shared__ float sk[64][64], sv[64][64], sc[64];
    const int qb = blockIdx.x, bh = blockIdx.y, b = bh >> 3, h = bh & 7, t = threadIdx.x, tq = qb * 256 + t;
    const size_t mq = (size_t)b * 4096 + tq;
    float q[64], o[64];
#pragma unroll
    for (int d = 0; d < 64; ++d) { q[d] = bf2f(FQ[mq * 512 + h * 64 + d]); o[d] = 0.f; }
    const float ct = C2S[(size_t)bh * 4096 + tq];
    float mr = -INFINITY, l = 0.f;
    const int ntile = (qb * 256 + 256) / 64;
    for (int kt = 0; kt < ntile; ++kt) {
        __syncthreads();
        for (int e = t; e < 4096; e += 256) { const int j = e >> 6, d = e & 63; const size_t mk = (size_t)b * 4096 + kt * 64 + j; sk[j][d] = bf2f(FK[mk * 512 + h * 64 + d]); sv[j][d] = bf2f(FV[mk * 512 + h * 64 + d]); }
        if (t < 64) sc[t] = C2S[(size_t)bh * 4096 + kt * 64 + t];
        __syncthreads();
        for (int j = 0; j < 64; ++j) {
            const int s = kt * 64 + j;
            if (s <= tq) {
                float dot = 0.f;
#pragma unroll
                for (int d = 0; d < 64; ++d) dot += q[d] * sk[j][d];
                const float lg = dot + ct - sc[j];
                const float mn = fmaxf(mr, lg), sc_ = exp2f(mr - mn), p = exp2f(lg - mn);
                l = l * sc_ + p;
#pragma unroll
                for (int d = 0; d < 64; ++d) o[d] = o[d] * sc_ + p * sv[j][d];
                mr = mn;
            }
        }
    }
    const float il = 1.f / l;
#pragma unroll
    for (int d = 0; d < 64; ++d) OGF[mq * 1024 + 512 + h * 64 + d] = f2bf(o[d] * il);
}
__global__ void __launch_bounds__(256) k_merge(const float* C1, const float* C2, const bf16_t* SG, const bf16_t* SF, bf16_t* Y, int row0, int n) {
    const int i = blockIdx.x * 256 + threadIdx.x; if (i >= n) return; const size_t g = (size_t)row0 * 1024 + i;
    Y[g] = f2bf(bf2f(SF[g]) * (bf2f(SG[g]) * C1[i] + C2[i]));
}
__global__ void __launch_bounds__(256) k_resid(const float* base, const float* C, float* out, int row0, int n) {
    const int i = blockIdx.x * 256 + threadIdx.x; if (i >= n) return; const size_t g = (size_t)row0 * 1024 + i;
    out[g] = base[g] + C[i];
}
__device__ __forceinline__ float gelu_tanh_(float x) { return 0.5f * x * (1.f + tanhf(0.7978845608028654f * (x + 0.044715f * x * x * x))); }
__global__ void __launch_bounds__(256) k_conv_gelu(const float* U, int row0, int rows, const float* cw, const float* cb, bf16_t* HM) {
    const size_t i = (size_t)blockIdx.x * 256 + threadIdx.x; if (i >= (size_t)rows * 2816) return;
    const int r = (int)(i / 2816), c = (int)(i % 2816); const int tok = (row0 + r) & 4095;
    const float a0 = U[(size_t)r * 5632 + c], a1 = tok >= 1 ? U[(size_t)(r - 1) * 5632 + c] : 0.f, a2 = tok >= 2 ? U[(size_t)(r - 2) * 5632 + c] : 0.f;
    const float cv = cb[c] + cw[c] * a2 + cw[2816 + c] * a1 + cw[2 * 2816 + c] * a0;
    HM[((size_t)row0 + r) * 2816 + c] = f2bf(gelu_tanh_(cv) * U[(size_t)r * 5632 + 2816 + c]);
}
}
static void gold_forward(void* const* d_in, float* out, unsigned char* ws, hipStream_t st, int s_lo, int s_hi, int gm1 = 15) {
    const float* x = (const float*)d_in[0];
    bf16_t* A = (bf16_t*)(ws + WS_A); bf16_t *GQ = (bf16_t*)(ws + WS_GQ), *GK = (bf16_t*)(ws + WS_GK), *GV = (bf16_t*)(ws + WS_GV), *GR = (bf16_t*)(ws + WS_GR);
    bf16_t *FQ = (bf16_t*)(ws + WS_FQ), *FK = (bf16_t*)(ws + WS_FK), *FV = (bf16_t*)(ws + WS_FV), *SG = (bf16_t*)(ws + WS_SG), *SF = (bf16_t*)(ws + WS_SF);
    float *GLR = (float*)(ws + WS_GLR), *LF2 = (float*)(ws + WS_LF2), *C2S = (float*)(ws + WS_C2S), *C1 = (float*)(ws + WS_C), *C2 = (float*)(ws + WS_C + 32 * MiB);
    bf16_t *Y = (bf16_t*)(ws + WS_Y), *HM = (bf16_t*)(ws + WS_HM);
    const int CH = 8192, NCH = M_TOK / CH;
#define ST(k) (s_lo <= (k) && (k) < s_hi)
    if (ST(0)) gold::k_rmsnorm_bf16<<<M_TOK / 4, 256, 0, st>>>(x, (const float*)d_in[1], A, M_TOK);
    if (ST(1)) for (int c = 0; c < NCH; ++c) {
        gold::k_gemm<<<dim3((INC + 63) / 64, CH / 64), 256, 0, st>>>(A + (size_t)c * CH * 1024, 1024, (const float*)d_in[2], INC, C1, INC, INC, 1024);
        gold::k_inproj_epi<<<CH, 256, 0, st>>>(C1, c * CH, (const float*)d_in[6], (const float*)d_in[7], (const float*)d_in[8], (const float*)d_in[9], GQ, GK, GV, GR, GLR, FQ, FK, FV, LF2, SG, SF, gm1);
    }
    if (ST(2)) gold::k_gla<<<64, 256, 0, st>>>(GQ, GK, GV, GR, GLR, (const float*)d_in[3], (const float*)d_in[4], (const float*)d_in[5], A);
    if (ST(3)) { gold::k_cumsum<<<128, 64, 0, st>>>(LF2, C2S); gold::k_fox<<<dim3(16, 128), 256, 0, st>>>(FQ, FK, FV, C2S, A); }
    if (ST(4)) for (int c = 0; c < NCH; ++c) {
        gold::k_gemm<<<dim3(16, CH / 64), 256, 0, st>>>(A + (size_t)c * CH * 1024, 1024, (const float*)d_in[10], 1024, C1, 1024, 1024, 512);
        gold::k_gemm<<<dim3(16, CH / 64), 256, 0, st>>>(A + (size_t)c * CH * 1024 + 512, 1024, (const float*)d_in[11], 1024, C2, 1024, 1024, 512);
        gold::k_merge<<<CH * 1024 / 256, 256, 0, st>>>(C1, C2, SG, SF, Y, c * CH, CH * 1024);
    }
    if (ST(5)) for (int c = 0; c < NCH; ++c) {
        gold::k_gemm<<<dim3(16, CH / 64), 256, 0, st>>>(Y + (size_t)c * CH * 1024, 1024, (const float*)d_in[12], 1024, C1, 1024, 1024, 1024);
        gold::k_resid<<<CH * 1024 / 256, 256, 0, st>>>(x, C1, out, c * CH, CH * 1024);
    }
    if (ST(6)) gold::k_rmsnorm_bf16<<<M_TOK / 4, 256, 0, st>>>(out, (const float*)d_in[13], A, M_TOK);
    if (ST(7)) for (int c = 0; c < NCH; ++c) {
        gold::k_gemm<<<dim3(5632 / 64, CH / 64), 256, 0, st>>>(A + (size_t)c * CH * 1024, 1024, (const float*)d_in[14], 5632, C1, 5632, 5632, 1024);
        gold::k_conv_gelu<<<(unsigned)(((size_t)CH * 2816 + 255) / 256), 256, 0, st>>>(C1, c * CH, CH, (const float*)d_in[15], (const float*)d_in[16], HM);
    }
    if (ST(8)) for (int c = 0; c < NCH; ++c) {
        gold::k_gemm<<<dim3(16, CH / 64), 256, 0, st>>>(HM + (size_t)c * CH * 2816, 2816, (const float*)d_in[17], 1024, C1, 1024, 1024, 2816);
        gold::k_resid<<<CH * 1024 / 256, 256, 0, st>>>(out, C1, out, c * CH, CH * 1024);
    }
    if (ST(9)) gold::k_rmsnorm_f32<<<M_TOK / 4, 256, 0, st>>>(out, (const float*)d_in[18], M_TOK);
#undef ST
}
namespace pg8 {
#define PG8_LAS __attribute__((address_space(3)))
typedef unsigned short bf16_t;
typedef short bf16x8 __attribute__((ext_vector_type(8)));
typedef float f32x4 __attribute__((ext_vector_type(4)));
typedef unsigned u32x4 __attribute__((ext_vector_type(4)));
constexpr int BM = 256, BK = 64, HALF = 128, HTB = HALF * BK * 2  , STAGE_BYTES = 8 * HTB, NXCD = 8, WGM = 8;

__host__ __device__ __forceinline__ int lds_byte(int r, int c) { const int st = (r >> 4) * 2 + (c >> 5), rr = r & 15, cc = c & 31, ob = rr * 64 + cc * 2; return st * 1024 + (ob ^ (((ob >> 9) & 1) << 5)); }
__host__ __device__ __forceinline__ void stage_rc(int b, int& R, int& C) { const int st = b / 1024, sb = b % 1024, swz = sb ^ (((sb >> 9) & 1) << 5); R = (st >> 1) * 16 + swz / 64; C = (st & 1) * 32 + (swz % 64) / 2; }
__host__ __device__ __forceinline__ int perm32(int rho) { const int n = rho >> 4, i = rho & 15; return 8 * (i >> 2) + 4 * n + (i & 3); }

struct Unit { int pm, pn; };
struct Gemm { const bf16_t* A; const bf16_t* Bt; int M, N, K; };

struct StaticOrder {
    int nM, nN, nwg, G, c;
    __host__ __device__ void init(int M, int N, int G_, int c_) { nM = M / BM; nN = N / BM; nwg = nM * nN; G = G_; c = c_; }
    __host__ __device__ bool next(int i, Unit& u) const {
        const long L = (long)i * G + c; if (L >= nwg) return false;
        int wgid = (int)L; { const int q = nwg / NXCD, r = nwg % NXCD, xcd = wgid % NXCD, off = wgid / NXCD; wgid = (xcd < r ? xcd * (q + 1) : r * (q + 1) + (xcd - r) * q) + off; }
        const int nig = WGM * nN, gid = wgid / nig, fm = gid * WGM, gsz = (nM - fm) < WGM ? (nM - fm) : WGM;
        u.pm = fm + ((wgid % nig) % gsz); u.pn = (wgid % nig) / gsz; return true;
    }
    __device__ __forceinline__ void a_ready(const Unit&) const {}
    __device__ __forceinline__ void done(const Unit&) const {}
};

typedef float f32x2 __attribute__((ext_vector_type(2))); typedef __bf16 bf16x2_t __attribute__((ext_vector_type(2)));
__device__ __forceinline__ unsigned cvt_pk_bf16(float lo, float hi) { f32x2 v = {lo, hi}; bf16x2_t b = __builtin_convertvector(v, bf16x2_t); return __builtin_bit_cast(unsigned, b); }
template <class Epi, class Sched, bool ALIGN_EPI = false, bool SP2 = false>
__device__ __forceinline__ void gemm_phase(PG8_LAS unsigned char* lds, const Gemm g, const Sched& S, const Epi& E) {
    const int tid = threadIdx.x, wid = __builtin_amdgcn_readfirstlane(tid >> 6), lane = tid & 63, wr = wid >> 2, wc = wid & 3, fr = lane & 15, fq = lane >> 4;
    const int K = g.K, nt = K / BK;
    unsigned voffA[2], voffB[2];
#pragma unroll
    for (int i = 0; i < 2; ++i) { int R, C; stage_rc(tid * 16 + i * 8192, R, C); const int Rb = Epi::PERM ? ((R & ~31) + perm32(R & 31)) : R;
        voffA[i] = (unsigned)(R * K + C) * 2u; voffB[i] = (unsigned)(Rb * K + C) * 2u; }
    const size_t kstep = (size_t)(BK * 2);
    const size_t hstep = (size_t)HALF * K * 2;
    const size_t tstep = 2 * hstep;
    const unsigned ldsw = (unsigned)wid * 1024u;
    const int aoff = lds_byte(wr * 64 + fr, fq * 8), boff = lds_byte(wc * 32 + fr, fq * 8);
#define PG8_SA(b, h) (((b) * 2 + (h)) * HTB)
#define PG8_SB(b, h) ((4 + (b) * 2 + (h)) * HTB)
#define PG8_STAGE(bufoff, gbase, voff) do { _Pragma("unroll") for (int _i = 0; _i < 2; ++_i) \
        __builtin_amdgcn_global_load_lds((const unsigned*)((const char*)(gbase) + (voff)[_i]), (PG8_LAS unsigned*)(lds + (bufoff) + ldsw + _i * 8192), 16, 0, 0); } while (0)
#define PG8_LDA(dst, b, h) do { _Pragma("unroll") for (int m = 0; m < 4; ++m) _Pragma("unroll") for (int k = 0; k < 2; ++k) dst[m][k] = *(const PG8_LAS bf16x8*)(lds + PG8_SA(b, h) + aoff + m * 2048 + k * 1024); } while (0)
#define PG8_LDB(dst, b, h) do { _Pragma("unroll") for (int n = 0; n < 2; ++n) _Pragma("unroll") for (int k = 0; k < 2; ++k) dst[n][k] = *(const PG8_LAS bf16x8*)(lds + PG8_SB(b, h) + boff + n * 2048 + k * 1024); } while (0)
#define PG8_MMA(ai, bj, At, Bt) do { __builtin_amdgcn_s_setprio(1); _Pragma("unroll") for (int m = 0; m < 4; ++m) _Pragma("unroll") for (int n = 0; n < 2; ++n) _Pragma("unroll") for (int k = 0; k < 2; ++k) \
        acc[ai][bj][m][n] = __builtin_amdgcn_mfma_f32_16x16x32_bf16(Bt[n][k], At[m][k], acc[ai][bj][m][n], 0, 0, 0); __builtin_amdgcn_s_setprio(0); } while (0)
#define PG8_WAIT_V(n) asm volatile("s_waitcnt vmcnt(" #n ")" ::: "memory")
#define PG8_WAIT_L(n) asm volatile("s_waitcnt lgkmcnt(" #n ")" ::: "memory")
#define PG8_BAR __builtin_amdgcn_s_barrier()
#define PG8_SCHED __builtin_amdgcn_sched_barrier(0)
    Unit cur, nxt; int ui = 0;
    if (!S.next(0, cur)) return;
    f32x4 acc[2][2][4][2];
#pragma unroll
    for (int a = 0; a < 2; ++a)
#pragma unroll
        for (int b = 0; b < 2; ++b)
#pragma unroll
            for (int m = 0; m < 4; ++m)
#pragma unroll
                for (int n = 0; n < 2; ++n) acc[a][b][m][n] = (f32x4){0.f, 0.f, 0.f, 0.f};
    bf16x8 At[4][2], B0[2][2], B1[2][2];
    const char* cA = (const char*)g.A + (size_t)cur.pm * tstep; const char* cB = (const char*)g.Bt + (size_t)cur.pn * tstep;
    S.a_ready(cur);
    if constexpr (SP2) {
        PG8_STAGE(PG8_SB(0, 0), cB, voffB); PG8_STAGE(PG8_SB(0, 1), cB + hstep, voffB); PG8_STAGE(PG8_SA(0, 0), cA, voffA); PG8_STAGE(PG8_SA(0, 1), cA + hstep, voffA);
        if (wr == 1) PG8_BAR;
        PG8_WAIT_V(2); PG8_BAR;
        PG8_STAGE(PG8_SB(1, 0), cB + kstep, voffB); PG8_STAGE(PG8_SA(1, 0), cA + kstep, voffA); PG8_STAGE(PG8_SB(1, 1), cB + hstep + kstep, voffB);
        PG8_WAIT_V(6); PG8_BAR;
    } else {
        PG8_STAGE(PG8_SB(0, 0), cB, voffB); PG8_STAGE(PG8_SA(0, 0), cA, voffA); PG8_STAGE(PG8_SB(0, 1), cB + hstep, voffB); PG8_STAGE(PG8_SA(0, 1), cA + hstep, voffA);
        if (wr == 1) PG8_BAR;
        PG8_WAIT_V(4); PG8_BAR;
        PG8_STAGE(PG8_SB(1, 0), cB + kstep, voffB); PG8_STAGE(PG8_SA(1, 0), cA + kstep, voffA); PG8_STAGE(PG8_SB(1, 1), cB + hstep + kstep, voffB);
        PG8_WAIT_V(6); PG8_BAR;
    }
    for (;;) {
        const bool has_next = S.next(ui + 1, nxt);
        const char* nA = has_next ? (const char*)g.A + (size_t)nxt.pm * tstep : cA; const char* nB = has_next ? (const char*)g.Bt + (size_t)nxt.pn * tstep : cB;
        for (int t = 0; t < nt; t += 2) {
            if constexpr (Epi::MIDK) { if (t == nt / 2) { PG8_SCHED; E.mid(acc, cur, wr, wc, fr, fq); PG8_SCHED; } }
            const bool last = (t == nt - 2);
            const char* a1 = cA + (size_t)(t + 1) * kstep;
            const char* a2 = last ? nA : cA + (size_t)(t + 2) * kstep; const char* b2 = last ? nB : cB + (size_t)(t + 2) * kstep;
            const char* a3 = a2 + kstep; const char* b3 = b2 + kstep;
            if (last && has_next) S.a_ready(nxt);
            if constexpr (SP2) {
            PG8_LDB(B0, 0, 0); PG8_LDB(B1, 0, 1); PG8_SCHED; PG8_LDA(At, 0, 0); PG8_STAGE(PG8_SA(1, 1), a1 + hstep, voffA);
            PG8_WAIT_V(8); PG8_WAIT_L(0); PG8_BAR; PG8_MMA(0, 0, At, B0); PG8_MMA(0, 1, At, B1); PG8_BAR; PG8_SCHED;
            PG8_LDA(At, 0, 1); PG8_STAGE(PG8_SB(0, 0), b2, voffB); PG8_STAGE(PG8_SB(0, 1), b2 + hstep, voffB); PG8_STAGE(PG8_SA(0, 0), a2, voffA);
            PG8_WAIT_V(8); PG8_WAIT_L(0); PG8_BAR; PG8_MMA(1, 0, At, B0); PG8_MMA(1, 1, At, B1); PG8_BAR; PG8_SCHED;
            PG8_LDB(B0, 1, 0); PG8_LDB(B1, 1, 1); PG8_SCHED; PG8_LDA(At, 1, 0); PG8_STAGE(PG8_SA(0, 1), a2 + hstep, voffA);
            PG8_WAIT_V(8); PG8_WAIT_L(0); PG8_BAR; PG8_MMA(0, 0, At, B0); PG8_MMA(0, 1, At, B1); PG8_BAR; PG8_SCHED;
            PG8_LDA(At, 1, 1); PG8_STAGE(PG8_SB(1, 0), b3, voffB); PG8_STAGE(PG8_SB(1, 1), b3 + hstep, voffB); PG8_STAGE(PG8_SA(1, 0), a3, voffA);
            PG8_WAIT_V(8); PG8_WAIT_L(0); PG8_BAR; PG8_MMA(1, 0, At, B0); PG8_MMA(1, 1, At, B1); PG8_BAR; PG8_SCHED;
            } else {
            PG8_LDB(B0, 0, 0); PG8_SCHED; PG8_LDA(At, 0, 0); PG8_STAGE(PG8_SA(1, 1), a1 + hstep, voffA);
            PG8_WAIT_L(8); PG8_BAR; PG8_WAIT_L(0); PG8_MMA(0, 0, At, B0); PG8_BAR; PG8_SCHED;
            PG8_LDB(B1, 0, 1); PG8_STAGE(PG8_SB(0, 0), b2, voffB);
            PG8_BAR; PG8_WAIT_L(0); PG8_MMA(0, 1, At, B1); PG8_BAR;
            PG8_LDA(At, 0, 1); PG8_STAGE(PG8_SA(0, 0), a2, voffA);
            PG8_BAR; PG8_WAIT_L(0); PG8_MMA(1, 0, At, B0); PG8_BAR; PG8_SCHED;
            PG8_STAGE(PG8_SB(0, 1), b2 + hstep, voffB);
            PG8_WAIT_V(6); PG8_BAR; PG8_MMA(1, 1, At, B1); PG8_BAR;
            PG8_LDB(B0, 1, 0); PG8_SCHED; PG8_LDA(At, 1, 0); PG8_STAGE(PG8_SA(0, 1), a2 + hstep, voffA);
            PG8_WAIT_L(8); PG8_BAR; PG8_WAIT_L(0); PG8_MMA(0, 0, At, B0); PG8_BAR; PG8_SCHED;
            PG8_LDB(B1, 1, 1); PG8_STAGE(PG8_SB(1, 0), b3, voffB);
            PG8_BAR; PG8_WAIT_L(0); PG8_MMA(0, 1, At, B1); PG8_BAR;
            PG8_LDA(At, 1, 1); PG8_STAGE(PG8_SA(1, 0), a3, voffA);
            PG8_BAR; PG8_WAIT_L(0); PG8_MMA(1, 0, At, B0); PG8_BAR; PG8_SCHED;
            PG8_STAGE(PG8_SB(1, 1), b3 + hstep, voffB);
            PG8_WAIT_V(6); PG8_BAR; PG8_MMA(1, 1, At, B1); PG8_BAR;
            }
        }
        if constexpr (ALIGN_EPI) { if (wr == 0) PG8_BAR; }
        if constexpr (!Epi::AFTER_DRAIN) { E(acc, cur, wr, wc, fr, fq); S.done(cur); }
        if (!has_next) break;
#pragma unroll
        for (int a = 0; a < 2; ++a)
#pragma unroll
            for (int b = 0; b < 2; ++b)
#pragma unroll
                for (int m = 0; m < 4; ++m)
#pragma unroll
                    for (int n = 0; n < 2; ++n) acc[a][b][m][n] = (f32x4){0.f, 0.f, 0.f, 0.f};
        cur = nxt; cA = nA; cB = nB; ++ui;
        if constexpr (ALIGN_EPI) { if (wr == 1) PG8_BAR; }
    }
    PG8_WAIT_V(0);
    if constexpr (!ALIGN_EPI) { if (wr == 0) PG8_BAR; }
    PG8_BAR;
    if constexpr (Epi::AFTER_DRAIN) { E.fused(acc, cur, wr, wc, fr, fq, lds, wid, lane); S.done(cur); }
#undef PG8_SA
#undef PG8_SB
#undef PG8_STAGE
#undef PG8_LDA
#undef PG8_LDB
#undef PG8_MMA
#undef PG8_WAIT_V
#undef PG8_WAIT_L
#undef PG8_BAR
#undef PG8_SCHED
}
}
namespace pg8 {
typedef unsigned u32x2 __attribute__((ext_vector_type(2)));
__device__ __forceinline__ u32x4 pack8(f32x4 a, f32x4 b) { u32x4 w; w.x = cvt_pk_bf16(a[0], a[1]); w.y = cvt_pk_bf16(a[2], a[3]); w.z = cvt_pk_bf16(b[0], b[1]); w.w = cvt_pk_bf16(b[2], b[3]); return w; }
__device__ __forceinline__ float bflo(unsigned w) { return __uint_as_float(w << 16); }
__device__ __forceinline__ float bfhi(unsigned w) { return __uint_as_float(w & 0xffff0000u); }
__device__ __forceinline__ void unpack8(u32x4 w, f32x4& a, f32x4& b) { a = (f32x4){bflo(w.x), bfhi(w.x), bflo(w.y), bfhi(w.y)}; b = (f32x4){bflo(w.z), bfhi(w.z), bflo(w.w), bfhi(w.w)}; }
__device__ __forceinline__ float fast_sigmoid(float z) { return __builtin_amdgcn_rcpf(1.f + __builtin_amdgcn_exp2f(-LOG2E * z)); }
__device__ __forceinline__ f32x4 sig4(f32x4 z) { return (f32x4){fast_sigmoid(z[0]), fast_sigmoid(z[1]), fast_sigmoid(z[2]), fast_sigmoid(z[3])}; }
__device__ __forceinline__ float logsig(float z) { return fminf(z, 0.f) - log1pf(expf(-fabsf(z))); }

struct EpiInProj {
    static constexpr bool PERM = true, AFTER_DRAIN = false, MIDK = false;
    bf16_t *GQ, *GK, *GV, *GR, *FQ, *FK, *FV, *SG, *SF; float *GLR, *LF2; const float *fb, *qg, *kg, *gate_b;
    __device__ __forceinline__ void operator()(const f32x4 (&acc)[2][2][4][2], const Unit& u, int wr, int wc, int fr, int fq) const {
        const int pn = u.pn; const size_t row0 = (size_t)u.pm * BM + wr * 64 + fr; const int qc = 64 * wc + 8 * fq;
        if (pn < 6 || pn == 10 || pn == 11) {
            bf16_t* base; int ld, col0; float sc = 1.f;
            if (pn == 0) { base = GQ; ld = 256; col0 = 0; sc = 0.125f; } else if (pn == 1) { base = GK; ld = 256; col0 = 0; }
            else if (pn < 4) { base = GV; ld = 512; col0 = 256 * (pn - 2); } else if (pn < 6) { base = GR; ld = 512; col0 = 256 * (pn - 4); } else { base = FV; ld = 512; col0 = 256 * (pn - 10); }
#pragma unroll
            for (int ai = 0; ai < 2; ++ai)
#pragma unroll
                for (int m = 0; m < 4; ++m) { bf16_t* rp = base + (row0 + ai * HALF + m * 16) * ld + col0 + qc;
#pragma unroll
                    for (int bj = 0; bj < 2; ++bj) *(u32x4*)(rp + 32 * bj) = pack8(acc[ai][bj][m][0] * sc, acc[ai][bj][m][1] * sc); }
        } else if (pn < 10) {
            const bool isq = pn < 8; bf16_t* base = isq ? FQ : FK; const float* g = isq ? qg : kg; const int head = 4 * ((pn - 6) & 1) + wc; const float osc = isq ? QSCALE2 : 1.f;
            f32x4 gv[2][2];
#pragma unroll
            for (int bj = 0; bj < 2; ++bj)
#pragma unroll
                for (int n = 0; n < 2; ++n) gv[bj][n] = *(const f32x4*)(g + 32 * bj + 8 * fq + 4 * n);
#pragma unroll
            for (int ai = 0; ai < 2; ++ai)
#pragma unroll
                for (int m = 0; m < 4; ++m) { float ss = 0.f;
#pragma unroll
                    for (int bj = 0; bj < 2; ++bj)
#pragma unroll
                        for (int n = 0; n < 2; ++n) { const f32x4 x = acc[ai][bj][m][n]; ss += (x[0] * x[0] + x[1] * x[1]) + (x[2] * x[2] + x[3] * x[3]); }
                    ss += __shfl_xor(ss, 16); ss += __shfl_xor(ss, 32);
                    const float rs = rsqrtf(ss * (1.f / 64.f) + 1e-6f) * osc;
                    bf16_t* rp = base + (row0 + ai * HALF + m * 16) * 512 + 64 * head + 8 * fq;
#pragma unroll
                    for (int bj = 0; bj < 2; ++bj) *(u32x4*)(rp + 32 * bj) = pack8(acc[ai][bj][m][0] * rs * gv[bj][0], acc[ai][bj][m][1] * rs * gv[bj][1]); }
        } else if (pn < 20) {
            const int ch0 = 128 * (pn - 12) + 32 * wc + 8 * fq;
            f32x4 bg[2], bf_[2];
#pragma unroll
            for (int n = 0; n < 2; ++n) { bg[n] = *(const f32x4*)(gate_b + ch0 + 4 * n); bf_[n] = *(const f32x4*)(gate_b + 1024 + ch0 + 4 * n); }
#pragma unroll
            for (int ai = 0; ai < 2; ++ai)
#pragma unroll
                for (int m = 0; m < 4; ++m) { const size_t off = (row0 + ai * HALF + m * 16) * 1024 + ch0; f32x4 r[2], s[2];
#pragma unroll
                    for (int n = 0; n < 2; ++n)
#pragma unroll
                        for (int i = 0; i < 4; ++i) { const float eg = __builtin_amdgcn_exp2f(-LOG2E * (acc[ai][0][m][n][i] + bg[n][i])), ef = __builtin_amdgcn_exp2f(-LOG2E * (acc[ai][1][m][n][i] + bf_[n][i]));
                            s[n][i] = __builtin_amdgcn_rcpf(1.f + ef); r[n][i] = (1.f + ef) * __builtin_amdgcn_rcpf(1.f + eg); }
                    *(u32x4*)(SG + off) = pack8(r[0], r[1]); *(u32x4*)(SF + off) = pack8(s[0], s[1]); }
        } else {
            if (wc == 0 && fq < 3) {
                const f32x4 f0 = *(const f32x4*)fb, f1 = *(const f32x4*)(fb + 4);
#pragma unroll
                for (int ai = 0; ai < 2; ++ai)
#pragma unroll
                    for (int m = 0; m < 4; ++m) { const size_t row = row0 + ai * HALF + m * 16; const f32x4 v0 = acc[ai][0][m][0], v1 = acc[ai][0][m][1];
                        if (fq < 2) { *(f32x4*)(GLR + row * 16 + 8 * fq) = v0; *(f32x4*)(GLR + row * 16 + 8 * fq + 4) = v1; }
                        else { f32x4 o0, o1;
#pragma unroll
                            for (int i = 0; i < 4; ++i) { o0[i] = logsig(v0[i] + f0[i]) * LOG2E; o1[i] = logsig(v1[i] + f1[i]) * LOG2E; }
                            *(f32x4*)(LF2 + row * 8) = o0; *(f32x4*)(LF2 + row * 8 + 4) = o1; } }
            }
        }
    }
};
struct EpiMerge {
    static constexpr bool PERM = true, AFTER_DRAIN = false, MIDK = true;
    const bf16_t *SG, *SF; bf16_t* Y;
    __device__ __forceinline__ void mid(f32x4 (&acc)[2][2][4][2], const Unit& u, int wr, int wc, int fr, int fq) const {
        asm volatile("" : "+v"(fr), "+v"(fq));
        const size_t row0 = (size_t)u.pm * BM + wr * 64 + fr; const int col = u.pn * BM + 64 * wc + 8 * fq;
#pragma unroll
        for (int ai = 0; ai < 2; ++ai)
#pragma unroll
            for (int m = 0; m < 4; ++m) { const size_t off = (row0 + ai * HALF + m * 16) * 1024 + col;
#pragma unroll
                for (int bj = 0; bj < 2; ++bj) { f32x4 g0, g1; unpack8(*(const u32x4*)(SG + off + 32 * bj), g0, g1); acc[ai][bj][m][0] *= g0; acc[ai][bj][m][1] *= g1; }
                asm volatile("" : "+v"(acc[ai][0][m][0]), "+v"(acc[ai][0][m][1]), "+v"(acc[ai][1][m][0]), "+v"(acc[ai][1][m][1]));
                if (m & 1) asm volatile("" ::: "memory"); }
    }
    __device__ __forceinline__ void operator()(const f32x4 (&acc)[2][2][4][2], const Unit& u, int wr, int wc, int fr, int fq) const {
        const size_t row0 = (size_t)u.pm * BM + wr * 64 + fr; const int col = u.pn * BM + 64 * wc + 8 * fq;
#pragma unroll
        for (int ai = 0; ai < 2; ++ai)
#pragma unroll
            for (int m = 0; m < 4; ++m) { const size_t off = (row0 + ai * HALF + m * 16) * 1024 + col;
#pragma unroll
                for (int bj = 0; bj < 2; ++bj) { f32x4 s0, s1; unpack8(*(const u32x4*)(SF + off + 32 * bj), s0, s1); *(u32x4*)(Y + off + 32 * bj) = pack8(acc[ai][bj][m][0] * s0, acc[ai][bj][m][1] * s1); } }
    }
};
struct EpiOut {
    static constexpr bool PERM = true, AFTER_DRAIN = false, MIDK = false;
    const float* x; bf16_t* x1b; float* ss;
    __device__ __forceinline__ void operator()(const f32x4 (&acc)[2][2][4][2], const Unit& u, int wr, int wc, int fr, int fq) const {
        const size_t row0 = (size_t)u.pm * BM + wr * 64 + fr; const int col = u.pn * BM + 64 * wc + 8 * fq;
#pragma unroll
        for (int ai = 0; ai < 2; ++ai)
#pragma unroll
            for (int m = 0; m < 4; ++m) { const size_t row = row0 + ai * HALF + m * 16, off = row * 1024 + col; float sq = 0.f;
#pragma unroll
                for (int bj = 0; bj < 2; ++bj) { const f32x4 v0 = *(const f32x4*)(x + off + 32 * bj) + acc[ai][bj][m][0], v1 = *(const f32x4*)(x + off + 32 * bj + 4) + acc[ai][bj][m][1];
                    sq += (v0[0] * v0[0] + v0[1] * v0[1]) + (v0[2] * v0[2] + v0[3] * v0[3]) + (v1[0] * v1[0] + v1[1] * v1[1]) + (v1[2] * v1[2] + v1[3] * v1[3]);
                    *(u32x4*)(x1b + off + 32 * bj) = pack8(v0, v1); }
                sq += __shfl_xor(sq, 16); sq += __shfl_xor(sq, 32);
                if (fq == 0) atomicAdd(ss + row, sq); }
    }
};
struct EpiDown {
    static constexpr bool PERM = true, AFTER_DRAIN = false, MIDK = false;
    const bf16_t* x1b; bf16_t* x2b; float* ss;
    __device__ __forceinline__ void operator()(const f32x4 (&acc)[2][2][4][2], const Unit& u, int wr, int wc, int fr, int fq) const {
        const size_t row0 = (size_t)u.pm * BM + wr * 64 + fr; const int col = u.pn * BM + 64 * wc + 8 * fq;
#pragma unroll
        for (int ai = 0; ai < 2; ++ai)
#pragma unroll
            for (int m = 0; m < 4; ++m) { const size_t row = row0 + ai * HALF + m * 16, off = row * 1024 + col; float sq = 0.f;
#pragma unroll
                for (int bj = 0; bj < 2; ++bj) { f32x4 b0, b1; unpack8(*(const u32x4*)(x1b + off + 32 * bj), b0, b1); const f32x4 v0 = b0 + acc[ai][bj][m][0], v1 = b1 + acc[ai][bj][m][1];
                    sq += (v0[0] * v0[0] + v0[1] * v0[1]) + (v0[2] * v0[2] + v0[3] * v0[3]) + (v1[0] * v1[0] + v1[1] * v1[1]) + (v1[2] * v1[2] + v1[3] * v1[3]);
                    *(u32x4*)(x2b + off + 32 * bj) = pack8(v0, v1); }
                sq += __shfl_xor(sq, 16); sq += __shfl_xor(sq, 32);
                if (fq == 0) atomicAdd(ss + row, sq); }
    }
};
template <int CTRL> __device__ __forceinline__ float dppmov(float v) { return __builtin_bit_cast(float, __builtin_amdgcn_update_dpp(0, __builtin_bit_cast(int, v), CTRL, 0xf, 0xf, false)); }
__device__ __forceinline__ float gelu_tanh_fast(float x) { const float u = x * (1.f + 0.044715f * x * x); return x * __builtin_amdgcn_rcpf(1.f + __builtin_amdgcn_exp2f(-1.5957691216057308f * LOG2E * u)); }
struct EpiUp {
    static constexpr bool PERM = true, AFTER_DRAIN = false, MIDK = false;
    bf16_t* HM; float* EDGE; const float *cw, *cb, *ss;
    __device__ __forceinline__ void operator()(const f32x4 (&acc)[2][2][4][2], const Unit& u, int wr, int wc, int fr, int fq) const {
        const int ch0 = 128 * u.pn + 32 * wc + 8 * fq;
        f32x4 w0[2], w1[2], w2[2], bb[2];
#pragma unroll
        for (int n = 0; n < 2; ++n) { w0[n] = *(const f32x4*)(cw + ch0 + 4 * n); w1[n] = *(const f32x4*)(cw + 2816 + ch0 + 4 * n); w2[n] = *(const f32x4*)(cw + 5632 + ch0 + 4 * n); bb[n] = *(const f32x4*)(cb + ch0 + 4 * n); }
#pragma unroll
        for (int ai = 0; ai < 2; ++ai) {
            const size_t rowg = (size_t)u.pm * BM + ai * HALF + wr * 64;
            f32x4 ar[4][2], vr[4][2];
#pragma unroll
            for (int m = 0; m < 4; ++m) { const float rs = rsqrtf(ss[rowg + m * 16 + fr] * (1.f / 1024.f) + 1e-6f);
#pragma unroll
                for (int n = 0; n < 2; ++n) { ar[m][n] = acc[ai][0][m][n] * rs; vr[m][n] = acc[ai][1][m][n] * rs; } }
            float* eg = EDGE + (rowg >> 6) * (size_t)(6 * 2816) + ch0;
            if (fr < 2) {
#pragma unroll
                for (int n = 0; n < 2; ++n) { *(f32x4*)(eg + fr * 2816 + 4 * n) = ar[0][n]; *(f32x4*)(eg + (4 + fr) * 2816 + 4 * n) = vr[0][n]; } }
            if (fr >= 14) {
#pragma unroll
                for (int n = 0; n < 2; ++n) *(f32x4*)(eg + (fr - 12) * 2816 + 4 * n) = ar[3][n]; }
#pragma unroll
            for (int m = 0; m < 4; ++m) { f32x4 h[2];
#pragma unroll
                for (int n = 0; n < 2; ++n)
#pragma unroll
                    for (int i = 0; i < 4; ++i) { const float a0 = ar[m][n][i];
                        float a1 = dppmov<0x111>(a0), a2 = dppmov<0x112>(a0);
                        if (m > 0) { const float p = ar[m - 1][n][i]; const float p1 = dppmov<0x121>(p), p2 = dppmov<0x122>(p);
                            a1 = fr == 0 ? p1 : a1; a2 = fr < 2 ? p2 : a2; }
                        const float cv = bb[n][i] + w0[n][i] * a2 + w1[n][i] * a1 + w2[n][i] * a0;
                        h[n][i] = gelu_tanh_fast(cv) * vr[m][n][i]; }
                *(u32x4*)(HM + (rowg + m * 16 + fr) * 2816 + ch0) = pack8(h[0], h[1]); }
        }
    }
};
}
#define GAS __attribute__((address_space(1)))
#define LAS __attribute__((address_space(3)))
typedef unsigned v4u __attribute__((ext_vector_type(4)));
typedef float f32x4 __attribute__((ext_vector_type(4)));
typedef short bf16x8 __attribute__((ext_vector_type(8)));
typedef GAS unsigned gu32;
typedef GAS unsigned long long gu64;
#define RLX_AGENT __ATOMIC_RELAXED, __HIP_MEMORY_SCOPE_AGENT
#define LDS_WAIT() asm volatile("s_waitcnt lgkmcnt(0)" ::: "memory")
#define VM_WAIT() asm volatile("s_waitcnt vmcnt(0)" ::: "memory")
__device__ __forceinline__ unsigned long long rt() { return __builtin_amdgcn_s_memrealtime(); }
__device__ __forceinline__ unsigned pk2(float lo, float hi) { return (unsigned)f2bf(lo) | ((unsigned)f2bf(hi) << 16); }
#define XB_TMO      128
#define XB_XCNT(j)  (256  + 64 * (j))
#define XB_XSUB(j)  (1280 + 64 * (j))
#define XB_XGEN(j)  (2304 + 64 * (j))
#define XB_TOP      3328
#define XB_TOPGEN   3392
#define XCD_BAR_WORDS 3456
#define XB_SPIN_CAP (1u << 18)

__device__ __forceinline__ unsigned xb_ld(unsigned* p)              { return __hip_atomic_load(p, __ATOMIC_RELAXED, __HIP_MEMORY_SCOPE_AGENT); }
__device__ __forceinline__ unsigned xb_add(unsigned* p, unsigned v) { return __hip_atomic_fetch_add(p, v, __ATOMIC_RELAXED, __HIP_MEMORY_SCOPE_AGENT); }
__device__ __forceinline__ unsigned xb_xcc_id() { return (unsigned)__builtin_amdgcn_s_getreg((3 << 11) | 20) & 0xFu; }
#define XB_SPIN(cond, bar) do { unsigned _sp = 0; while (cond) { __builtin_amdgcn_s_sleep(1); \
    if ((++_sp & 255u) == 0u) { if (xb_ld(&(bar)[XB_TMO])) break; if (_sp > XB_SPIN_CAP) { atomicAdd(&(bar)[XB_TMO], 1u); break; } } } } while (0)

struct XcdBarrier {
    unsigned* bar; unsigned x;
    volatile LAS unsigned* st;
};

__device__ __forceinline__ XcdBarrier xcd_barrier_post(unsigned* bar, volatile LAS unsigned* st) {
    XcdBarrier b; b.bar = bar; b.x = xb_xcc_id(); b.st = st;
    if (threadIdx.x == 0) (void)xb_add(&bar[XB_XCNT(b.x)], 1u);
    return b;
}
__device__ __forceinline__ void xcd_barrier_complete(unsigned* bar, unsigned x, unsigned& nloc, unsigned& nx) {
    const unsigned G = gridDim.x * gridDim.y * gridDim.z;
    unsigned sum, cnt, mine, sp = 0u;
    for (;;) {
        sum = 0u; cnt = 0u; mine = 0u;
#pragma unroll
        for (unsigned j = 0; j < 16; ++j) { const unsigned c = xb_ld(&bar[XB_XCNT(j)]); sum += c; cnt += (c > 0u) ? 1u : 0u; mine = (j == x) ? c : mine; }
        if (sum == G) break;
        __builtin_amdgcn_s_sleep(1);
        if ((++sp & 255u) == 0u) { if (xb_ld(&bar[XB_TMO])) break; if (sp > XB_SPIN_CAP) { atomicAdd(&bar[XB_TMO], 1u); break; } }
    }
    nloc = mine > 0u ? mine : 1u; nx = cnt > 0u ? cnt : 1u;
}

__device__ __forceinline__ void xcd_barrier(const XcdBarrier& b) {
    asm volatile("s_waitcnt vmcnt(0)" ::: "memory");
    __syncthreads();
    if (threadIdx.x == 0) {
        unsigned* bar = b.bar;
        __builtin_amdgcn_s_waitcnt(0);
        unsigned nloc = b.st[0], nx = b.st[1];
        if (nloc == 0u) { xcd_barrier_complete(bar, b.x, nloc, nx); b.st[0] = nloc; b.st[1] = nx; }
        const unsigned old = xb_add(&bar[XB_XSUB(b.x)], 1u);
        const unsigned gen = old / nloc;
        if (old + 1u == (gen + 1u) * nloc) {
            __builtin_amdgcn_fence(__ATOMIC_RELEASE, "agent");
            asm volatile("s_waitcnt vmcnt(0)" ::: "memory");
            const unsigned og = xb_add(&bar[XB_TOP], 1u);
            const unsigned tg = og / nx;
            if (og + 1u == (tg + 1u) * nx) xb_add(&bar[XB_TOPGEN], 1u);
            else XB_SPIN(xb_ld(&bar[XB_TOPGEN]) == tg, bar);
            __builtin_amdgcn_fence(__ATOMIC_ACQUIRE, "agent");
            xb_add(&bar[XB_XGEN(b.x)], 1u);
            asm volatile("s_waitcnt vmcnt(0)" ::: "memory");
        } else {
            XB_SPIN(xb_ld(&bar[XB_XGEN(b.x)]) == gen, bar);
            __builtin_amdgcn_fence(__ATOMIC_ACQUIRE, "agent");
            asm volatile("s_waitcnt vmcnt(0)" ::: "memory");
        }
    }
    __syncthreads();
}
namespace fox {
using bf16x8 = __attribute__((ext_vector_type(8))) short;
using s16x4 = __attribute__((ext_vector_type(4))) short;
using f32x16 = __attribute__((ext_vector_type(16))) float;
using f32x4 = __attribute__((ext_vector_type(4))) float;
using u32x4 = __attribute__((ext_vector_type(4))) unsigned;
constexpr int SEQL = 4096, PQ = 512, PO = 1024, QB = 256, KVBLK = 64, SLOTB = 8192;
constexpr int NSLOT = 4, LDS_K = 0, LDS_V = NSLOT * SLOTB, LDS_WS = 2 * NSLOT * SLOTB, LDS_OST = LDS_WS + 8 * 64 * 4, LDS_CB = LDS_OST + 8 * 4096, LDS_Q = LDS_CB + (4096 + 256) * 4, LDS_TOT = LDS_Q + 64;
static_assert(LDS_TOT <= 131072, "fox LDS");
__device__ __forceinline__ int crow(int r, int hi) { return (r & 3) + 8 * (r >> 2) + 4 * hi; }
#define FSBAR() __builtin_amdgcn_sched_barrier(0)
__device__ __forceinline__ void glds16(const void* gsrc, unsigned lds_dst) { unsigned keep;
    asm volatile("s_mov_b32 %0, m0\n\ts_mov_b32 m0, %2\n\ts_nop 0\n\tglobal_load_lds_dwordx4 %1, off\n\ts_mov_b32 m0, %0" : "=&s"(keep) : "v"(gsrc), "s"(lds_dst) : "memory"); }
__device__ __forceinline__ void glds4(const void* gsrc, unsigned lds_dst) { unsigned keep;
    asm volatile("s_mov_b32 %0, m0\n\ts_mov_b32 m0, %2\n\ts_nop 0\n\tglobal_load_lds_dword %1, off\n\ts_mov_b32 m0, %0" : "=&s"(keep) : "v"(gsrc), "s"(lds_dst) : "memory"); }
typedef float f32x2_t __attribute__((ext_vector_type(2))); typedef __bf16 bf16x2_t __attribute__((ext_vector_type(2)));
__device__ __forceinline__ unsigned cvtpk_s(float lo, float hi) { f32x2_t v = {lo, hi}; bf16x2_t b = __builtin_convertvector(v, bf16x2_t); return __builtin_bit_cast(unsigned, b); }
#define FWAIT_BAR(N) asm volatile("s_waitcnt vmcnt(" #N ") lgkmcnt(0)\n\ts_barrier" ::: "memory")
#define FWAIT_BAR2(N0, N1) do { if (wid == 0) FWAIT_BAR(N0); else FWAIT_BAR(N1); } while (0)
typedef __attribute__((address_space(3))) const char* lds_cptr;
__device__ __forceinline__ void qkt(f32x16& p0, f32x16& p1, lds_cptr Kslot, const bf16x8* qr, const f32x16& c0, const f32x16& c1, int r32, int hi) {
    lds_cptr kb = Kslot + hi * 1024 + r32 * 16;
#pragma unroll
    for (int d0 = 0; d0 < 4; ++d0) {
        const bf16x8 b0 = *(const __attribute__((address_space(3))) bf16x8*)(kb + d0 * 2048);
        const bf16x8 b1 = *(const __attribute__((address_space(3))) bf16x8*)(kb + d0 * 2048 + 512);
        if (d0 == 0) { p0 = __builtin_amdgcn_mfma_f32_32x32x16_bf16(b0, qr[0], c0, 0, 0, 0); p1 = __builtin_amdgcn_mfma_f32_32x32x16_bf16(b1, qr[0], c1, 0, 0, 0); }
        else { p0 = __builtin_amdgcn_mfma_f32_32x32x16_bf16(b0, qr[d0], p0, 0, 0, 0); p1 = __builtin_amdgcn_mfma_f32_32x32x16_bf16(b1, qr[d0], p1, 0, 0, 0); } }
}
typedef short v4i16_t __attribute__((ext_vector_type(4)));
__device__ __forceinline__ s16x4 vtr(lds_cptr p) { return __builtin_bit_cast(s16x4, __builtin_amdgcn_ds_read_tr16_b64_v4i16((__attribute__((address_space(3))) v4i16_t*)p)); }
__device__ __forceinline__ void pv(f32x16* o, lds_cptr vp, bf16x8 pa0, bf16x8 pa1, bf16x8 pa2, bf16x8 pa3) {
#pragma unroll
    for (int d0 = 0; d0 < 2; ++d0) { s16x4 lo[4], hi[4];
#pragma unroll
        for (int ks = 0; ks < 4; ++ks) { lo[ks] = vtr(vp + d0 * 4096 + ks * 1024); hi[ks] = vtr(vp + d0 * 4096 + ks * 1024 + 512); }
#define FPK(k) (bf16x8){lo[k][0], lo[k][1], lo[k][2], lo[k][3], hi[k][0], hi[k][1], hi[k][2], hi[k][3]}
        o[d0] = __builtin_amdgcn_mfma_f32_32x32x16_bf16(pa0, FPK(0), o[d0], 0, 0, 0);
        o[d0] = __builtin_amdgcn_mfma_f32_32x32x16_bf16(pa1, FPK(1), o[d0], 0, 0, 0);
        o[d0] = __builtin_amdgcn_mfma_f32_32x32x16_bf16(pa2, FPK(2), o[d0], 0, 0, 0);
        o[d0] = __builtin_amdgcn_mfma_f32_32x32x16_bf16(pa3, FPK(3), o[d0], 0, 0, 0);
#undef FPK
    }
}
__device__ __forceinline__ void fox_cumsum(const float* LF2, int b, int h, char* shm, float* c2g) {
    float* wtot = (float*)(shm + LDS_WS);
    const int tid = threadIdx.x, lane = tid & 63, wid = tid >> 6;
    const float* p = LF2 + ((size_t)b * SEQL + 8 * tid) * 8 + h;
    float v[8];
#pragma unroll
    for (int j = 0; j < 8; ++j) v[j] = p[8 * j];
#pragma unroll
    for (int j = 1; j < 8; ++j) v[j] += v[j - 1];
    float inc = v[7];
#pragma unroll
    for (int o = 1; o < 64; o <<= 1) { const float u = __shfl_up(inc, o); if (lane >= o) inc += u; }
    if (lane == 63) wtot[wid] = inc;
    __syncthreads();
    float base = inc - v[7];
    for (int w = 0; w < wid; ++w) base += wtot[w];
    *(f32x4*)(c2g + 8 * tid) = (f32x4){base + v[0], base + v[1], base + v[2], base + v[3]};
    *(f32x4*)(c2g + 8 * tid + 4) = (f32x4){base + v[4], base + v[5], base + v[6], base + v[7]};
    __syncthreads();
}
__device__ __forceinline__ void fox_unit(int b, int h, int qb, const bf16_t* Q, const bf16_t* K, const bf16_t* V, bf16_t* O, char* shm, const float* c2g) {
    int tid = threadIdx.x; asm volatile("" : "+v"(tid));
    const int lane = tid & 63, r32 = lane & 31, hi = lane >> 5; const int wid = __builtin_amdgcn_readfirstlane(tid >> 6);
    const long rowbase = (long)b * SEQL; const int q0 = qb * QB;
    const bf16_t* Qw = Q + (rowbase + q0 + wid * 32) * PQ + h * 64;
    const bf16_t* Kh = K + rowbase * PQ + h * 64; const bf16_t* Vh = V + rowbase * PQ + h * 64;
    const unsigned lds0 = (unsigned)(uintptr_t)shm;
    float* wsf = (float*)(shm + LDS_WS) + wid * 64;
    const bf16_t* ksrc = Kh + (long)lane * PQ + wid * 8;
    const bf16_t* vsrc = Vh + (long)(16 * (wid & 3) + (lane >> 2)) * PQ + (wid >> 2) * 32 + (lane & 3) * 8;
    const unsigned kdst = lds0 + LDS_K + wid * 1024, vdst = lds0 + LDS_V + wid * 1024;
#define DMA_K(t, slot) glds16(ksrc + (long)(t) * KVBLK * PQ, (unsigned)__builtin_amdgcn_readfirstlane(kdst + (slot)))
#define DMA_V(t, slot) glds16(vsrc + (long)(t) * KVBLK * PQ, (unsigned)__builtin_amdgcn_readfirstlane(vdst + (slot)))
    const lds_cptr shm3 = (lds_cptr)shm;
    const lds_cptr vp0 = shm3 + LDS_V + ((lane >> 4) & 1) * 32 + (lane & 3) * 8 + (4 * hi + ((lane & 15) >> 2)) * 64;
    const int NT = (q0 + QB) / KVBLK;
#define DMA_T(t) do { const int s_ = ((t) & 3); DMA_K(t, s_ * SLOTB); DMA_V(t, s_ * SLOTB); } while (0)
    bf16x8 qr[4];
#pragma unroll
    for (int d0 = 0; d0 < 4; ++d0) qr[d0] = *reinterpret_cast<const bf16x8*>(&Qw[(long)r32 * PQ + d0 * 16 + hi * 8]);
    const int qrel = wid * 32 + r32;
    const float ct = c2g[q0 + qrel];
    if (wid <= qb) glds16(c2g + 256 * wid + 4 * lane, (unsigned)__builtin_amdgcn_readfirstlane(lds0 + LDS_CB + wid * 1024));
    if (wid + 8 <= qb) glds16(c2g + 256 * (wid + 8) + 4 * lane, (unsigned)__builtin_amdgcn_readfirstlane(lds0 + LDS_CB + (wid + 8) * 1024));
    DMA_T(0); DMA_T(1); DMA_T(2);
    float l_reg = 0.f; f32x16 o[2]; o[0] = f32x16{}; o[1] = f32x16{};
    f32x16 pA0, pA1, pB0, pB1; u32x4 pw0, pw1, pw2, pw3; bf16x8 kf[8]; s16x4 vlo[8], vhi[8]; f32x4 bz;
    typedef const __attribute__((address_space(3))) float* lds_fptr; typedef const __attribute__((address_space(3))) f32x4* lds_f4ptr;
    const lds_fptr cb0 = (lds_fptr)(shm3 + LDS_CB) + 4 * hi;
#define CIN(C0, C1, t) do { lds_fptr cp_ = cb0 + 64 * (t); \
        _Pragma("unroll") for (int g = 0; g < 4; ++g) { const f32x4 a_ = *(lds_f4ptr)(cp_ + 8 * g), b_ = *(lds_f4ptr)(cp_ + 32 + 8 * g); \
            _Pragma("unroll") for (int i = 0; i < 4; ++i) { C0[4 * g + i] = ct - a_[i]; C1[4 * g + i] = ct - b_[i]; } } } while (0)
#define KRD2(t, j) do { lds_cptr kb_ = shm3 + LDS_K + ((t) & 3) * SLOTB + hi * 1024 + r32 * 16; \
        kf[2 * (j)] = *(const __attribute__((address_space(3))) bf16x8*)(kb_ + (j) * 2048); kf[2 * (j) + 1] = *(const __attribute__((address_space(3))) bf16x8*)(kb_ + (j) * 2048 + 512); } while (0)
#define MASKT(P0, P1, t) do { const int jb_ = (t) - (NT - 4); if (jb_ >= 0) { asm volatile("; band tile" ::: "memory"); const int kb_ = 64 * jb_ + 4 * hi; \
        _Pragma("unroll") for (int r = 0; r < 16; ++r) { const int kv_ = kb_ + (r & 3) + 8 * (r >> 2); if (kv_ > qrel) P0[r] = -INFINITY; if (kv_ + 32 > qrel) P1[r] = -INFINITY; } } } while (0)
#define EX(v) __builtin_amdgcn_exp2f(v)
#define PIN(x) asm volatile("" : "+v"(x))
#define VRD(vp_, i) do { vlo[i] = vtr(vp_ + (((i) >> 2) * 4096 + ((i) & 3) * 1024)); vhi[i] = vtr(vp_ + (((i) >> 2) * 4096 + ((i) & 3) * 1024 + 512)); } while (0)
#define VFR(i) (bf16x8){vlo[i][0], vlo[i][1], vlo[i][2], vlo[i][3], vhi[i][0], vhi[i][1], vhi[i][2], vhi[i][3]}
#define PAF(k) __builtin_bit_cast(bf16x8, pw##k)
#define GAPA(MF, XP, B, PW, W, VI) do { MF; sacc_ += XP[B]; sacc_ += XP[(B) + 1]; sacc_ += XP[(B) + 2]; sacc_ += XP[(B) + 3]; PW[W] = cvtpk_s(XP[B], XP[(B) + 1]); PW[(W) + 1] = cvtpk_s(XP[(B) + 2], XP[(B) + 3]); PIN(sacc_); PIN(PW); VRD(vp_, VI); FSBAR(); } while (0)
#define GAPB(MF, YP, XP, B, NB) do { MF; YP[B] = EX(YP[B]); YP[(B) + 1] = EX(YP[(B) + 1]); YP[(B) + 2] = EX(YP[(B) + 2]); YP[(B) + 3] = EX(YP[(B) + 3]); \
        XP[B] = ct - bz[0]; XP[(B) + 1] = ct - bz[1]; XP[(B) + 2] = ct - bz[2]; XP[(B) + 3] = ct - bz[3]; bz = *(lds_f4ptr)(cbn_ + (NB)); PIN(YP); PIN(XP); FSBAR(); } while (0)
#define STEP(X0, X1, Y0, Y1, t) do { \
        FWAIT_BAR(0); \
        if ((t) + 3 < NT) DMA_T((t) + 3); \
        FSBAR(); \
        { const lds_cptr vp_ = vp0 + ((t) & 3) * SLOTB; float sacc_ = 0.f; \
          GAPA(Y0 = __builtin_amdgcn_mfma_f32_32x32x16_bf16(kf[0], qr[0], Y0, 0, 0, 0), X0, 0, pw0, 0, 0); \
          GAPA(Y1 = __builtin_amdgcn_mfma_f32_32x32x16_bf16(kf[1], qr[0], Y1, 0, 0, 0), X0, 4, pw0, 2, 4); \
          GAPA(Y0 = __builtin_amdgcn_mfma_f32_32x32x16_bf16(kf[2], qr[1], Y0, 0, 0, 0), X0, 8, pw1, 0, 1); \
          GAPA(Y1 = __builtin_amdgcn_mfma_f32_32x32x16_bf16(kf[3], qr[1], Y1, 0, 0, 0), X0, 12, pw1, 2, 5); \
          GAPA(Y0 = __builtin_amdgcn_mfma_f32_32x32x16_bf16(kf[4], qr[2], Y0, 0, 0, 0), X1, 0, pw2, 0, 2); \
          GAPA(Y1 = __builtin_amdgcn_mfma_f32_32x32x16_bf16(kf[5], qr[2], Y1, 0, 0, 0), X1, 4, pw2, 2, 6); \
          GAPA(Y0 = __builtin_amdgcn_mfma_f32_32x32x16_bf16(kf[6], qr[3], Y0, 0, 0, 0), X1, 8, pw3, 0, 3); \
          GAPA(Y1 = __builtin_amdgcn_mfma_f32_32x32x16_bf16(kf[7], qr[3], Y1, 0, 0, 0), X1, 12, pw3, 2, 7); \
          l_reg += sacc_; } \
        MASKT(Y0, Y1, (t) + 1); \
        FSBAR(); \
        { const lds_fptr cbn_ = cb0 + 64 * ((t) + 2); bz = *(lds_f4ptr)(cbn_); FSBAR(); \
          GAPB(o[0] = __builtin_amdgcn_mfma_f32_32x32x16_bf16(PAF(0), VFR(0), o[0], 0, 0, 0), Y0, X0, 0, 8); \
          GAPB(o[1] = __builtin_amdgcn_mfma_f32_32x32x16_bf16(PAF(0), VFR(4), o[1], 0, 0, 0), Y0, X0, 4, 16); \
          KRD2((t) + 2, 0); GAPB(o[0] = __builtin_amdgcn_mfma_f32_32x32x16_bf16(PAF(1), VFR(1), o[0], 0, 0, 0), Y0, X0, 8, 24); \
          KRD2((t) + 2, 1); GAPB(o[1] = __builtin_amdgcn_mfma_f32_32x32x16_bf16(PAF(1), VFR(5), o[1], 0, 0, 0), Y0, X0, 12, 32); \
          KRD2((t) + 2, 2); GAPB(o[0] = __builtin_amdgcn_mfma_f32_32x32x16_bf16(PAF(2), VFR(2), o[0], 0, 0, 0), Y1, X1, 0, 40); \
          KRD2((t) + 2, 3); GAPB(o[1] = __builtin_amdgcn_mfma_f32_32x32x16_bf16(PAF(2), VFR(6), o[1], 0, 0, 0), Y1, X1, 4, 48); \
          GAPB(o[0] = __builtin_amdgcn_mfma_f32_32x32x16_bf16(PAF(3), VFR(3), o[0], 0, 0, 0), Y1, X1, 8, 56); \
          GAPB(o[1] = __builtin_amdgcn_mfma_f32_32x32x16_bf16(PAF(3), VFR(7), o[1], 0, 0, 0), Y1, X1, 12, 0); } \
        } while (0)
    FWAIT_BAR(2);
    CIN(pA0, pA1, 0); CIN(pB0, pB1, 1);
    { KRD2(0, 0); KRD2(0, 1); KRD2(0, 2); KRD2(0, 3);
#pragma unroll
      for (int d0 = 0; d0 < 4; ++d0) { pA0 = __builtin_amdgcn_mfma_f32_32x32x16_bf16(kf[2 * d0], qr[d0], pA0, 0, 0, 0); pA1 = __builtin_amdgcn_mfma_f32_32x32x16_bf16(kf[2 * d0 + 1], qr[d0], pA1, 0, 0, 0); }
      MASKT(pA0, pA1, 0);
#pragma unroll
      for (int r = 0; r < 16; ++r) { pA0[r] = EX(pA0[r]); pA1[r] = EX(pA1[r]); }
      KRD2(1, 0); KRD2(1, 1); KRD2(1, 2); KRD2(1, 3); }
    for (int t = 0; t + 2 < NT; t += 2) { STEP(pA0, pA1, pB0, pB1, t); STEP(pB0, pB1, pA0, pA1, t + 1); }
    STEP(pA0, pA1, pB0, pB1, NT - 2);
    FWAIT_BAR(0);
    { float sacc_ = 0.f;
#pragma unroll
      for (int r = 0; r < 16; ++r) sacc_ += pB0[r] + pB1[r];
      l_reg += sacc_;
      pw0 = (u32x4){cvtpk_s(pB0[0], pB0[1]), cvtpk_s(pB0[2], pB0[3]), cvtpk_s(pB0[4], pB0[5]), cvtpk_s(pB0[6], pB0[7])};
      pw1 = (u32x4){cvtpk_s(pB0[8], pB0[9]), cvtpk_s(pB0[10], pB0[11]), cvtpk_s(pB0[12], pB0[13]), cvtpk_s(pB0[14], pB0[15])};
      pw2 = (u32x4){cvtpk_s(pB1[0], pB1[1]), cvtpk_s(pB1[2], pB1[3]), cvtpk_s(pB1[4], pB1[5]), cvtpk_s(pB1[6], pB1[7])};
      pw3 = (u32x4){cvtpk_s(pB1[8], pB1[9]), cvtpk_s(pB1[10], pB1[11]), cvtpk_s(pB1[12], pB1[13]), cvtpk_s(pB1[14], pB1[15])};
      pv(o, vp0 + ((NT - 1) & 3) * SLOTB, PAF(0), PAF(1), PAF(2), PAF(3)); }
#undef CIN
#undef KRD2
#undef MASKT
#undef EX
#undef PIN
#undef VRD
#undef VFR
#undef PAF
#undef GAPA
#undef GAPB
#undef STEP
    { auto rr = __builtin_amdgcn_permlane32_swap(__float_as_uint(l_reg), __float_as_uint(l_reg), false, false); l_reg = __uint_as_float(rr[0]) + __uint_as_float(rr[1]); }
    if (hi == 0) wsf[32 + r32] = l_reg; asm volatile("s_waitcnt lgkmcnt(0)" ::: "memory");
    float rli[16];
#pragma unroll
    for (int r = 0; r < 16; ++r) rli[r] = __builtin_amdgcn_rcpf(wsf[32 + crow(r, hi)]);
    bf16_t* Ow = O + (rowbase + q0 + wid * 32) * PO + 512 + h * 64;
    { bf16_t* stg = (bf16_t*)(shm + LDS_OST) + wid * 2048;
#pragma unroll
      for (int r = 0; r < 16; ++r) { const int orow = crow(r, hi);
#pragma unroll
          for (int d0 = 0; d0 < 2; ++d0) stg[orow * 64 + d0 * 32 + r32] = f2bf(o[d0][r] * rli[r]); }
      asm volatile("s_waitcnt lgkmcnt(0)" ::: "memory");
#pragma unroll
      for (int i = 0; i < 4; ++i) { const int row = i * 8 + (lane >> 3), ch = lane & 7; const u32x4 v = *(const u32x4*)(stg + row * 64 + ch * 8); *(u32x4*)(Ow + (long)row * PO + ch * 8) = v; } }
    asm volatile("s_waitcnt lgkmcnt(0)\n\ts_barrier" ::: "memory");
#undef DMA_K
#undef DMA_V
#undef DMA_T
}
__device__ __forceinline__ void fox_phase_queue(char* shm, unsigned* qctr, int xg, const bf16_t* Q, const bf16_t* K, const bf16_t* V, const float* C2S, bf16_t* O) {
    volatile __attribute__((address_space(3))) unsigned* uq = (volatile __attribute__((address_space(3))) unsigned*)((__attribute__((address_space(3))) char*)shm + LDS_Q);
    int qi = 0;
    for (;;) {
        if (threadIdx.x == 0) { unsigned u = 256u; int q = qi;
            for (; q < 8; ++q) { u = atomicAdd(qctr + 64 * ((xg + q) & 7), 1u); if (u < 256u) break; }
            uq[0] = u; uq[1] = (unsigned)q; }
        __syncthreads();
        const unsigned u = uq[0]; qi = (int)uq[1];
        __syncthreads();
        if (u >= 256u) break;
        const int bh = 16 * ((xg + qi) & 7) + (int)(u >> 4), qb = 15 - (int)(u & 15u);
        fox_unit(bh >> 3, bh & 7, qb, Q, K, V, O, shm, C2S + (size_t)bh * SEQL);
    }
}
#undef FSBAR
#undef FWAIT_BAR
}
namespace gla {
using bf16x8 = __attribute__((ext_vector_type(8))) short;
using s16x4 = __attribute__((ext_vector_type(4))) short;
using f32x4 = __attribute__((ext_vector_type(4))) float;
using u32x4 = __attribute__((ext_vector_type(4))) unsigned;
using u32x2 = __attribute__((ext_vector_type(2))) unsigned;
typedef short v4i16_t __attribute__((ext_vector_type(4)));
#define GLAS __attribute__((address_space(3)))
constexpr int G_GLR = 0, G_SEG = 4096, G_DEC = 6144, G_QE = 6400, G_KE = 15616, G_KDT = 24832, G_SC = 34048, G_V = 43264, G_O = 61696, G_END = 95488;
constexpr int RS = 144, VS = 288, OS = 528;
static_assert(G_END <= 131072, "gla LDS");
typedef float f32x2_t __attribute__((ext_vector_type(2))); typedef __bf16 bf16x2_t __attribute__((ext_vector_type(2)));
__device__ __forceinline__ unsigned pk(float lo, float hi) { f32x2_t v = {lo, hi}; bf16x2_t b = __builtin_convertvector(v, bf16x2_t); return __builtin_bit_cast(unsigned, b); }
__device__ __forceinline__ bf16_t cv1(float x) { return (bf16_t)(pk(x, 0.f) & 0xffffu); }
__device__ __forceinline__ float ex2(float x) { return __builtin_amdgcn_exp2f(x); }
__device__ __forceinline__ float logsig2(float z) { return fminf(z, 0.f) * LOG2E - __builtin_amdgcn_logf(1.f + ex2(-fabsf(z) * LOG2E)); }
__device__ __forceinline__ s16x4 vtr(const GLAS char* p) { return __builtin_bit_cast(s16x4, __builtin_amdgcn_ds_read_tr16_b64_v4i16((GLAS v4i16_t*)p)); }

__device__ __forceinline__ void gla_unit(int b, int h, const bf16_t* GQ, const bf16_t* GK, const bf16_t* GV, const bf16_t* GR, const float* GLR, const float* w2, const float* ba, const float* gn, bf16_t* OGF, GLAS char* sm) {
    const int tid = threadIdx.x, lane = tid & 63, g = lane >> 4, c = lane & 15; const int wid = __builtin_amdgcn_readfirstlane(tid >> 6);
    const int d = lane, seg = wid;
    float w2c[16];
#pragma unroll
    for (int r = 0; r < 16; ++r) w2c[r] = w2[r * 256 + h * 64 + d];
    const float bac = ba[h * 64 + d];
    f32x4 S[4];
#pragma unroll
    for (int mb = 0; mb < 4; ++mb) S[mb] = (f32x4){0.f, 0.f, 0.f, 0.f};
    const int el = tid >> 3, ej = tid & 7;
    f32x4 pf_glr = {0.f, 0.f, 0.f, 0.f}; u32x4 pf_v[2], pf_gr[2]; unsigned short pf_q[8], pf_k[8];
#define GLA_PREFETCH(CH) do { const size_t mm_ = (size_t)b * 4096 + 64 * (CH); \
        if (tid < 256) pf_glr = *(const f32x4*)(GLR + (mm_ + (tid >> 2)) * 16 + 4 * (tid & 3)); \
        _Pragma("unroll") for (int i = 0; i < 2; ++i) { const int p = tid + 512 * i, row = p >> 4, ch = p & 15; pf_v[i] = *(const u32x4*)(GV + (mm_ + row) * 512 + h * 128 + 8 * ch); } \
        _Pragma("unroll") for (int i = 0; i < 8; ++i) { pf_q[i] = GQ[(mm_ + 8 * seg + i) * 256 + h * 64 + d]; pf_k[i] = GK[(mm_ + 8 * seg + i) * 256 + h * 64 + d]; } \
        { const bf16_t* grp = GR + (mm_ + el) * 512 + h * 128 + 16 * ej; pf_gr[0] = *(const u32x4*)grp; pf_gr[1] = *(const u32x4*)(grp + 8); } } while (0)
    GLA_PREFETCH(0);
    f32x4 gnv[4];
#pragma unroll
    for (int j = 0; j < 4; ++j) gnv[j] = *(const f32x4*)(gn + h * 128 + 16 * ej + 4 * j);
    for (int chunk = 0; chunk < 64; ++chunk) {
        const size_t m0 = (size_t)b * 4096 + 64 * chunk;
        if (tid < 256) *(GLAS f32x4*)(sm + G_GLR + tid * 16) = pf_glr;
#pragma unroll
        for (int i = 0; i < 2; ++i) { const int p = tid + 512 * i, row = p >> 4, ch = p & 15; *(GLAS u32x4*)(sm + G_V + row * VS + ch * 16) = pf_v[i]; }
        float qv[8], kv[8];
#pragma unroll
        for (int i = 0; i < 8; ++i) { qv[i] = bf2f(pf_q[i]); kv[i] = bf2f(pf_k[i]); }
        const u32x4 g0 = pf_gr[0], g1 = pf_gr[1];
        if (chunk + 1 < 64) GLA_PREFETCH(chunk + 1);
        __syncthreads();
        float la[8];
#pragma unroll
        for (int i = 0; i < 8; ++i) { float z = bac; const GLAS f32x4* gp = (const GLAS f32x4*)(sm + G_GLR + (8 * seg + i) * 64);
#pragma unroll
            for (int r4 = 0; r4 < 4; ++r4) { const f32x4 t = gp[r4]; z += t[0] * w2c[4 * r4] + t[1] * w2c[4 * r4 + 1] + t[2] * w2c[4 * r4 + 2] + t[3] * w2c[4 * r4 + 3]; }
            la[i] = logsig2(z) * (1.f / 16.f); }
#pragma unroll
        for (int i = 1; i < 8; ++i) la[i] += la[i - 1];
        *(GLAS float*)(sm + G_SEG + (seg * 64 + d) * 4) = la[7];
        __syncthreads();
        float pre = 0.f, tot = 0.f;
#pragma unroll
        for (int s = 0; s < 8; ++s) { const float v = *(const GLAS float*)(sm + G_SEG + (s * 64 + d) * 4); tot += v; pre += (s < seg) ? v : 0.f; }
        { float kd[8];
#pragma unroll
          for (int i = 0; i < 8; ++i) { const float bb = la[i] + pre; const int l = 8 * seg + i;
              *(GLAS bf16_t*)(sm + G_QE + l * RS + d * 2) = cv1(qv[i] * ex2(bb)); *(GLAS bf16_t*)(sm + G_KE + l * RS + d * 2) = cv1(kv[i] * ex2(-bb)); kd[i] = kv[i] * ex2(tot - bb); }
          *(GLAS u32x4*)(sm + G_KDT + d * RS + seg * 16) = (u32x4){pk(kd[0], kd[1]), pk(kd[2], kd[3]), pk(kd[4], kd[5]), pk(kd[6], kd[7])};
          if (seg == 0) *(GLAS float*)(sm + G_DEC + d * 4) = ex2(tot); }
        __syncthreads();
        { const int lb = wid >> 1;
#pragma unroll
          for (int mm = 0; mm < 2; ++mm) { const int mbk = 2 * (wid & 1) + mm; f32x4 acc = {0.f, 0.f, 0.f, 0.f};
#pragma unroll
              for (int ks = 0; ks < 2; ++ks) { const bf16x8 a = *(const GLAS bf16x8*)(sm + G_KE + (16 * mbk + c) * RS + (32 * ks + 8 * g) * 2), bq = *(const GLAS bf16x8*)(sm + G_QE + (16 * lb + c) * RS + (32 * ks + 8 * g) * 2);
                  acc = __builtin_amdgcn_mfma_f32_16x16x32_bf16(a, bq, acc, 0, 0, 0); }
              const int l = 16 * lb + c, mq = 16 * mbk + 4 * g;
#pragma unroll
              for (int r = 0; r < 4; ++r) acc[r] = (l >= mq + r) ? acc[r] : 0.f;
              *(GLAS u32x2*)(sm + G_SC + l * RS + mq * 2) = (u32x2){pk(acc[0], acc[1]), pk(acc[2], acc[3])}; } }
        __syncthreads();
        bf16x8 vf[2], sf[2];
        { const int q = c >> 2, p = c & 3;
#pragma unroll
          for (int ks = 0; ks < 2; ++ks) { const GLAS char* ap = sm + G_V + (32 * ks + 8 * g + q) * VS + (16 * wid + 4 * p) * 2; const s16x4 r1 = vtr(ap), r2 = vtr(ap + 4 * VS);
              vf[ks] = (bf16x8){r1[0], r1[1], r1[2], r1[3], r2[0], r2[1], r2[2], r2[3]}; } }
#pragma unroll
        for (int s = 0; s < 2; ++s) { const u32x4 w = {pk(S[2 * s][0], S[2 * s][1]), pk(S[2 * s][2], S[2 * s][3]), pk(S[2 * s + 1][0], S[2 * s + 1][1]), pk(S[2 * s + 1][2], S[2 * s + 1][3])}; sf[s] = __builtin_bit_cast(bf16x8, w); }
        f32x4 oacc[4];
#pragma unroll
        for (int lb = 0; lb < 4; ++lb) { f32x4 acc = {0.f, 0.f, 0.f, 0.f};
#pragma unroll
            for (int ks = 0; ks < 2; ++ks) { const bf16x8 a = *(const GLAS bf16x8*)(sm + G_SC + (16 * lb + c) * RS + (32 * ks + 8 * g) * 2); acc = __builtin_amdgcn_mfma_f32_16x16x32_bf16(a, vf[ks], acc, 0, 0, 0); }
#pragma unroll
            for (int s = 0; s < 2; ++s) { const GLAS char* ap = sm + G_QE + (16 * lb + c) * RS + (32 * s + 4 * g) * 2; const s16x4 lo = *(const GLAS s16x4*)ap, hi = *(const GLAS s16x4*)(ap + 32);
                const bf16x8 a = {lo[0], lo[1], lo[2], lo[3], hi[0], hi[1], hi[2], hi[3]}; acc = __builtin_amdgcn_mfma_f32_16x16x32_bf16(a, sf[s], acc, 0, 0, 0); }
            oacc[lb] = acc; }
#pragma unroll
        for (int mb = 0; mb < 4; ++mb) { const f32x4 dec = *(const GLAS f32x4*)(sm + G_DEC + (16 * mb + 4 * g) * 4); f32x4 acc = S[mb] * dec;
#pragma unroll
            for (int ks = 0; ks < 2; ++ks) { const bf16x8 a = *(const GLAS bf16x8*)(sm + G_KDT + (16 * mb + c) * RS + (32 * ks + 8 * g) * 2); acc = __builtin_amdgcn_mfma_f32_16x16x32_bf16(a, vf[ks], acc, 0, 0, 0); }
            S[mb] = acc; }
#pragma unroll
        for (int lb = 0; lb < 4; ++lb)
#pragma unroll
            for (int r = 0; r < 4; ++r) *(GLAS float*)(sm + G_O + (16 * lb + 4 * g + r) * OS + (16 * wid + c) * 4) = oacc[lb][r];
        __syncthreads();
        { f32x4 o4[4]; float ss = 0.f;
#pragma unroll
          for (int j = 0; j < 4; ++j) { o4[j] = *(const GLAS f32x4*)(sm + G_O + el * OS + ej * 64 + j * 16); ss += (o4[j][0] * o4[j][0] + o4[j][1] * o4[j][1]) + (o4[j][2] * o4[j][2] + o4[j][3] * o4[j][3]); }
          ss += __shfl_xor(ss, 1); ss += __shfl_xor(ss, 2); ss += __shfl_xor(ss, 4);
          const float rs = rsqrtf(ss * (1.f / 128.f) + 1e-6f);
          const unsigned gw[8] = {g0.x, g0.y, g0.z, g0.w, g1.x, g1.y, g1.z, g1.w};
          unsigned ow[8];
#pragma unroll
          for (int j = 0; j < 4; ++j) { const f32x4 gv = gnv[j]; float r[4];
#pragma unroll
              for (int i = 0; i < 4; ++i) { const unsigned w = gw[2 * j + (i >> 1)]; const float gr = (i & 1) ? __uint_as_float(w & 0xffff0000u) : __uint_as_float(w << 16);
                  r[i] = o4[j][i] * rs * gv[i] * gr * __builtin_amdgcn_rcpf(1.f + ex2(-LOG2E * gr)); }
              ow[2 * j] = pk(r[0], r[1]); ow[2 * j + 1] = pk(r[2], r[3]); }
          bf16_t* op = OGF + (m0 + el) * 1024 + h * 128 + 16 * ej;
          *(u32x4*)op = (u32x4){ow[0], ow[1], ow[2], ow[3]}; *(u32x4*)(op + 8) = (u32x4){ow[4], ow[5], ow[6], ow[7]}; }
    }
}
__device__ __forceinline__ void gla_phase(GLAS char* sm, int vcu, const bf16_t* GQ, const bf16_t* GK, const bf16_t* GV, const bf16_t* GR, const float* GLR, const float* w2, const float* ba, const float* gn, bf16_t* OGF) {
    gla_unit(vcu >> 2, vcu & 3, GQ, GK, GV, GR, GLR, w2, ba, gn, OGF, sm);
}
#undef GLA_PREFETCH
#undef GLAS
}
#define PHASE_GLA do { if (args.pad == 0) { if (F.vcu < 128) fox::fox_cumsum(LF2, F.vcu >> 3, F.vcu & 7, (char*)lds + RING_OFF, C2S + (size_t)F.vcu * 4096); GRID_BAR(); } \
    if ((F.vcu & 3) == 0 && args.pad != 2) gla::gla_phase((__attribute__((address_space(3))) char*)(F.lds + RING_OFF), F.vcu >> 2, GQ, GK, GV, GR, GLR, args.in[3], args.in[4], args.in[5], A); \
    if (args.pad != 1) fox::fox_phase_queue((char*)lds + RING_OFF, (unsigned*)(F.ctl + CW_FOXQ + 512 * args.li), F.vcu >> 5, FQ, FK, FV, C2S, A); } while (0)
#define PHASE_FOX do {} while (0)
constexpr int NWAVES = 8;
constexpr int RING_OFF = 0, RING_BYTES = 131072, LDSCTL_OFF = RING_BYTES, MISC_OFF = LDSCTL_OFF + 320, LDS_BYTES = 147456;
constexpr size_t CTL_ZERO_BYTES = 1 * MiB;
constexpr int CW_TMO = 0, CW_CODE = 1, CW_FOXQ = 64, CW_BAR = 4096;
constexpr int N_PHASES = 12;
constexpr size_t WS_WIN = WS_W, WS_WGF = WS_WIN + (size_t)5376 * 1024 * 2, WS_WOUT = WS_WGF + 2 * MiB, WS_WUP = WS_WOUT + 2 * MiB, WS_WDN = WS_WUP + (size_t)5632 * 1024 * 2;
static_assert(WS_WDN + (size_t)1024 * 2816 * 2 <= WS_A, "weights fit below WS_A");
constexpr size_t WS_EDGE = WS_C;

struct Frame {
    LAS unsigned char* lds; volatile LAS unsigned* MISC; gu32* ctl;
    int tid, lane, wave, vcu, G;
};
__device__ __forceinline__ float wave_sum(float v) {
#pragma unroll
    for (int o = 1; o < 64; o <<= 1) v += __shfl_xor(v, o);
    return v;
}
__device__ __forceinline__ void p0_xpose(const float* colp, int ldw, bf16_t* dst, int ldd, LAS float* scr, int lane, const float* ksc) {
#pragma unroll 8
    for (int i = 0; i < 32; ++i) { const int kk = 2 * i + (lane >> 5); scr[kk * 33 + (lane & 31)] = colp ? colp[(size_t)kk * ldw] * (ksc ? ksc[kk] : 1.f) : 0.f; }
    LDS_WAIT(); asm volatile("" ::: "memory");
    const int c = lane & 7;
#pragma unroll
    for (int j = 0; j < 4; ++j) { const int n = (lane >> 3) + 8 * j; const LAS float* s = scr + (8 * c) * 33 + n;
        v4u o; o.x = pk2(s[0 * 33], s[1 * 33]); o.y = pk2(s[2 * 33], s[3 * 33]); o.z = pk2(s[4 * 33], s[5 * 33]); o.w = pk2(s[6 * 33], s[7 * 33]);
        *(GAS v4u*)(dst + (size_t)n * ldd + 8 * c) = o; }
    LDS_WAIT(); asm volatile("" ::: "memory");
}
__device__ __forceinline__ int inproj_base(int pn) { return pn < 6 ? 256 * pn : (pn < 12 ? 1552 + 256 * (pn - 6) : 3096 + 256 * (pn - 12)); }
struct Args { const float* in[19]; float* out; unsigned char* ws; int ph_lo, ph_hi, li, pad; };

__device__ __forceinline__ void p0_weights(Frame& F, const Args& a) {
    LAS float* scr = (LAS float*)(F.lds + RING_OFF + F.wave * 16384);
    const int gw = F.vcu * NWAVES + F.wave, NGW = F.G * NWAVES, lane = F.lane, c = lane & 31;
    constexpr int I_IN = 16 * 168, I_GF = 16 * 32, I_OUT = 16 * 32, I_UP = 16 * 176, I_DN = 44 * 32, NITEMS = I_IN + I_GF + I_OUT + I_UP + I_DN;
    unsigned char* ws = a.ws;
    for (int it = gw; it < NITEMS; it += NGW) {
        int r = it; const float* colp; int ldw, ldd; bf16_t* dst; const float* ksc = nullptr;
        if (r < I_IN) { const int kb = r / 168, nb = r % 168, pn = nb >> 3, pb = nb & 7, q0 = 64 * (pb & 3) + 32 * (pb >> 2);
            int col; if (pn < 12) col = inproj_base(pn) + q0 + c; else if (pn < 20) col = ((pb >> 2) ? 4120 : 3096) + 128 * (pn - 12) + 32 * (pb & 3) + c; else col = (q0 == 0) ? (c < 16 ? 1536 + c : (c < 24 ? 3088 + c - 16 : -1)) : -1;
            ldw = INC; ldd = 1024; colp = col >= 0 ? a.in[2] + (size_t)(64 * kb) * INC + col : nullptr; dst = (bf16_t*)(ws + WS_WIN) + (size_t)(32 * nb) * 1024 + 64 * kb;
        } else if ((r -= I_IN) < I_GF) { const int kb = r / 32, nb = r % 32, pn = nb >> 3, pb = nb & 7, col = 256 * pn + 64 * (pb & 3) + 32 * (pb >> 2) + c;
            ldw = 1024; ldd = 1024; colp = (kb < 8 ? a.in[10] + (size_t)(64 * kb) * 1024 : a.in[11] + (size_t)(64 * (kb - 8)) * 1024) + col; dst = (bf16_t*)(ws + WS_WGF) + (size_t)(32 * nb) * 1024 + 64 * kb;
        } else if ((r -= I_GF) < I_OUT) { const int kb = r / 32, nb = r % 32, pn = nb >> 3, pb = nb & 7, col = 256 * pn + 64 * (pb & 3) + 32 * (pb >> 2) + c;
            ldw = 1024; ldd = 1024; colp = a.in[12] + (size_t)(64 * kb) * 1024 + col; dst = (bf16_t*)(ws + WS_WOUT) + (size_t)(32 * nb) * 1024 + 64 * kb;
        } else if ((r -= I_OUT) < I_UP) { const int kb = r / 176, nb = r % 176, pn = nb >> 3, pb = nb & 7, col = (pb >> 2) * 2816 + 128 * pn + 32 * (pb & 3) + c;
            ldw = 5632; ldd = 1024; ksc = a.in[13] + 64 * kb; colp = a.in[14] + (size_t)(64 * kb) * 5632 + col; dst = (bf16_t*)(ws + WS_WUP) + (size_t)(32 * nb) * 1024 + 64 * kb;
        } else { r -= I_UP; const int kb = r / 32, nb = r % 32, pn = nb >> 3, pb = nb & 7, col = 256 * pn + 64 * (pb & 3) + 32 * (pb >> 2) + c;
            ldw = 1024; ldd = 2816; colp = a.in[17] + (size_t)(64 * kb) * 1024 + col; dst = (bf16_t*)(ws + WS_WDN) + (size_t)(32 * nb) * 2816 + 64 * kb; }
        p0_xpose(colp, ldw, dst, ldd, scr, lane, ksc);
    }
}
__device__ __forceinline__ void rms_rows_bf16(Frame& F, const float* x, const float* g, bf16_t* out, float* ssz) {
    const int gw = F.vcu * NWAVES + F.wave, NGW = F.G * NWAVES;
    f32x4 gv[4];
#pragma unroll
    for (int j = 0; j < 4; ++j) gv[j] = ((const GAS f32x4*)g)[F.lane + 64 * j];
    for (int m = gw; m < M_TOK; m += NGW) {
        const GAS f32x4* xr = (const GAS f32x4*)(x + (size_t)m * 1024) + F.lane;
        f32x4 v[4]; float s = 0.f;
#pragma unroll
        for (int j = 0; j < 4; ++j) { v[j] = xr[64 * j]; s += (v[j].x * v[j].x + v[j].y * v[j].y) + (v[j].z * v[j].z + v[j].w * v[j].w); }
        const float rs = rsqrtf(wave_sum(s) * (1.f / 1024.f) + 1e-6f);
        GAS unsigned long long* o8 = (GAS unsigned long long*)(out + (size_t)m * 1024) + F.lane;
#pragma unroll
        for (int j = 0; j < 4; ++j) { const f32x4 y = v[j] * rs * gv[j]; o8[64 * j] = (unsigned long long)pk2(y.x, y.y) | ((unsigned long long)pk2(y.z, y.w) << 32); }
    }
}
__device__ __forceinline__ void final_rows(Frame& F, const bf16_t* x2b, const float* ss2, const float* g, float* out) {
    const int gw = F.vcu * NWAVES + F.wave, NGW = F.G * NWAVES;
    f32x4 gv[4];
#pragma unroll
    for (int j = 0; j < 4; ++j) gv[j] = ((const GAS f32x4*)g)[4 * F.lane + j];
    for (int m = gw; m < M_TOK; m += NGW) {
        const v4u a = ((const GAS v4u*)(x2b + (size_t)m * 1024))[2 * F.lane], b = ((const GAS v4u*)(x2b + (size_t)m * 1024))[2 * F.lane + 1];
        const float rs = rsqrtf(ss2[m] * (1.f / 1024.f) + 1e-6f);
        f32x4 v0, v1, v2, v3; pg8::unpack8(a, v0, v1); pg8::unpack8(b, v2, v3);
        GAS f32x4* o = (GAS f32x4*)(out + (size_t)m * 1024) + 4 * F.lane;
        o[0] = v0 * rs * gv[0]; o[1] = v1 * rs * gv[1]; o[2] = v2 * rs * gv[2]; o[3] = v3 * rs * gv[3];
    }
}
__device__ __forceinline__ void conv_fixup(Frame& F, const float* EDGE, const float* cw, const float* cb, bf16_t* HM) {
    const int gt = (F.vcu * NWAVES + F.wave) * 64 + F.lane, NT = F.G * NWAVES * 64;
    constexpr int NQ = 2816 / 4, TOTAL = 1024 * 2 * NQ;
    for (int it = gt; it < TOTAL; it += NT) {
        const int q = it % NQ, j = (it / NQ) & 1, g = it / (2 * NQ); const int c = 4 * q;
        const bool prev = ((g * 64) & 4095) != 0;
        const float* eg = EDGE + (size_t)g * (6 * 2816) + c; const float* ep = eg - 6 * 2816;
        const f32x4 z = {0.f, 0.f, 0.f, 0.f};
        const f32x4 a0 = *(const f32x4*)(eg + j * 2816);
        const f32x4 a1 = j ? *(const f32x4*)(eg) : (prev ? *(const f32x4*)(ep + 3 * 2816) : z);
        const f32x4 a2 = j ? (prev ? *(const f32x4*)(ep + 3 * 2816) : z) : (prev ? *(const f32x4*)(ep + 2 * 2816) : z);
        const f32x4 vl = *(const f32x4*)(eg + (4 + j) * 2816);
        const f32x4 w0 = *(const f32x4*)(cw + c), w1 = *(const f32x4*)(cw + 2816 + c), w2 = *(const f32x4*)(cw + 5632 + c), b = *(const f32x4*)(cb + c);
        const f32x4 cv = b + w0 * a2 + w1 * a1 + w2 * a0;
        unsigned long long o = (unsigned long long)pk2(pg8::gelu_tanh_fast(cv.x) * vl.x, pg8::gelu_tanh_fast(cv.y) * vl.y) | ((unsigned long long)pk2(pg8::gelu_tanh_fast(cv.z) * vl.z, pg8::gelu_tanh_fast(cv.w) * vl.w) << 32);
        *(unsigned long long*)(HM + ((size_t)g * 64 + j) * 2816 + c) = o;
    }
}

#ifndef PG_ALIGN
#define PG_ALIGN true
#endif
#ifndef PG_SP2
#define PG_SP2 true
#endif
#ifndef REP0
#define REP0 1
#endif
#ifndef REP1
#define REP1 1
#endif
#ifndef REP2
#define REP2 1
#endif
#ifndef REP3
#define REP3 1
#endif
#ifndef REP4
#define REP4 1
#endif
#ifndef REP5
#define REP5 1
#endif
#ifndef REP6
#define REP6 1
#endif
#ifndef REP7
#define REP7 1
#endif
#ifndef REP8
#define REP8 1
#endif
#ifndef REP9
#define REP9 1
#endif
#ifndef REP10
#define REP10 1
#endif
#ifndef REP11
#define REP11 1
#endif
__global__ void __launch_bounds__(NWAVES * 64, 2) skel_fwd(Args args) {
    extern __shared__ __attribute__((aligned(16))) unsigned char lds[];
    Frame F;
    F.lds = (LAS unsigned char*)lds; F.MISC = (volatile LAS unsigned*)(F.lds + MISC_OFF);
    F.tid = threadIdx.x; F.lane = F.tid & 63; F.wave = __builtin_amdgcn_readfirstlane(F.tid >> 6);
    F.G = gridDim.x; { const int bx = blockIdx.x; F.vcu = (F.G % 8 == 0) ? (bx % 8) * (F.G / 8) + bx / 8 : bx; }
    unsigned char* ws = args.ws;
    F.ctl = (gu32*)(ws + WS_CTL);
    for (int u = F.tid; u < (LDS_BYTES - LDSCTL_OFF) / 4; u += NWAVES * 64) ((LAS unsigned*)(F.lds + LDSCTL_OFF))[u] = 0u;
    __syncthreads();
    XcdBarrier bar = xcd_barrier_post((unsigned*)(F.ctl + CW_BAR) + args.li * XCD_BAR_WORDS, F.MISC + 8);
#define GRID_BAR() xcd_barrier(bar)
    const int lo = args.ph_lo, hi = args.ph_hi;
#define IN(k) (lo <= (k) && (k) < hi)
#define BOTH(k) (IN(k) && IN((k) + 1))
    bf16_t* const A = (bf16_t*)(ws + WS_A);
    bf16_t *GQ = (bf16_t*)(ws + WS_GQ), *GK = (bf16_t*)(ws + WS_GK), *GV = (bf16_t*)(ws + WS_GV), *GR = (bf16_t*)(ws + WS_GR), *FQ = (bf16_t*)(ws + WS_FQ), *FK = (bf16_t*)(ws + WS_FK), *FV = (bf16_t*)(ws + WS_FV);
    bf16_t *SG = (bf16_t*)(ws + WS_SG), *SF = (bf16_t*)(ws + WS_SF), *Y = (bf16_t*)(ws + WS_Y), *HM = (bf16_t*)(ws + WS_HM);
    float *GLR = (float*)(ws + WS_GLR), *LF2 = (float*)(ws + WS_LF2), *EDGE = (float*)(ws + WS_EDGE), *C2S = (float*)(ws + WS_C2S), *SS1 = (float*)(ws + WS_SS), *SS2 = SS1 + M_TOK;
    bf16_t* const X2B = (bf16_t*)(ws + WS_SG);

    if (IN(0)) { for (int rp_ = 0; rp_ < REP0; ++rp_) { p0_weights(F, args); if (rp_ + 1 < REP0) GRID_BAR(); } if (BOTH(0)) GRID_BAR(); }
    if (IN(1)) { for (int rp_ = 0; rp_ < REP1; ++rp_) { rms_rows_bf16(F, args.in[0], args.in[1], A, SS1); if (rp_ + 1 < REP1) GRID_BAR(); } if (BOTH(1)) GRID_BAR(); }
    if (IN(2)) { for (int rp_ = 0; rp_ < REP2; ++rp_) {
        pg8::Gemm g{A, (const bf16_t*)(ws + WS_WIN), M_TOK, 5376, 1024}; pg8::StaticOrder S; S.init(M_TOK, 5376, F.G, (int)blockIdx.x);
        pg8::EpiInProj E{GQ, GK, GV, GR, FQ, FK, FV, SG, SF, GLR, LF2, args.in[6], args.in[7], args.in[8], args.in[9]};
        pg8::gemm_phase<pg8::EpiInProj, pg8::StaticOrder, PG_ALIGN, PG_SP2>(F.lds + RING_OFF, g, S, E);
        if (rp_ + 1 < REP2) GRID_BAR(); } if (BOTH(2)) GRID_BAR();
    }
    if (IN(3)) { for (int rp_ = 0; rp_ < REP3; ++rp_) { PHASE_GLA; if (rp_ + 1 < REP3) GRID_BAR(); } if (BOTH(3)) GRID_BAR(); }
    if (IN(5)) { for (int rp_ = 0; rp_ < REP5; ++rp_) {
        pg8::Gemm g{A, (const bf16_t*)(ws + WS_WGF), M_TOK, 1024, 1024}; pg8::StaticOrder S; S.init(M_TOK, 1024, F.G, (int)blockIdx.x);
        pg8::EpiMerge E{SG, SF, Y};
        pg8::gemm_phase<pg8::EpiMerge, pg8::StaticOrder, PG_ALIGN, PG_SP2>(F.lds + RING_OFF, g, S, E);
        if (rp_ + 1 < REP5) GRID_BAR(); } if (BOTH(5)) GRID_BAR();
    }
    if (IN(6)) { for (int rp_ = 0; rp_ < REP6; ++rp_) {
        pg8::Gemm g{Y, (const bf16_t*)(ws + WS_WOUT), M_TOK, 1024, 1024}; pg8::StaticOrder S; S.init(M_TOK, 1024, F.G, (int)blockIdx.x);
        pg8::EpiOut E{args.in[0], A, SS1};
        pg8::gemm_phase<pg8::EpiOut, pg8::StaticOrder, PG_ALIGN, PG_SP2>(F.lds + RING_OFF, g, S, E);
        if (rp_ + 1 < REP6) GRID_BAR(); } if (BOTH(6)) GRID_BAR();
    }
    if (IN(8)) { for (int rp_ = 0; rp_ < REP8; ++rp_) {
        pg8::Gemm g{A, (const bf16_t*)(ws + WS_WUP), M_TOK, 5632, 1024}; pg8::StaticOrder S; S.init(M_TOK, 5632, F.G, (int)blockIdx.x);
        pg8::EpiUp E{HM, EDGE, args.in[15], args.in[16], SS1};
        pg8::gemm_phase<pg8::EpiUp, pg8::StaticOrder, PG_ALIGN, PG_SP2>(F.lds + RING_OFF, g, S, E);
        if (rp_ + 1 < REP8) GRID_BAR(); } if (BOTH(8)) GRID_BAR();
    }
    if (IN(9)) { for (int rp_ = 0; rp_ < REP9; ++rp_) { conv_fixup(F, EDGE, args.in[15], args.in[16], HM); if (rp_ + 1 < REP9) GRID_BAR(); } if (BOTH(9)) GRID_BAR(); }
    if (IN(10)) { for (int rp_ = 0; rp_ < REP10; ++rp_) {
        pg8::Gemm g{HM, (const bf16_t*)(ws + WS_WDN), M_TOK, 1024, 2816}; pg8::StaticOrder S; S.init(M_TOK, 1024, F.G, (int)blockIdx.x);
        pg8::EpiDown E{A, X2B, SS2};
        pg8::gemm_phase<pg8::EpiDown, pg8::StaticOrder, PG_ALIGN, PG_SP2>(F.lds + RING_OFF, g, S, E);
        if (rp_ + 1 < REP10) GRID_BAR(); } if (BOTH(10)) GRID_BAR();
    }
    if (IN(11)) { for (int rp_ = 0; rp_ < REP11; ++rp_) { final_rows(F, X2B, SS2, args.in[18], args.out); } }
#undef IN
#undef BOTH
}
static const int ST_PH_LO[10] = {1, 2, 3, 4, 5, 6, 7, 8, 10, 11}, ST_PH_HI[10] = {2, 3, 4, 5, 6, 7, 8, 10, 11, 12};
#ifndef OPT_MASK
#define OPT_MASK 0x3F3
#endif
extern "C" void kernel_launch(void* const* d_in, const int* in_sizes, int n_in, void* d_out, int out_size, void* d_ws, size_t ws_size, hipStream_t stream) {
    static int grid = 0;
    if (grid == 0) {
        if (n_in != 19 || out_size != M_TOK * DM || ws_size < WS_END) { fprintf(stderr, "kernel_launch: unexpected shapes (n_in %d out %d ws %zu)\n", n_in, out_size, ws_size); grid = -1; return; }
        int dev = 0, cus = 0, per_cu = 0;
        if (hipGetDevice(&dev) != hipSuccess || hipDeviceGetAttribute(&cus, hipDeviceAttributeMultiprocessorCount, dev) != hipSuccess) { grid = -1; return; }
        if (hipFuncSetAttribute((const void*)skel_fwd, hipFuncAttributeMaxDynamicSharedMemorySize, LDS_BYTES) != hipSuccess) { fprintf(stderr, "kernel_launch: hipFuncSetAttribute failed\n"); grid = -1; return; }
        if (hipOccupancyMaxActiveBlocksPerMultiprocessor(&per_cu, (const void*)skel_fwd, NWAVES * 64, LDS_BYTES) != hipSuccess || per_cu < 1) fprintf(stderr, "kernel_launch: occupancy query reports %d\n", per_cu);
        (void)hipGetLastError();
        grid = cus;
    }
    if (grid < 0) return;
    (void)hipMemsetAsync((char*)d_ws + WS_CTL, 0, CTL_ZERO_BYTES, stream);
    Args a{};
    for (int i = 0; i < 19; ++i) a.in[i] = (const float*)d_in[i];
    a.out = (float*)d_out; a.ws = (unsigned char*)d_ws;
    int li = 0;
    auto launch = [&](int lo, int hi) { a.ph_lo = lo; a.ph_hi = hi; a.li = li++; hipLaunchKernelGGL(skel_fwd, dim3(grid), dim3(NWAVES * 64), LDS_BYTES, stream, a); };
    const unsigned mask = OPT_MASK;
#ifdef PROBE_SPLIT
    launch(0, PROBE_SPLIT + 1);
#ifdef PROBE_DUP
    launch(PROBE_SPLIT, PROBE_SPLIT + 1);
#endif
    launch(PROBE_SPLIT + 1, N_PHASES);
    return;
#endif
    int pend_lo = 0, pend_hi = 1;
    for (int s = 0; s < 10; ++s) {
#ifdef DBG_G1MASK
        if (s == 1 && (mask & 2u)) { launch(pend_lo, ST_PH_HI[1]); pend_lo = pend_hi = 0; gold_forward(d_in, (float*)d_out, (unsigned char*)d_ws, stream, 1, 2, DBG_G1MASK); continue; }
#endif
        if (mask & (1u << s)) { if (pend_hi == ST_PH_LO[s]) pend_hi = ST_PH_HI[s]; else { if (pend_hi > pend_lo) launch(pend_lo, pend_hi); pend_lo = ST_PH_LO[s]; pend_hi = ST_PH_HI[s]; } }
        else { if (pend_hi > pend_lo) launch(pend_lo, pend_hi); pend_lo = pend_hi = 0; gold_forward(d_in, (float*)d_out, (unsigned char*)d_ws, stream, s, s + 1); }
    }
    if (pend_hi > pend_lo) launch(pend_lo, pend_hi);
#ifdef PROBE_EXTRA
#ifndef PROBE_PAD
#define PROBE_PAD 0
#endif
    a.pad = PROBE_PAD; launch(PROBE_EXTRA, PROBE_EXTRA + 1);
#endif
}
```

```cpp
#include <hip/hip_runtime.h>
#include <hip/hip_bf16.h>
#include <cstdint>
#include <cstdio>
#include <cmath>

typedef unsigned short bf16_t;
__device__ __forceinline__ float bf2f(bf16_t v) { return __uint_as_float(((unsigned)v) << 16); }
__device__ __forceinline__ bf16_t f2bf(float f) { unsigned u = __float_as_uint(f); return (bf16_t)((u + 0x7fffu + ((u >> 16) & 1u)) >> 16); }
#define LOG2E 1.4426950408889634f
#define QSCALE2 (0.125f * 1.4426950408889634f)

#ifndef PG_WGM
#define PG_WGM 4
#endif
constexpr int M_TOK = 65536, DM = 1024, SEQ = 4096, NB = 16, DFF = 2816, INC = 5144;
constexpr size_t MiB = 1u << 20;
constexpr size_t WS_CTL = 0;
constexpr size_t WS_W = 1 * MiB;
constexpr size_t WS_A = 32 * MiB;
constexpr size_t WS_GQ = 160 * MiB, WS_GK = 192 * MiB, WS_GV = 224 * MiB, WS_GR = 288 * MiB, WS_FQ = 352 * MiB, WS_FK = 416 * MiB, WS_FV = 480 * MiB;
constexpr size_t WS_SG = 544 * MiB, WS_SF = 672 * MiB;
constexpr size_t WS_GLR = 800 * MiB, WS_LF2 = 804 * MiB, WS_C2S = 806 * MiB;
constexpr size_t WS_Y = 160 * MiB;
constexpr size_t WS_HM = 160 * MiB;
constexpr size_t WS_SS = 512 * 1024;
constexpr size_t WS_C = 832 * MiB;
constexpr size_t WS_END = 1008 * MiB;
#define OPT_MASK 0x3FF
namespace gold {
__device__ __forceinline__ float wsum(float v) {
#pragma unroll
    for (int o = 1; o < 64; o <<= 1) v += __shfl_xor(v, o);
    return v;
}
__device__ __forceinline__ float logsigmoidf_(float z) { return fminf(z, 0.f) - log1pf(expf(-fabsf(z))); }
__device__ __forceinline__ float sigmoidf_(float z) { return 1.f / (1.f + expf(-z)); }

__global__ void __launch_bounds__(256) k_rmsnorm_bf16(const float* x, const float* g, bf16_t* out, int rows) {
    const int w = (blockIdx.x * 256 + threadIdx.x) >> 6, lane = threadIdx.x & 63;
    if (w >= rows) return;
    const float* xr = x + (size_t)w * 1024;
    float v[16]; float s = 0.f;
#pragma unroll
    for (int j = 0; j < 16; ++j) { v[j] = xr[lane + 64 * j]; s += v[j] * v[j]; }
    s = wsum(s); const float rs = rsqrtf(s * (1.f / 1024.f) + 1e-6f);
#pragma unroll
    for (int j = 0; j < 16; ++j) out[(size_t)w * 1024 + lane + 64 * j] = f2bf(v[j] * rs * g[lane + 64 * j]);
}
__global__ void __launch_bounds__(256) k_rmsnorm_f32(float* x, const float* g, int rows) {
    const int w = (blockIdx.x * 256 + threadIdx.x) >> 6, lane = threadIdx.x & 63;
    if (w >= rows) return;
    float* xr = x + (size_t)w * 1024;
    float v[16]; float s = 0.f;
#pragma unroll
    for (int j = 0; j < 16; ++j) { v[j] = xr[lane + 64 * j]; s += v[j] * v[j]; }
    s = wsum(s); const float rs = rsqrtf(s * (1.f / 1024.f) + 1e-6f);
#pragma unroll
    for (int j = 0; j < 16; ++j) xr[lane + 64 * j] = v[j] * rs * g[lane + 64 * j];
}
__global__ void __launch_bounds__(256) k_gemm(const bf16_t* A, int lda, const float* W, int ldw, float* C, int ldc, int N, int K) {
    __shared__ float As[16][68]; __shared__ float Bs[16][68];
    const int t = threadIdx.x, tx = t & 15, ty = t >> 4;
    const int m0 = blockIdx.y * 64, n0 = blockIdx.x * 64;
    float acc[4][4];
#pragma unroll
    for (int i = 0; i < 4; ++i)
#pragma unroll
        for (int j = 0; j < 4; ++j) acc[i][j] = 0.f;
    const int ar = t >> 2, ak = (t & 3) * 4, bk = t >> 4, bn = (t & 15) * 4;
    for (int k0 = 0; k0 < K; k0 += 16) {
        const bf16_t* ap = A + (size_t)(m0 + ar) * lda + k0 + ak;
#pragma unroll
        for (int i = 0; i < 4; ++i) As[ak + i][ar] = bf2f(ap[i]);
        const float* wp = W + (size_t)(k0 + bk) * ldw + n0 + bn;
#pragma unroll
        for (int i = 0; i < 4; ++i) Bs[bk][bn + i] = (n0 + bn + i < N) ? wp[i] : 0.f;
        __syncthreads();
#pragma unroll
        for (int kk = 0; kk < 16; ++kk) {
            float a[4], b[4];
#pragma unroll
            for (int i = 0; i < 4; ++i) { a[i] = As[kk][ty * 4 + i]; b[i] = Bs[kk][tx * 4 + i]; }
#pragma unroll
            for (int i = 0; i < 4; ++i)
#pragma unroll
                for (int j = 0; j < 4; ++j) acc[i][j] += a[i] * b[j];
        }
        __syncthreads();
    }
#pragma unroll
    for (int i = 0; i < 4; ++i)
#pragma unroll
        for (int j = 0; j < 4; ++j) if (n0 + tx * 4 + j < N) C[(size_t)(m0 + ty * 4 + i) * ldc + n0 + tx * 4 + j] = acc[i][j];
}
__global__ void __launch_bounds__(256) k_inproj_epi(const float* P, int row0, const float* fb, const float* qg, const float* kg, const float* gate_b,
                                                    bf16_t* GQ, bf16_t* GK, bf16_t* GV, bf16_t* GR, float* GLR, bf16_t* FQ, bf16_t* FK, bf16_t* FV, float* LF2, bf16_t* SG, bf16_t* SF, int gm) {
    const int r = blockIdx.x, t = threadIdx.x; const float* p = P + (size_t)r * 5144; const size_t m = (size_t)row0 + r;
    if (gm & 1) { GQ[m * 256 + t] = f2bf(p[t] * 0.125f); GK[m * 256 + t] = f2bf(p[256 + t]); }
    if (gm & 1)
#pragma unroll
    for (int j = 0; j < 2; ++j) { const int c = t + 256 * j; GV[m * 512 + c] = f2bf(p[512 + c]); GR[m * 512 + c] = f2bf(p[1024 + c]); FV[m * 512 + c] = f2bf(p[2576 + c]); }
    if ((gm & 2) && t < 16) GLR[m * 16 + t] = p[1536 + t];
    if ((gm & 2) && t < 8) LF2[m * 8 + t] = logsigmoidf_(p[3088 + t] + fb[t]) * LOG2E;
    if (gm & 4)
#pragma unroll
    for (int j = 0; j < 2; ++j) { const int c = t + 256 * j;
        float v = p[1552 + c]; float rs = rsqrtf(wsum(v * v) * (1.f / 64.f) + 1e-6f); FQ[m * 512 + c] = f2bf(v * rs * qg[c & 63] * QSCALE2);
        v = p[2064 + c]; rs = rsqrtf(wsum(v * v) * (1.f / 64.f) + 1e-6f); FK[m * 512 + c] = f2bf(v * rs * kg[c & 63]); }
    if (gm & 8)
#pragma unroll
    for (int j = 0; j < 4; ++j) { const int c = t + 256 * j; const float sf_ = sigmoidf_(p[4120 + c] + gate_b[1024 + c]); SG[m * 1024 + c] = f2bf(sigmoidf_(p[3096 + c] + gate_b[c]) / sf_); SF[m * 1024 + c] = f2bf(sf_); }
}
__global__ void __launch_bounds__(256) k_gla(const bf16_t* GQ, const bf16_t* GK, const bf16_t* GV, const bf16_t* GR, const float* GLR, const float* w2, const float* ba, const float* gn, bf16_t* OGF) {
    __shared__ float sa[64], sq[64], sk[64], so[2][128], sred[4];
    const int bh = blockIdx.x, b = bh >> 2, h = bh & 3, t = threadIdx.x, dv = t & 127, dh = t >> 7;
    float S[32];
#pragma unroll
    for (int i = 0; i < 32; ++i) S[i] = 0.f;
    float w2c[16]; float bac = 0.f;
#pragma unroll
    for (int r = 0; r < 16; ++r) w2c[r] = (t < 64) ? w2[r * 256 + h * 64 + t] : 0.f;
    if (t < 64) bac = ba[h * 64 + t];
    const float gnv = gn[h * 128 + dv];
    for (int tok = 0; tok < 4096; ++tok) {
        const size_t m = (size_t)b * 4096 + tok;
        if (t < 64) { float z = bac;
#pragma unroll
            for (int r = 0; r < 16; ++r) z += GLR[m * 16 + r] * w2c[r];
            sa[t] = expf(logsigmoidf_(z) * (1.f / 16.f)); sq[t] = bf2f(GQ[m * 256 + h * 64 + t]); sk[t] = bf2f(GK[m * 256 + h * 64 + t]); }
        __syncthreads();
        const float v = bf2f(GV[m * 512 + h * 128 + dv]); float op = 0.f;
#pragma unroll
        for (int i = 0; i < 32; ++i) { const int d = 32 * dh + i; S[i] = sa[d] * S[i] + sk[d] * v; op += sq[d] * S[i]; }
        so[dh][dv] = op;
        __syncthreads();
        const float o = so[0][dv] + so[1][dv]; const float ss = wsum(o * o);
        if ((t & 63) == 0) sred[t >> 6] = ss;
        __syncthreads();
        const float tot = sred[0] + sred[1]; const float rs = rsqrtf(tot * (1.f / 128.f) + 1e-6f);
        if (dh == 0) { const float gr = bf2f(GR[m * 512 + h * 128 + dv]); OGF[m * 1024 + h * 128 + dv] = f2bf(o * rs * gnv * gr * sigmoidf_(gr)); }
    }
}
__global__ void __launch_bounds__(64) k_cumsum(const float* LF2, float* C2S) {
    const int bh = blockIdx.x, b = bh >> 3, h = bh & 7, lane = threadIdx.x;
    float s = 0.f;
    for (int i = 0; i < 64; ++i) s += LF2[((size_t)b * 4096 + lane * 64 + i) * 8 + h];
    float inc = s;
#pragma unroll
    for (int o = 1; o < 64; o <<= 1) { const float u = __shfl_up(inc, o); if (lane >= o) inc += u; }
    float run = inc - s;
    for (int i = 0; i < 64; ++i) { run += LF2[((size_t)b * 4096 + lane * 64 + i) * 8 + h]; C2S[(size_t)bh * 4096 + lane * 64 + i] = run; }
}
__global__ void __launch_bounds__(256) k_fox(const bf16_t* FQ, const bf16_t* FK, const bf16_t* FV, const float* C2S, bf16_t* OGF) {
    __shared__ float sk[64][64], sv[64][64], sc[64];
    const int qb = blockIdx.x, bh = blockIdx.y, b = bh >> 3, h = bh & 7, t = threadIdx.x, tq = qb * 256 + t;
    const size_t mq = (size_t)b * 4096 + tq;
    float q[64], o[64];
#pragma unroll
    for (int d = 0; d < 64; ++d) { q[d] = bf2f(FQ[mq * 512 + h * 64 + d]); o[d] = 0.f; }
    const float ct = C2S[(size_t)bh * 4096 + tq];
    float mr = -INFINITY, l = 0.f;
    const int ntile = (qb * 256 + 256) / 64;
    for (int kt = 0; kt < ntile; ++kt) {
        __syncthreads();
        for (int e = t; e < 4096; e += 256) { const int j = e >> 6, d = e & 63; const size_t mk = (size_t)b * 4096 + kt * 64 + j; sk[j][d] = bf2f(FK[mk * 512 + h * 64 + d]); sv[j][d] = bf2f(FV[mk * 512 + h * 64 + d]); }
        if (t < 64) sc[t] = C2S[(size_t)bh * 4096 + kt * 64 + t];
        __syncthreads();
        for (int j = 0; j < 64; ++j) {
            const int s = kt * 64 + j;
            if (s <= tq) {
                float dot = 0.f;
#pragma unroll
                for (int d = 0; d < 64; ++d) dot += q[d] * sk[j][d];
                const float lg = dot + ct - sc[j];
                const float mn = fmaxf(mr, lg), sc_ = exp2f(mr - mn), p = exp2f(lg - mn);
                l = l * sc_ + p;
#pragma unroll
                for (int d = 0; d < 64; ++d) o[d] = o[d] * sc_ + p * sv[j][d];
                mr = mn;
            }
        }
    }
    const float il = 1.f / l;
#pragma unroll
    for (int d = 0; d < 64; ++d) OGF[mq * 1024 + 512 + h * 64 + d] = f2bf(o[d] * il);
}
__global__ void __launch_bounds__(256) k_merge(const float* C1, const float* C2, const bf16_t* SG, const bf16_t* SF, bf16_t* Y, int row0, int n) {
    const int i = blockIdx.x * 256 + threadIdx.x; if (i >= n) return; const size_t g = (size_t)row0 * 1024 + i;
    Y[g] = f2bf(bf2f(SF[g]) * (bf2f(SG[g]) * C1[i] + C2[i]));
}
__global__ void __launch_bounds__(256) k_resid(const float* base, const float* C, float* out, int row0, int n) {
    const int i = blockIdx.x * 256 + threadIdx.x; if (i >= n) return; const size_t g = (size_t)row0 * 1024 + i;
    out[g] = base[g] + C[i];
}
__device__ __forceinline__ float gelu_tanh_(float x) { return 0.5f * x * (1.f + tanhf(0.7978845608028654f * (x + 0.044715f * x * x * x))); }
__global__ void __launch_bounds__(256) k_conv_gelu(const float* U, int row0, int rows, const float* cw, const float* cb, bf16_t* HM) {
    const size_t i = (size_t)blockIdx.x * 256 + threadIdx.x; if (i >= (size_t)rows * 2816) return;
    const int r = (int)(i / 2816), c = (int)(i % 2816); const int tok = (row0 + r) & 4095;
    const float a0 = U[(size_t)r * 5632 + c], a1 = tok >= 1 ? U[(size_t)(r - 1) * 5632 + c] : 0.f, a2 = tok >= 2 ? U[(size_t)(r - 2) * 5632 + c] : 0.f;
    const float cv = cb[c] + cw[c] * a2 + cw[2816 + c] * a1 + cw[2 * 2816 + c] * a0;
    HM[((size_t)row0 + r) * 2816 + c] = f2bf(gelu_tanh_(cv) * U[(size_t)r * 5632 + 2816 + c]);
}
}
static void gold_forward(void* const* d_in, float* out, unsigned char* ws, hipStream_t st, int s_lo, int s_hi, int gm1 = 15) {
    const float* x = (const float*)d_in[0];
    bf16_t* A = (bf16_t*)(ws + WS_A); bf16_t *GQ = (bf16_t*)(ws + WS_GQ), *GK = (bf16_t*)(ws + WS_GK), *GV = (bf16_t*)(ws + WS_GV), *GR = (bf16_t*)(ws + WS_GR);
    bf16_t *FQ = (bf16_t*)(ws + WS_FQ), *FK = (bf16_t*)(ws + WS_FK), *FV = (bf16_t*)(ws + WS_FV), *SG = (bf16_t*)(ws + WS_SG), *SF = (bf16_t*)(ws + WS_SF);
    float *GLR = (float*)(ws + WS_GLR), *LF2 = (float*)(ws + WS_LF2), *C2S = (float*)(ws + WS_C2S), *C1 = (float*)(ws + WS_C), *C2 = (float*)(ws + WS_C + 32 * MiB);
    bf16_t *Y = (bf16_t*)(ws + WS_Y), *HM = (bf16_t*)(ws + WS_HM);
    const int CH = 8192, NCH = M_TOK / CH;
#define ST(k) (s_lo <= (k) && (k) < s_hi)
    if (ST(0)) gold::k_rmsnorm_bf16<<<M_TOK / 4, 256, 0, st>>>(x, (const float*)d_in[1], A, M_TOK);
    if (ST(1)) for (int c = 0; c < NCH; ++c) {
        gold::k_gemm<<<dim3((INC + 63) / 64, CH / 64), 256, 0, st>>>(A + (size_t)c * CH * 1024, 1024, (const float*)d_in[2], INC, C1, INC, INC, 1024);
        gold::k_inproj_epi<<<CH, 256, 0, st>>>(C1, c * CH, (const float*)d_in[6], (const float*)d_in[7], (const float*)d_in[8], (const float*)d_in[9], GQ, GK, GV, GR, GLR, FQ, FK, FV, LF2, SG, SF, gm1);
    }
    if (ST(2)) gold::k_gla<<<64, 256, 0, st>>>(GQ, GK, GV, GR, GLR, (const float*)d_in[3], (const float*)d_in[4], (const float*)d_in[5], A);
    if (ST(3)) { gold::k_cumsum<<<128, 64, 0, st>>>(LF2, C2S); gold::k_fox<<<dim3(16, 128), 256, 0, st>>>(FQ, FK, FV, C2S, A); }
    if (ST(4)) for (int c = 0; c < NCH; ++c) {
        gold::k_gemm<<<dim3(16, CH / 64), 256, 0, st>>>(A + (size_t)c * CH * 1024, 1024, (const float*)d_in[10], 1024, C1, 1024, 1024, 512);
        gold::k_gemm<<<dim3(16, CH / 64), 256, 0, st>>>(A + (size_t)c * CH * 1024 + 512, 1024, (const float*)d_in[11], 1024, C2, 1024, 1024, 512);
        gold::k_merge<<<CH * 1024 / 256, 256, 0, st>>>(C1, C2, SG, SF, Y, c * CH, CH * 1024);
    }
    if (ST(5)) for (int c = 0; c < NCH; ++c) {
        gold::k_gemm<<<dim3(16, CH / 64), 256, 0, st>>>(Y + (size_t)c * CH * 1024, 1024, (const float*)d_in[12], 1024, C1, 1024, 1024, 1024);
        gold::k_resid<<<CH * 1024 / 256, 256, 0, st>>>(x, C1, out, c * CH, CH * 1024);
    }
    if (ST(6)) gold::k_rmsnorm_bf16<<<M_TOK / 4, 256, 0, st>>>(out, (const float*)d_in[13], A, M_TOK);
    if (ST(7)) for (int c = 0; c < NCH; ++c) {
        gold::k_gemm<<<dim3(5632 / 64, CH / 64), 256, 0, st>>>(A + (size_t)c * CH * 1024, 1024, (const float*)d_in[14], 5632, C1, 5632, 5632, 1024);
        gold::k_conv_gelu<<<(unsigned)(((size_t)CH * 2816 + 255) / 256), 256, 0, st>>>(C1, c * CH, CH, (const float*)d_in[15], (const float*)d_in[16], HM);
    }
    if (ST(8)) for (int c = 0; c < NCH; ++c) {
        gold::k_gemm<<<dim3(16, CH / 64), 256, 0, st>>>(HM + (size_t)c * CH * 2816, 2816, (const float*)d_in[17], 1024, C1, 1024, 1024, 2816);
        gold::k_resid<<<CH * 1024 / 256, 256, 0, st>>>(out, C1, out, c * CH, CH * 1024);
    }
    if (ST(9)) gold::k_rmsnorm_f32<<<M_TOK / 4, 256, 0, st>>>(out, (const float*)d_in[18], M_TOK);
#undef ST
}
namespace pg8 {
#define PG8_LAS __attribute__((address_space(3)))
typedef unsigned short bf16_t;
typedef short bf16x8 __attribute__((ext_vector_type(8)));
typedef float f32x4 __attribute__((ext_vector_type(4)));
typedef unsigned u32x4 __attribute__((ext_vector_type(4)));
constexpr int BM = 256, BK = 64, HALF = 128, HTB = HALF * BK * 2  , STAGE_BYTES = 8 * HTB, NXCD = 8, WGM = PG_WGM;

__host__ __device__ __forceinline__ int lds_byte(int r, int c) { const int st = (r >> 4) * 2 + (c >> 5), rr = r & 15, cc = c & 31, ob = rr * 64 + cc * 2; return st * 1024 + (ob ^ (((ob >> 9) & 1) << 5)); }
__host__ __device__ __forceinline__ void stage_rc(int b, int& R, int& C) { const int st = b / 1024, sb = b % 1024, swz = sb ^ (((sb >> 9) & 1) << 5); R = (st >> 1) * 16 + swz / 64; C = (st & 1) * 32 + (swz % 64) / 2; }
__host__ __device__ __forceinline__ int perm32(int rho) { const int n = rho >> 4, i = rho & 15; return 8 * (i >> 2) + 4 * n + (i & 3); }

struct Unit { int pm, pn; };
struct Gemm { const bf16_t* A; const bf16_t* Bt; int M, N, K; };

struct StaticOrder {
    int nM, nN, nwg, G, c;
    __host__ __device__ void init(int M, int N, int G_, int c_) { nM = M / BM; nN = N / BM; nwg = nM * nN; G = G_; c = c_; }
    __host__ __device__ bool next(int i, Unit& u) const {
        const long L = (long)i * G + c; if (L >= nwg) return false;
        int wgid = (int)L; { const int q = nwg / NXCD, r = nwg % NXCD, xcd = wgid % NXCD, off = wgid / NXCD; wgid = (xcd < r ? xcd * (q + 1) : r * (q + 1) + (xcd - r) * q) + off; }
        const int nig = WGM * nN, gid = wgid / nig, fm = gid * WGM, gsz = (nM - fm) < WGM ? (nM - fm) : WGM;
        u.pm = fm + ((wgid % nig) % gsz); u.pn = (wgid % nig) / gsz; return true;
    }
    __device__ __forceinline__ void a_ready(const Unit&) const {}
    __device__ __forceinline__ void done(const Unit&) const {}
};

typedef float f32x2 __attribute__((ext_vector_type(2))); typedef __bf16 bf16x2_t __attribute__((ext_vector_type(2)));
__device__ __forceinline__ unsigned cvt_pk_bf16(float lo, float hi) { f32x2 v = {lo, hi}; bf16x2_t b = __builtin_convertvector(v, bf16x2_t); return __builtin_bit_cast(unsigned, b); }
template <class Epi, class Sched, bool ALIGN_EPI = false, bool SP2 = false>
__device__ __forceinline__ void gemm_phase(PG8_LAS unsigned char* lds, const Gemm g, const Sched& S, const Epi& E) {
    const int tid = threadIdx.x, wid = __builtin_amdgcn_readfirstlane(tid >> 6), lane = tid & 63, wr = wid >> 2, wc = wid & 3, fr = lane & 15, fq = lane >> 4;
    const int K = g.K, nt = K / BK;
    unsigned voffA[2], voffB[2];
#pragma unroll
    for (int i = 0; i < 2; ++i) { int R, C; stage_rc(tid * 16 + i * 8192, R, C); const int Rb = Epi::PERM ? ((R & ~31) + perm32(R & 31)) : R;
        voffA[i] = (unsigned)(R * K + C) * 2u; voffB[i] = (unsigned)(Rb * K + C) * 2u; }
    const size_t kstep = (size_t)(BK * 2);
    const size_t hstep = (size_t)HALF * K * 2;
    const size_t tstep = 2 * hstep;
    const unsigned ldsw = (unsigned)wid * 1024u;
    const int aoff = lds_byte(wr * 64 + fr, fq * 8), boff = lds_byte(wc * 32 + fr, fq * 8);
#define PG8_SA(b, h) (((b) * 2 + (h)) * HTB)
#define PG8_SB(b, h) ((4 + (b) * 2 + (h)) * HTB)
#define PG8_STAGE(bufoff, gbase, voff) do { _Pragma("unroll") for (int _i = 0; _i < 2; ++_i) \
        __builtin_amdgcn_global_load_lds((const unsigned*)((const char*)(gbase) + (voff)[_i]), (PG8_LAS unsigned*)(lds + (bufoff) + ldsw + _i * 8192), 16, 0, 0); } while (0)
#define PG8_LDA(dst, b, h) do { _Pragma("unroll") for (int m = 0; m < 4; ++m) _Pragma("unroll") for (int k = 0; k < 2; ++k) dst[m][k] = *(const PG8_LAS bf16x8*)(lds + PG8_SA(b, h) + aoff + m * 2048 + k * 1024); } while (0)
#define PG8_LDB(dst, b, h) do { _Pragma("unroll") for (int n = 0; n < 2; ++n) _Pragma("unroll") for (int k = 0; k < 2; ++k) dst[n][k] = *(const PG8_LAS bf16x8*)(lds + PG8_SB(b, h) + boff + n * 2048 + k * 1024); } while (0)
#define PG8_MMA(ai, bj, At, Bt) do { __builtin_amdgcn_s_setprio(1); _Pragma("unroll") for (int m = 0; m < 4; ++m) _Pragma("unroll") for (int n = 0; n < 2; ++n) _Pragma("unroll") for (int k = 0; k < 2; ++k) \
        acc[ai][bj][m][n] = __builtin_amdgcn_mfma_f32_16x16x32_bf16(Bt[n][k], At[m][k], acc[ai][bj][m][n], 0, 0, 0); __builtin_amdgcn_s_setprio(0); } while (0)
#define PG8_WAIT_V(n) asm volatile("s_waitcnt vmcnt(" #n ")" ::: "memory")
#define PG8_WAIT_L(n) asm volatile("s_waitcnt lgkmcnt(" #n ")" ::: "memory")
#define PG8_BAR __builtin_amdgcn_s_barrier()
#define PG8_SCHED __builtin_amdgcn_sched_barrier(0)
    Unit cur, nxt; int ui = 0;
    if (!S.next(0, cur)) return;
    f32x4 acc[2][2][4][2];
#pragma unroll
    for (int a = 0; a < 2; ++a)
#pragma unroll
        for (int b = 0; b < 2; ++b)
#pragma unroll
            for (int m = 0; m < 4; ++m)
#pragma unroll
                for (int n = 0; n < 2; ++n) acc[a][b][m][n] = (f32x4){0.f, 0.f, 0.f, 0.f};
    bf16x8 At[4][2], B0[2][2], B1[2][2];
    const char* cA = (const char*)g.A + (size_t)cur.pm * tstep; const char* cB = (const char*)g.Bt + (size_t)cur.pn * tstep;
    S.a_ready(cur);
    if constexpr (SP2) {
        PG8_STAGE(PG8_SB(0, 0), cB, voffB); PG8_STAGE(PG8_SB(0, 1), cB + hstep, voffB); PG8_STAGE(PG8_SA(0, 0), cA, voffA); PG8_STAGE(PG8_SA(0, 1), cA + hstep, voffA);
        if (wr == 1) PG8_BAR;
        PG8_WAIT_V(2); PG8_BAR;
        PG8_STAGE(PG8_SB(1, 0), cB + kstep, voffB); PG8_STAGE(PG8_SA(1, 0), cA + kstep, voffA); PG8_STAGE(PG8_SB(1, 1), cB + hstep + kstep, voffB);
        PG8_WAIT_V(6); PG8_BAR;
    } else {
        PG8_STAGE(PG8_SB(0, 0), cB, voffB); PG8_STAGE(PG8_SA(0, 0), cA, voffA); PG8_STAGE(PG8_SB(0, 1), cB + hstep, voffB); PG8_STAGE(PG8_SA(0, 1), cA + hstep, voffA);
        if (wr == 1) PG8_BAR;
        PG8_WAIT_V(4); PG8_BAR;
        PG8_STAGE(PG8_SB(1, 0), cB + kstep, voffB); PG8_STAGE(PG8_SA(1, 0), cA + kstep, voffA); PG8_STAGE(PG8_SB(1, 1), cB + hstep + kstep, voffB);
        PG8_WAIT_V(6); PG8_BAR;
    }
    for (;;) {
        const bool has_next = S.next(ui + 1, nxt);
        const char* nA = has_next ? (const char*)g.A + (size_t)nxt.pm * tstep : cA; const char* nB = has_next ? (const char*)g.Bt + (size_t)nxt.pn * tstep : cB;
        for (int t = 0; t < nt; t += 2) {
            if constexpr (Epi::MIDK) { if (t == nt / 2) { PG8_SCHED; E.mid(acc, cur, wr, wc, fr, fq); PG8_SCHED; } }
            const bool last = (t == nt - 2);
            const char* a1 = cA + (size_t)(t + 1) * kstep;
            const char* a2 = last ? nA : cA + (size_t)(t + 2) * kstep; const char* b2 = last ? nB : cB + (size_t)(t + 2) * kstep;
            const char* a3 = a2 + kstep; const char* b3 = b2 + kstep;
            if (last && has_next) S.a_ready(nxt);
            if constexpr (SP2) {
            PG8_LDB(B0, 0, 0); PG8_LDB(B1, 0, 1); PG8_SCHED; PG8_LDA(At, 0, 0); PG8_STAGE(PG8_SA(1, 1), a1 + hstep, voffA);
            PG8_WAIT_V(8); PG8_WAIT_L(0); PG8_BAR; PG8_MMA(0, 0, At, B0); PG8_MMA(0, 1, At, B1); PG8_BAR; PG8_SCHED;
            PG8_LDA(At, 0, 1); PG8_STAGE(PG8_SB(0, 0), b2, voffB); PG8_STAGE(PG8_SB(0, 1), b2 + hstep, voffB); PG8_STAGE(PG8_SA(0, 0), a2, voffA);
            PG8_WAIT_V(8); PG8_WAIT_L(0); PG8_BAR; PG8_MMA(1, 0, At, B0); PG8_MMA(1, 1, At, B1); PG8_BAR; PG8_SCHED;
            PG8_LDB(B0, 1, 0); PG8_LDB(B1, 1, 1); PG8_SCHED; PG8_LDA(At, 1, 0); PG8_STAGE(PG8_SA(0, 1), a2 + hstep, voffA);
            PG8_WAIT_V(8); PG8_WAIT_L(0); PG8_BAR; PG8_MMA(0, 0, At, B0); PG8_MMA(0, 1, At, B1); PG8_BAR; PG8_SCHED;
            PG8_LDA(At, 1, 1); PG8_STAGE(PG8_SB(1, 0), b3, voffB); PG8_STAGE(PG8_SB(1, 1), b3 + hstep, voffB); PG8_STAGE(PG8_SA(1, 0), a3, voffA);
            PG8_WAIT_V(8); PG8_WAIT_L(0); PG8_BAR; PG8_MMA(1, 0, At, B0); PG8_MMA(1, 1, At, B1); PG8_BAR; PG8_SCHED;
            } else {
            PG8_LDB(B0, 0, 0); PG8_SCHED; PG8_LDA(At, 0, 0); PG8_STAGE(PG8_SA(1, 1), a1 + hstep, voffA);
            PG8_WAIT_L(8); PG8_BAR; PG8_WAIT_L(0); PG8_MMA(0, 0, At, B0); PG8_BAR; PG8_SCHED;
            PG8_LDB(B1, 0, 1); PG8_STAGE(PG8_SB(0, 0), b2, voffB);
            PG8_BAR; PG8_WAIT_L(0); PG8_MMA(0, 1, At, B1); PG8_BAR;
            PG8_LDA(At, 0, 1); PG8_STAGE(PG8_SA(0, 0), a2, voffA);
            PG8_BAR; PG8_WAIT_L(0); PG8_MMA(1, 0, At, B0); PG8_BAR; PG8_SCHED;
            PG8_STAGE(PG8_SB(0, 1), b2 + hstep, voffB);
            PG8_WAIT_V(6); PG8_BAR; PG8_MMA(1, 1, At, B1); PG8_BAR;
            PG8_LDB(B0, 1, 0); PG8_SCHED; PG8_LDA(At, 1, 0); PG8_STAGE(PG8_SA(0, 1), a2 + hstep, voffA);
            PG8_WAIT_L(8); PG8_BAR; PG8_WAIT_L(0); PG8_MMA(0, 0, At, B0); PG8_BAR; PG8_SCHED;
            PG8_LDB(B1, 1, 1); PG8_STAGE(PG8_SB(1, 0), b3, voffB);
            PG8_BAR; PG8_WAIT_L(0); PG8_MMA(0, 1, At, B1); PG8_BAR;
            PG8_LDA(At, 1, 1); PG8_STAGE(PG8_SA(1, 0), a3, voffA);
            PG8_BAR; PG8_WAIT_L(0); PG8_MMA(1, 0, At, B0); PG8_BAR; PG8_SCHED;
            PG8_STAGE(PG8_SB(1, 1), b3 + hstep, voffB);
            PG8_WAIT_V(6); PG8_BAR; PG8_MMA(1, 1, At, B1); PG8_BAR;
            }
        }
        if constexpr (ALIGN_EPI) { if (wr == 0) PG8_BAR; }
        if constexpr (!Epi::AFTER_DRAIN) { E(acc, cur, wr, wc, fr, fq); S.done(cur); }
        if (!has_next) break;
#pragma unroll
        for (int a = 0; a < 2; ++a)
#pragma unroll
            for (int b = 0; b < 2; ++b)
#pragma unroll
                for (int m = 0; m < 4; ++m)
#pragma unroll
                    for (int n = 0; n < 2; ++n) acc[a][b][m][n] = (f32x4){0.f, 0.f, 0.f, 0.f};
        cur = nxt; cA = nA; cB = nB; ++ui;
        if constexpr (ALIGN_EPI) { if (wr == 1) PG8_BAR; }
    }
    PG8_WAIT_V(0);
    if constexpr (!ALIGN_EPI) { if (wr == 0) PG8_BAR; }
    PG8_BAR;
    if constexpr (Epi::AFTER_DRAIN) { E.fused(acc, cur, wr, wc, fr, fq, lds, wid, lane); S.done(cur); }
#undef PG8_SA
#undef PG8_SB
#undef PG8_STAGE
#undef PG8_LDA
#undef PG8_LDB
#undef PG8_MMA
#undef PG8_WAIT_V
#undef PG8_WAIT_L
#undef PG8_BAR
#undef PG8_SCHED
}
}
namespace pg8 {
typedef unsigned u32x2 __attribute__((ext_vector_type(2)));
__device__ __forceinline__ u32x4 pack8(f32x4 a, f32x4 b) { u32x4 w; w.x = cvt_pk_bf16(a[0], a[1]); w.y = cvt_pk_bf16(a[2], a[3]); w.z = cvt_pk_bf16(b[0], b[1]); w.w = cvt_pk_bf16(b[2], b[3]); return w; }
__device__ __forceinline__ float bflo(unsigned w) { return __uint_as_float(w << 16); }
__device__ __forceinline__ float bfhi(unsigned w) { return __uint_as_float(w & 0xffff0000u); }
__device__ __forceinline__ void unpack8(u32x4 w, f32x4& a, f32x4& b) { a = (f32x4){bflo(w.x), bfhi(w.x), bflo(w.y), bfhi(w.y)}; b = (f32x4){bflo(w.z), bfhi(w.z), bflo(w.w), bfhi(w.w)}; }
__device__ __forceinline__ float fast_sigmoid(float z) { return __builtin_amdgcn_rcpf(1.f + __builtin_amdgcn_exp2f(-LOG2E * z)); }
__device__ __forceinline__ f32x4 sig4(f32x4 z) { return (f32x4){fast_sigmoid(z[0]), fast_sigmoid(z[1]), fast_sigmoid(z[2]), fast_sigmoid(z[3])}; }
__device__ __forceinline__ float logsig(float z) { return fminf(z, 0.f) - log1pf(expf(-fabsf(z))); }

struct EpiInProj {
    static constexpr bool PERM = true, AFTER_DRAIN = false, MIDK = false;
    bf16_t *GQ, *GK, *GV, *GR, *FQ, *FK, *FV, *SG, *SF; float *GLR, *LF2; const float *fb, *qg, *kg, *gate_b;
    __device__ __forceinline__ void operator()(const f32x4 (&acc)[2][2][4][2], const Unit& u, int wr, int wc, int fr, int fq) const {
        const int pn = u.pn; const size_t row0 = (size_t)u.pm * BM + wr * 64 + fr; const int qc = 64 * wc + 8 * fq;
        if (pn < 6 || pn == 10 || pn == 11) {
            bf16_t* base; int ld, col0; float sc = 1.f;
            if (pn == 0) { base = GQ; ld = 256; col0 = 0; sc = 0.125f; } else if (pn == 1) { base = GK; ld = 256; col0 = 0; }
            else if (pn < 4) { base = GV; ld = 512; col0 = 256 * (pn - 2); } else if (pn < 6) { base = GR; ld = 512; col0 = 256 * (pn - 4); } else { base = FV; ld = 512; col0 = 256 * (pn - 10); }
#pragma unroll
            for (int ai = 0; ai < 2; ++ai)
#pragma unroll
                for (int m = 0; m < 4; ++m) { bf16_t* rp = base + (row0 + ai * HALF + m * 16) * ld + col0 + qc;
#pragma unroll
                    for (int bj = 0; bj < 2; ++bj) *(u32x4*)(rp + 32 * bj) = pack8(acc[ai][bj][m][0] * sc, acc[ai][bj][m][1] * sc); }
        } else if (pn < 10) {
            const bool isq = pn < 8; bf16_t* base = isq ? FQ : FK; const float* g = isq ? qg : kg; const int head = 4 * ((pn - 6) & 1) + wc; const float osc = isq ? QSCALE2 : 1.f;
            f32x4 gv[2][2];
#pragma unroll
            for (int bj = 0; bj < 2; ++bj)
#pragma unroll
                for (int n = 0; n < 2; ++n) gv[bj][n] = *(const f32x4*)(g + 32 * bj + 8 * fq + 4 * n);
#pragma unroll
            for (int ai = 0; ai < 2; ++ai)
#pragma unroll
                for (int m = 0; m < 4; ++m) { float ss = 0.f;
#pragma unroll
                    for (int bj = 0; bj < 2; ++bj)
#pragma unroll
                        for (int n = 0; n < 2; ++n) { const f32x4 x = acc[ai][bj][m][n]; ss += (x[0] * x[0] + x[1] * x[1]) + (x[2] * x[2] + x[3] * x[3]); }
                    ss += __shfl_xor(ss, 16); ss += __shfl_xor(ss, 32);
                    const float rs = rsqrtf(ss * (1.f / 64.f) + 1e-6f) * osc;
                    bf16_t* rp = base + (row0 + ai * HALF + m * 16) * 512 + 64 * head + 8 * fq;
#pragma unroll
                    for (int bj = 0; bj < 2; ++bj) *(u32x4*)(rp + 32 * bj) = pack8(acc[ai][bj][m][0] * rs * gv[bj][0], acc[ai][bj][m][1] * rs * gv[bj][1]); }
        } else if (pn < 20) {
            const int ch0 = 128 * (pn - 12) + 32 * wc + 8 * fq;
            f32x4 bg[2], bf_[2];
#pragma unroll
            for (int n = 0; n < 2; ++n) { bg[n] = *(const f32x4*)(gate_b + ch0 + 4 * n); bf_[n] = *(const f32x4*)(gate_b + 1024 + ch0 + 4 * n); }
#pragma unroll
            for (int ai = 0; ai < 2; ++ai)
#pragma unroll
                for (int m = 0; m < 4; ++m) { const size_t off = (row0 + ai * HALF + m * 16) * 1024 + ch0; f32x4 r[2], s[2];
#pragma unroll
                    for (int n = 0; n < 2; ++n)
#pragma unroll
                        for (int i = 0; i < 4; ++i) { const float eg = __builtin_amdgcn_exp2f(-LOG2E * (acc[ai][0][m][n][i] + bg[n][i])), ef = __builtin_amdgcn_exp2f(-LOG2E * (acc[ai][1][m][n][i] + bf_[n][i]));
                            s[n][i] = __builtin_amdgcn_rcpf(1.f + ef); r[n][i] = (1.f + ef) * __builtin_amdgcn_rcpf(1.f + eg); }
                    *(u32x4*)(SG + off) = pack8(r[0], r[1]); *(u32x4*)(SF + off) = pack8(s[0], s[1]); }
        } else {
            if (wc == 0 && fq < 3) {
                const f32x4 f0 = *(const f32x4*)fb, f1 = *(const f32x4*)(fb + 4);
#pragma unroll
                for (int ai = 0; ai < 2; ++ai)
#pragma unroll
                    for (int m = 0; m < 4; ++m) { const size_t row = row0 + ai * HALF + m * 16; const f32x4 v0 = acc[ai][0][m][0], v1 = acc[ai][0][m][1];
                        if (fq < 2) { *(f32x4*)(GLR + row * 16 + 8 * fq) = v0; *(f32x4*)(GLR + row * 16 + 8 * fq + 4) = v1; }
                        else { f32x4 o0, o1;
#pragma unroll
                            for (int i = 0; i < 4; ++i) { o0[i] = logsig(v0[i] + f0[i]) * LOG2E; o1[i] = logsig(v1[i] + f1[i]) * LOG2E; }
                            *(f32x4*)(LF2 + row * 8) = o0; *(f32x4*)(LF2 + row * 8 + 4) = o1; } }
            }
        }
    }
};
struct EpiMerge {
    static constexpr bool PERM = true, AFTER_DRAIN = false, MIDK = true;
    const bf16_t *SG, *SF; bf16_t* Y;
    __device__ __forceinline__ void mid(f32x4 (&acc)[2][2][4][2], const Unit& u, int wr, int wc, int fr, int fq) const {
        asm volatile("" : "+v"(fr), "+v"(fq));
        const size_t row0 = (size_t)u.pm * BM + wr * 64 + fr; const int col = u.pn * BM + 64 * wc + 8 * fq;
        u32x4 rg[2][4][2];
#pragma unroll
        for (int ai = 0; ai < 2; ++ai)
#pragma unroll
            for (int m = 0; m < 4; ++m)
#pragma unroll
                for (int bj = 0; bj < 2; ++bj) rg[ai][m][bj] = *(const u32x4*)(SG + (row0 + ai * HALF + m * 16) * 1024 + col + 32 * bj);
#pragma unroll
        for (int ai = 0; ai < 2; ++ai)
#pragma unroll
            for (int m = 0; m < 4; ++m)
#pragma unroll
                for (int bj = 0; bj < 2; ++bj) { f32x4 g0, g1; unpack8(rg[ai][m][bj], g0, g1); acc[ai][bj][m][0] *= g0; acc[ai][bj][m][1] *= g1; }
    }
    __device__ __forceinline__ void operator()(const f32x4 (&acc)[2][2][4][2], const Unit& u, int wr, int wc, int fr, int fq) const {
        const size_t row0 = (size_t)u.pm * BM + wr * 64 + fr; const int col = u.pn * BM + 64 * wc + 8 * fq;
#pragma unroll
        for (int ai = 0; ai < 2; ++ai)
#pragma unroll
            for (int m = 0; m < 4; ++m) { const size_t off = (row0 + ai * HALF + m * 16) * 1024 + col;
#pragma unroll
                for (int bj = 0; bj < 2; ++bj) { f32x4 s0, s1; unpack8(*(const u32x4*)(SF + off + 32 * bj), s0, s1); *(u32x4*)(Y + off + 32 * bj) = pack8(acc[ai][bj][m][0] * s0, acc[ai][bj][m][1] * s1); } }
    }
};
struct EpiOut {
    static constexpr bool PERM = true, AFTER_DRAIN = false, MIDK = false;
    const float* x; bf16_t* x1b; float* ss;
    __device__ __forceinline__ void operator()(const f32x4 (&acc)[2][2][4][2], const Unit& u, int wr, int wc, int fr, int fq) const {
        const size_t row0 = (size_t)u.pm * BM + wr * 64 + fr; const int col = u.pn * BM + 64 * wc + 8 * fq;
#pragma unroll
        for (int ai = 0; ai < 2; ++ai)
#pragma unroll
            for (int m = 0; m < 4; ++m) { const size_t row = row0 + ai * HALF + m * 16, off = row * 1024 + col; float sq = 0.f;
#pragma unroll
                for (int bj = 0; bj < 2; ++bj) { const f32x4 v0 = *(const f32x4*)(x + off + 32 * bj) + acc[ai][bj][m][0], v1 = *(const f32x4*)(x + off + 32 * bj + 4) + acc[ai][bj][m][1];
                    sq += (v0[0] * v0[0] + v0[1] * v0[1]) + (v0[2] * v0[2] + v0[3] * v0[3]) + (v1[0] * v1[0] + v1[1] * v1[1]) + (v1[2] * v1[2] + v1[3] * v1[3]);
                    *(u32x4*)(x1b + off + 32 * bj) = pack8(v0, v1); }
                sq += __shfl_xor(sq, 16); sq += __shfl_xor(sq, 32);
                if (fq == 0) atomicAdd(ss + row, sq); }
    }
};
struct EpiDown {
    static constexpr bool PERM = true, AFTER_DRAIN = false, MIDK = false;
    const bf16_t* x1b; bf16_t* x2b; float* ss;
    __device__ __forceinline__ void operator()(const f32x4 (&acc)[2][2][4][2], const Unit& u, int wr, int wc, int fr, int fq) const {
        const size_t row0 = (size_t)u.pm * BM + wr * 64 + fr; const int col = u.pn * BM + 64 * wc + 8 * fq;
#pragma unroll
        for (int ai = 0; ai < 2; ++ai)
#pragma unroll
            for (int m = 0; m < 4; ++m) { const size_t row = row0 + ai * HALF + m * 16, off = row * 1024 + col; float sq = 0.f;
#pragma unroll
                for (int bj = 0; bj < 2; ++bj) { f32x4 b0, b1; unpack8(*(const u32x4*)(x1b + off + 32 * bj), b0, b1); const f32x4 v0 = b0 + acc[ai][bj][m][0], v1 = b1 + acc[ai][bj][m][1];
                    sq += (v0[0] * v0[0] + v0[1] * v0[1]) + (v0[2] * v0[2] + v0[3] * v0[3]) + (v1[0] * v1[0] + v1[1] * v1[1]) + (v1[2] * v1[2] + v1[3] * v1[3]);
                    *(u32x4*)(x2b + off + 32 * bj) = pack8(v0, v1); }
                sq += __shfl_xor(sq, 16); sq += __shfl_xor(sq, 32);
                if (fq == 0) atomicAdd(ss + row, sq); }
    }
};
template <int CTRL> __device__ __forceinline__ float dppz(float v) { return __builtin_bit_cast(float, __builtin_amdgcn_update_dpp(0, __builtin_bit_cast(int, v), CTRL, 0xf, 0xf, true)); }
__device__ __forceinline__ float gelu_tanh_fast(float x) { const float u = x * (1.f + 0.044715f * x * x); return x * __builtin_amdgcn_rcpf(1.f + __builtin_amdgcn_exp2f(-1.5957691216057308f * LOG2E * u)); }
struct EpiUp {
    static constexpr bool PERM = true, AFTER_DRAIN = false, MIDK = false;
    bf16_t* HM; float* EDGE; const float *cw, *cb, *ss;
    __device__ __forceinline__ void operator()(const f32x4 (&acc)[2][2][4][2], const Unit& u, int wr, int wc, int fr, int fq) const {
        const int ch0 = 128 * u.pn + 32 * wc + 8 * fq;
        f32x4 w0[2], w1[2], w2[2], bb[2];
#pragma unroll
        for (int n = 0; n < 2; ++n) { w0[n] = *(const f32x4*)(cw + ch0 + 4 * n); w1[n] = *(const f32x4*)(cw + 2816 + ch0 + 4 * n); w2[n] = *(const f32x4*)(cw + 5632 + ch0 + 4 * n); bb[n] = *(const f32x4*)(cb + ch0 + 4 * n); }
#pragma unroll
        for (int ai = 0; ai < 2; ++ai) {
            const size_t rowg = (size_t)u.pm * BM + ai * HALF + wr * 64;
            f32x4 ar[4][2], vr[4][2];
#pragma unroll
            for (int m = 0; m < 4; ++m) { const float rs = rsqrtf(ss[rowg + m * 16 + fr] * (1.f / 1024.f) + 1e-6f);
#pragma unroll
                for (int n = 0; n < 2; ++n) { ar[m][n] = acc[ai][0][m][n] * rs; vr[m][n] = acc[ai][1][m][n] * rs; } }
            float* eg = EDGE + (rowg >> 6) * (size_t)(6 * 2816) + ch0;
            if (fr < 2) {
#pragma unroll
                for (int n = 0; n < 2; ++n) { *(f32x4*)(eg + fr * 2816 + 4 * n) = ar[0][n]; *(f32x4*)(eg + (4 + fr) * 2816 + 4 * n) = vr[0][n]; } }
            if (fr >= 14) {
#pragma unroll
                for (int n = 0; n < 2; ++n) *(f32x4*)(eg + (fr - 12) * 2816 + 4 * n) = ar[3][n]; }
#pragma unroll
            for (int m = 0; m < 4; ++m) { f32x4 h[2];
#pragma unroll
                for (int n = 0; n < 2; ++n)
#pragma unroll
                    for (int i = 0; i < 4; ++i) { const float a0 = ar[m][n][i];
                        float a1 = dppz<0x111>(a0), a2 = dppz<0x112>(a0);
                        if (m > 0) { const float p = ar[m - 1][n][i]; a1 += dppz<0x10F>(p); a2 += dppz<0x10E>(p); }
                        const float cv = bb[n][i] + w0[n][i] * a2 + w1[n][i] * a1 + w2[n][i] * a0;
                        h[n][i] = gelu_tanh_fast(cv) * vr[m][n][i]; }
                *(u32x4*)(HM + (rowg + m * 16 + fr) * 2816 + ch0) = pack8(h[0], h[1]); }
        }
    }
};
}
#define GAS __attribute__((address_space(1)))
#define LAS __attribute__((address_space(3)))
typedef unsigned v4u __attribute__((ext_vector_type(4)));
typedef float f32x4 __attribute__((ext_vector_type(4)));
typedef short bf16x8 __attribute__((ext_vector_type(8)));
typedef GAS unsigned gu32;
typedef GAS unsigned long long gu64;
#define RLX_AGENT __ATOMIC_RELAXED, __HIP_MEMORY_SCOPE_AGENT
#define LDS_WAIT() asm volatile("s_waitcnt lgkmcnt(0)" ::: "memory")
#define VM_WAIT() asm volatile("s_waitcnt vmcnt(0)" ::: "memory")
__device__ __forceinline__ unsigned long long rt() { return __builtin_amdgcn_s_memrealtime(); }
__device__ __forceinline__ unsigned pk2(float lo, float hi) { return (unsigned)f2bf(lo) | ((unsigned)f2bf(hi) << 16); }
#define XB_TMO      128
#define XB_XCNT(j)  (256  + 64 * (j))
#define XB_XSUB(j)  (1280 + 64 * (j))
#define XB_XGEN(j)  (2304 + 64 * (j))
#define XB_TOP      3328
#define XB_TOPGEN   3392
#define XCD_BAR_WORDS 3456
#define XB_SPIN_CAP (1u << 18)

__device__ __forceinline__ unsigned xb_ld(unsigned* p)              { return __hip_atomic_load(p, __ATOMIC_RELAXED, __HIP_MEMORY_SCOPE_AGENT); }
__device__ __forceinline__ unsigned xb_add(unsigned* p, unsigned v) { return __hip_atomic_fetch_add(p, v, __ATOMIC_RELAXED, __HIP_MEMORY_SCOPE_AGENT); }
__device__ __forceinline__ unsigned xb_xcc_id() { return (unsigned)__builtin_amdgcn_s_getreg((3 << 11) | 20) & 0xFu; }
#define XB_SPIN(cond, bar) do { unsigned _sp = 0; while (cond) { __builtin_amdgcn_s_sleep(1); \
    if ((++_sp & 255u) == 0u) { if (xb_ld(&(bar)[XB_TMO])) break; if (_sp > XB_SPIN_CAP) { atomicAdd(&(bar)[XB_TMO], 1u); break; } } } } while (0)

struct XcdBarrier {
    unsigned* bar; unsigned x;
    volatile LAS unsigned* st;
};

__device__ __forceinline__ XcdBarrier xcd_barrier_post(unsigned* bar, volatile LAS unsigned* st) {
    XcdBarrier b; b.bar = bar; b.x = xb_xcc_id(); b.st = st;
    if (threadIdx.x == 0) (void)xb_add(&bar[XB_XCNT(b.x)], 1u);
    return b;
}
__device__ __forceinline__ void xcd_barrier_complete(unsigned* bar, unsigned x, unsigned& nloc, unsigned& nx) {
    const unsigned G = gridDim.x * gridDim.y * gridDim.z;
    unsigned sum, cnt, mine, sp = 0u;
    for (;;) {
        sum = 0u; cnt = 0u; mine = 0u;
#pragma unroll
        for (unsigned j = 0; j < 16; ++j) { const unsigned c = xb_ld(&bar[XB_XCNT(j)]); sum += c; cnt += (c > 0u) ? 1u : 0u; mine = (j == x) ? c : mine; }
        if (sum == G) break;
        __builtin_amdgcn_s_sleep(1);
        if ((++sp & 255u) == 0u) { if (xb_ld(&bar[XB_TMO])) break; if (sp > XB_SPIN_CAP) { atomicAdd(&bar[XB_TMO], 1u); break; } }
    }
    nloc = mine > 0u ? mine : 1u; nx = cnt > 0u ? cnt : 1u;
}

__device__ __forceinline__ void xcd_barrier(const XcdBarrier& b) {
    asm volatile("s_waitcnt vmcnt(0)" ::: "memory");
    __syncthreads();
    if (threadIdx.x == 0) {
        unsigned* bar = b.bar;
        __builtin_amdgcn_s_waitcnt(0);
        unsigned nloc = b.st[0], nx = b.st[1];
        if (nloc == 0u) { xcd_barrier_complete(bar, b.x, nloc, nx); b.st[0] = nloc; b.st[1] = nx; }
        const unsigned old = xb_add(&bar[XB_XSUB(b.x)], 1u);
        const unsigned gen = old / nloc;
        if (old + 1u == (gen + 1u) * nloc) {
            __builtin_amdgcn_fence(__ATOMIC_RELEASE, "agent");
            asm volatile("s_waitcnt vmcnt(0)" ::: "memory");
            const unsigned og = xb_add(&bar[XB_TOP], 1u);
            const unsigned tg = og / nx;
            if (og + 1u == (tg + 1u) * nx) xb_add(&bar[XB_TOPGEN], 1u);
            else XB_SPIN(xb_ld(&bar[XB_TOPGEN]) == tg, bar);
            __builtin_amdgcn_fence(__ATOMIC_ACQUIRE, "agent");
            xb_add(&bar[XB_XGEN(b.x)], 1u);
            asm volatile("s_waitcnt vmcnt(0)" ::: "memory");
        } else {
            XB_SPIN(xb_ld(&bar[XB_XGEN(b.x)]) == gen, bar);
            __builtin_amdgcn_fence(__ATOMIC_ACQUIRE, "agent");
            asm volatile("s_waitcnt vmcnt(0)" ::: "memory");
        }
    }
    __syncthreads();
}
namespace fox {
using bf16x8 = __attribute__((ext_vector_type(8))) short;
using s16x4 = __attribute__((ext_vector_type(4))) short;
using f32x16 = __attribute__((ext_vector_type(16))) float;
using f32x4 = __attribute__((ext_vector_type(4))) float;
using u32x4 = __attribute__((ext_vector_type(4))) unsigned;
constexpr int SEQL = 4096, PQ = 512, PO = 1024, QB = 256, KVBLK = 64, SLOTB = 8192;
constexpr int NSLOT = 4, LDS_K = 0, LDS_V = NSLOT * SLOTB, LDS_WS = 2 * NSLOT * SLOTB, LDS_OST = LDS_WS + 8 * 64 * 4, LDS_CB = LDS_OST + 8 * 4096, LDS_Q = LDS_CB + (4096 + 256) * 4, LDS_TOT = LDS_Q + 64;
static_assert(LDS_TOT <= 131072, "fox LDS");
__device__ __forceinline__ int crow(int r, int hi) { return (r & 3) + 8 * (r >> 2) + 4 * hi; }
#define FSBAR() __builtin_amdgcn_sched_barrier(0)
__device__ __forceinline__ void glds16(const void* gsrc, unsigned lds_dst) { unsigned keep;
    asm volatile("s_mov_b32 %0, m0\n\ts_mov_b32 m0, %2\n\ts_nop 0\n\tglobal_load_lds_dwordx4 %1, off\n\ts_mov_b32 m0, %0" : "=&s"(keep) : "v"(gsrc), "s"(lds_dst) : "memory"); }
__device__ __forceinline__ void glds4(const void* gsrc, unsigned lds_dst) { unsigned keep;
    asm volatile("s_mov_b32 %0, m0\n\ts_mov_b32 m0, %2\n\ts_nop 0\n\tglobal_load_lds_dword %1, off\n\ts_mov_b32 m0, %0" : "=&s"(keep) : "v"(gsrc), "s"(lds_dst) : "memory"); }
typedef float f32x2_t __attribute__((ext_vector_type(2))); typedef __bf16 bf16x2_t __attribute__((ext_vector_type(2)));
__device__ __forceinline__ unsigned cvtpk_s(float lo, float hi) { f32x2_t v = {lo, hi}; bf16x2_t b = __builtin_convertvector(v, bf16x2_t); return __builtin_bit_cast(unsigned, b); }
#define FWAIT_BAR(N) asm volatile("s_waitcnt vmcnt(" #N ") lgkmcnt(0)\n\ts_barrier" ::: "memory")
#define FWAIT_BAR2(N0, N1) do { if (wid == 0) FWAIT_BAR(N0); else FWAIT_BAR(N1); } while (0)
typedef __attribute__((address_space(3))) const char* lds_cptr;
__device__ __forceinline__ void qkt(f32x16& p0, f32x16& p1, lds_cptr Kslot, const bf16x8* qr, const f32x16& c0, const f32x16& c1, int r32, int hi) {
    lds_cptr kb = Kslot + hi * 1024 + r32 * 16;
#pragma unroll
    for (int d0 = 0; d0 < 4; ++d0) {
        const bf16x8 b0 = *(const __attribute__((address_space(3))) bf16x8*)(kb + d0 * 2048);
        const bf16x8 b1 = *(const __attribute__((address_space(3))) bf16x8*)(kb + d0 * 2048 + 512);
        if (d0 == 0) { p0 = __builtin_amdgcn_mfma_f32_32x32x16_bf16(b0, qr[0], c0, 0, 0, 0); p1 = __builtin_amdgcn_mfma_f32_32x32x16_bf16(b1, qr[0], c1, 0, 0, 0); }
        else { p0 = __builtin_amdgcn_mfma_f32_32x32x16_bf16(b0, qr[d0], p0, 0, 0, 0); p1 = __builtin_amdgcn_mfma_f32_32x32x16_bf16(b1, qr[d0], p1, 0, 0, 0); } }
}
typedef short v4i16_t __attribute__((ext_vector_type(4)));
__device__ __forceinline__ s16x4 vtr(lds_cptr p) { return __builtin_bit_cast(s16x4, __builtin_amdgcn_ds_read_tr16_b64_v4i16((__attribute__((address_space(3))) v4i16_t*)p)); }
__device__ __forceinline__ void pv(f32x16* o, lds_cptr vp, bf16x8 pa0, bf16x8 pa1, bf16x8 pa2, bf16x8 pa3) {
#pragma unroll
    for (int d0 = 0; d0 < 2; ++d0) { s16x4 lo[4], hi[4];
#pragma unroll
        for (int ks = 0; ks < 4; ++ks) { lo[ks] = vtr(vp + d0 * 4096 + ks * 1024); hi[ks] = vtr(vp + d0 * 4096 + ks * 1024 + 512); }
#define FPK(k) (bf16x8){lo[k][0], lo[k][1], lo[k][2], lo[k][3], hi[k][0], hi[k][1], hi[k][2], hi[k][3]}
        o[d0] = __builtin_amdgcn_mfma_f32_32x32x16_bf16(pa0, FPK(0), o[d0], 0, 0, 0);
        o[d0] = __builtin_amdgcn_mfma_f32_32x32x16_bf16(pa1, FPK(1), o[d0], 0, 0, 0);
        o[d0] = __builtin_amdgcn_mfma_f32_32x32x16_bf16(pa2, FPK(2), o[d0], 0, 0, 0);
        o[d0] = __builtin_amdgcn_mfma_f32_32x32x16_bf16(pa3, FPK(3), o[d0], 0, 0, 0);
#undef FPK
    }
}
__device__ __forceinline__ void fox_cumsum(const float* LF2, int b, int h, char* shm, float* c2g) {
    float* wtot = (float*)(shm + LDS_WS);
    const int tid = threadIdx.x, lane = tid & 63, wid = tid >> 6;
    const float* p = LF2 + ((size_t)b * SEQL + 8 * tid) * 8 + h;
    float v[8];
#pragma unroll
    for (int j = 0; j < 8; ++j) v[j] = p[8 * j];
#pragma unroll
    for (int j = 1; j < 8; ++j) v[j] += v[j - 1];
    float inc = v[7];
#pragma unroll
    for (int o = 1; o < 64; o <<= 1) { const float u = __shfl_up(inc, o); if (lane >= o) inc += u; }
    if (lane == 63) wtot[wid] = inc;
    __syncthreads();
    float base = inc - v[7];
    for (int w = 0; w < wid; ++w) base += wtot[w];
    *(f32x4*)(c2g + 8 * tid) = (f32x4){base + v[0], base + v[1], base + v[2], base + v[3]};
    *(f32x4*)(c2g + 8 * tid + 4) = (f32x4){base + v[4], base + v[5], base + v[6], base + v[7]};
    __syncthreads();
}
__device__ __forceinline__ void fox_unit(int b, int h, int qb, const bf16_t* Q, const bf16_t* K, const bf16_t* V, bf16_t* O, char* shm, const float* c2g, float b2) {
    int tid = threadIdx.x; asm volatile("" : "+v"(tid));
    const int lane = tid & 63, r32 = lane & 31, hi = lane >> 5; const int wid = __builtin_amdgcn_readfirstlane(tid >> 6);
    const long rowbase = (long)b * SEQL; const int q0 = qb * QB;
    const bf16_t* Qw = Q + (rowbase + q0 + wid * 32) * PQ + h * 64;
    const bf16_t* Kh = K + rowbase * PQ + h * 64; const bf16_t* Vh = V + rowbase * PQ + h * 64;
    const unsigned lds0 = (unsigned)(uintptr_t)shm;
    float* wsf = (float*)(shm + LDS_WS) + wid * 64;
    const bf16_t* ksrc = Kh + (long)lane * PQ + wid * 8;
    const bf16_t* vsrc = Vh + (long)(16 * (wid & 3) + (lane >> 2)) * PQ + (wid >> 2) * 32 + (lane & 3) * 8;
    const unsigned kdst = lds0 + LDS_K + wid * 1024, vdst = lds0 + LDS_V + wid * 1024;
#define DMA_K(t, slot) glds16(ksrc + (long)(t) * KVBLK * PQ, (unsigned)__builtin_amdgcn_readfirstlane(kdst + (slot)))
#define DMA_V(t, slot) glds16(vsrc + (long)(t) * KVBLK * PQ, (unsigned)__builtin_amdgcn_readfirstlane(vdst + (slot)))
    const lds_cptr shm3 = (lds_cptr)shm;
    const lds_cptr vp0 = shm3 + LDS_V + ((lane >> 4) & 1) * 32 + (lane & 3) * 8 + (4 * hi + ((lane & 15) >> 2)) * 64;
    const int NT = (q0 + QB) / KVBLK;
    int t0;
    { const float cq0 = c2g[q0]; const float cl = c2g[64 * (lane < NT ? lane : NT - 1) + 63];
      const bool keep = (lane >= NT - 4) || (b2 + cq0 - cl >= -72.f);
      const unsigned long long mk = __ballot(keep);
      t0 = (__ffsll((long long)mk) - 1) & ~1; if (t0 > NT - 4) t0 = NT - 4; t0 = __builtin_amdgcn_readfirstlane(t0); }
#define DMA_T(t) do { const int s_ = ((t) & 3); DMA_K(t, s_ * SLOTB); DMA_V(t, s_ * SLOTB); } while (0)
    bf16x8 qr[4];
#pragma unroll
    for (int d0 = 0; d0 < 4; ++d0) qr[d0] = *reinterpret_cast<const bf16x8*>(&Qw[(long)r32 * PQ + d0 * 16 + hi * 8]);
    const int qrel = wid * 32 + r32;
    const float ct = c2g[q0 + qrel];
    if (wid <= qb) glds16(c2g + 256 * wid + 4 * lane, (unsigned)__builtin_amdgcn_readfirstlane(lds0 + LDS_CB + wid * 1024));
    if (wid + 8 <= qb) glds16(c2g + 256 * (wid + 8) + 4 * lane, (unsigned)__builtin_amdgcn_readfirstlane(lds0 + LDS_CB + (wid + 8) * 1024));
    DMA_T(t0); DMA_T(t0 + 1); DMA_T(t0 + 2);
    float l_reg = 0.f; f32x16 o[2]; o[0] = f32x16{}; o[1] = f32x16{};
    f32x16 pA0, pA1, pB0, pB1; u32x4 pw0, pw1, pw2, pw3; bf16x8 kf[8]; s16x4 vlo[8], vhi[8]; f32x4 bz, bz2;
    typedef const __attribute__((address_space(3))) float* lds_fptr; typedef const __attribute__((address_space(3))) f32x4* lds_f4ptr;
    const lds_fptr cb0 = (lds_fptr)(shm3 + LDS_CB) + 4 * hi;
#define CIN(C0, C1, t) do { lds_fptr cp_ = cb0 + 64 * (t); \
        _Pragma("unroll") for (int g = 0; g < 4; ++g) { const f32x4 a_ = *(lds_f4ptr)(cp_ + 8 * g), b_ = *(lds_f4ptr)(cp_ + 32 + 8 * g); \
            _Pragma("unroll") for (int i = 0; i < 4; ++i) { C0[4 * g + i] = ct - a_[i]; C1[4 * g + i] = ct - b_[i]; } } } while (0)
#define KRD2(t, j) do { lds_cptr kb_ = shm3 + LDS_K + ((t) & 3) * SLOTB + hi * 1024 + r32 * 16; \
        kf[2 * (j)] = *(const __attribute__((address_space(3))) bf16x8*)(kb_ + (j) * 2048); kf[2 * (j) + 1] = *(const __attribute__((address_space(3))) bf16x8*)(kb_ + (j) * 2048 + 512); } while (0)
#define MASKT(P0, P1, t) do { const int jb_ = (t) - (NT - 4); if (jb_ >= 0) { asm volatile("; band tile" ::: "memory"); const int kb_ = 64 * jb_ + 4 * hi; \
        _Pragma("unroll") for (int r = 0; r < 16; ++r) { const int kv_ = kb_ + (r & 3) + 8 * (r >> 2); if (kv_ > qrel) P0[r] = -INFINITY; if (kv_ + 32 > qrel) P1[r] = -INFINITY; } } } while (0)
#define EX(v) __builtin_amdgcn_exp2f(v)
#define PIN(x) asm volatile("" : "+v"(x))
#define VRD(vp_, i) do { vlo[i] = vtr(vp_ + (((i) >> 2) * 4096 + ((i) & 3) * 1024)); vhi[i] = vtr(vp_ + (((i) >> 2) * 4096 + ((i) & 3) * 1024 + 512)); } while (0)
#define VFR(i) (bf16x8){vlo[i][0], vlo[i][1], vlo[i][2], vlo[i][3], vhi[i][0], vhi[i][1], vhi[i][2], vhi[i][3]}
#define PAF(k) __builtin_bit_cast(bf16x8, pw##k)
#define GAPA(MF, XP, B, PW, W, VI) do { MF; sacc_ += XP[B]; sacc_ += XP[(B) + 1]; sacc_ += XP[(B) + 2]; sacc_ += XP[(B) + 3]; PW[W] = cvtpk_s(XP[B], XP[(B) + 1]); PW[(W) + 1] = cvtpk_s(XP[(B) + 2], XP[(B) + 3]); PIN(sacc_); PIN(PW); VRD(vp_, VI); FSBAR(); } while (0)
#define GAPB(MF, YP, XP, B, NB, BZ) do { MF; YP[B] = EX(YP[B]); YP[(B) + 1] = EX(YP[(B) + 1]); YP[(B) + 2] = EX(YP[(B) + 2]); YP[(B) + 3] = EX(YP[(B) + 3]); \
        XP[B] = ct - BZ[0]; XP[(B) + 1] = ct - BZ[1]; XP[(B) + 2] = ct - BZ[2]; XP[(B) + 3] = ct - BZ[3]; BZ = *(lds_f4ptr)(cbn_ + (NB)); PIN(YP); PIN(XP); FSBAR(); } while (0)
#define STEP(X0, X1, Y0, Y1, t) do { \
        FWAIT_BAR(0); \
        if ((t) + 3 < NT) DMA_T((t) + 3); \
        FSBAR(); \
        { const lds_cptr vp_ = vp0 + ((t) & 3) * SLOTB; float sacc_ = 0.f; \
          GAPA(Y0 = __builtin_amdgcn_mfma_f32_32x32x16_bf16(kf[0], qr[0], Y0, 0, 0, 0), X0, 0, pw0, 0, 0); \
          GAPA(Y1 = __builtin_amdgcn_mfma_f32_32x32x16_bf16(kf[1], qr[0], Y1, 0, 0, 0), X0, 4, pw0, 2, 4); \
          GAPA(Y0 = __builtin_amdgcn_mfma_f32_32x32x16_bf16(kf[2], qr[1], Y0, 0, 0, 0), X0, 8, pw1, 0, 1); \
          GAPA(Y1 = __builtin_amdgcn_mfma_f32_32x32x16_bf16(kf[3], qr[1], Y1, 0, 0, 0), X0, 12, pw1, 2, 5); \
          GAPA(Y0 = __builtin_amdgcn_mfma_f32_32x32x16_bf16(kf[4], qr[2], Y0, 0, 0, 0), X1, 0, pw2, 0, 2); \
          GAPA(Y1 = __builtin_amdgcn_mfma_f32_32x32x16_bf16(kf[5], qr[2], Y1, 0, 0, 0), X1, 4, pw2, 2, 6); \
          GAPA(Y0 = __builtin_amdgcn_mfma_f32_32x32x16_bf16(kf[6], qr[3], Y0, 0, 0, 0), X1, 8, pw3, 0, 3); \
          GAPA(Y1 = __builtin_amdgcn_mfma_f32_32x32x16_bf16(kf[7], qr[3], Y1, 0, 0, 0), X1, 12, pw3, 2, 7); \
          l_reg += sacc_; bz = *(lds_f4ptr)(cb0 + 64 * ((t) + 2)); bz2 = *(lds_f4ptr)(cb0 + 64 * ((t) + 2) + 8); } \
        MASKT(Y0, Y1, (t) + 1); \
        FSBAR(); \
        { const lds_fptr cbn_ = cb0 + 64 * ((t) + 2); \
          GAPB(o[0] = __builtin_amdgcn_mfma_f32_32x32x16_bf16(PAF(0), VFR(0), o[0], 0, 0, 0), Y0, X0, 0, 16, bz); \
          GAPB(o[1] = __builtin_amdgcn_mfma_f32_32x32x16_bf16(PAF(0), VFR(4), o[1], 0, 0, 0), Y0, X0, 4, 24, bz2); \
          KRD2((t) + 2, 0); GAPB(o[0] = __builtin_amdgcn_mfma_f32_32x32x16_bf16(PAF(1), VFR(1), o[0], 0, 0, 0), Y0, X0, 8, 32, bz); \
          KRD2((t) + 2, 1); GAPB(o[1] = __builtin_amdgcn_mfma_f32_32x32x16_bf16(PAF(1), VFR(5), o[1], 0, 0, 0), Y0, X0, 12, 40, bz2); \
          KRD2((t) + 2, 2); GAPB(o[0] = __builtin_amdgcn_mfma_f32_32x32x16_bf16(PAF(2), VFR(2), o[0], 0, 0, 0), Y1, X1, 0, 48, bz); \
          KRD2((t) + 2, 3); GAPB(o[1] = __builtin_amdgcn_mfma_f32_32x32x16_bf16(PAF(2), VFR(6), o[1], 0, 0, 0), Y1, X1, 4, 56, bz2); \
          GAPB(o[0] = __builtin_amdgcn_mfma_f32_32x32x16_bf16(PAF(3), VFR(3), o[0], 0, 0, 0), Y1, X1, 8, 0, bz); \
          GAPB(o[1] = __builtin_amdgcn_mfma_f32_32x32x16_bf16(PAF(3), VFR(7), o[1], 0, 0, 0), Y1, X1, 12, 8, bz2); } \
        } while (0)
    FWAIT_BAR(2);
    CIN(pA0, pA1, t0); CIN(pB0, pB1, t0 + 1);
    { KRD2(t0, 0); KRD2(t0, 1); KRD2(t0, 2); KRD2(t0, 3);
#pragma unroll
      for (int d0 = 0; d0 < 4; ++d0) { pA0 = __builtin_amdgcn_mfma_f32_32x32x16_bf16(kf[2 * d0], qr[d0], pA0, 0, 0, 0); pA1 = __builtin_amdgcn_mfma_f32_32x32x16_bf16(kf[2 * d0 + 1], qr[d0], pA1, 0, 0, 0); }
      MASKT(pA0, pA1, t0);
#pragma unroll
      for (int r = 0; r < 16; ++r) { pA0[r] = EX(pA0[r]); pA1[r] = EX(pA1[r]); }
      KRD2(t0 + 1, 0); KRD2(t0 + 1, 1); KRD2(t0 + 1, 2); KRD2(t0 + 1, 3); }
    for (int t = t0; t + 2 < NT; t += 2) { STEP(pA0, pA1, pB0, pB1, t); STEP(pB0, pB1, pA0, pA1, t + 1); }
    STEP(pA0, pA1, pB0, pB1, NT - 2);
    FWAIT_BAR(0);
    { float sacc_ = 0.f;
#pragma unroll
      for (int r = 0; r < 16; ++r) sacc_ += pB0[r] + pB1[r];
      l_reg += sacc_;
      pw0 = (u32x4){cvtpk_s(pB0[0], pB0[1]), cvtpk_s(pB0[2], pB0[3]), cvtpk_s(pB0[4], pB0[5]), cvtpk_s(pB0[6], pB0[7])};
      pw1 = (u32x4){cvtpk_s(pB0[8], pB0[9]), cvtpk_s(pB0[10], pB0[11]), cvtpk_s(pB0[12], pB0[13]), cvtpk_s(pB0[14], pB0[15])};
      pw2 = (u32x4){cvtpk_s(pB1[0], pB1[1]), cvtpk_s(pB1[2], pB1[3]), cvtpk_s(pB1[4], pB1[5]), cvtpk_s(pB1[6], pB1[7])};
      pw3 = (u32x4){cvtpk_s(pB1[8], pB1[9]), cvtpk_s(pB1[10], pB1[11]), cvtpk_s(pB1[12], pB1[13]), cvtpk_s(pB1[14], pB1[15])};
      pv(o, vp0 + ((NT - 1) & 3) * SLOTB, PAF(0), PAF(1), PAF(2), PAF(3)); }
#undef CIN
#undef KRD2
#undef MASKT
#undef EX
#undef PIN
#undef VRD
#undef VFR
#undef PAF
#undef GAPA
#undef GAPB
#undef STEP
    { auto rr = __builtin_amdgcn_permlane32_swap(__float_as_uint(l_reg), __float_as_uint(l_reg), false, false); l_reg = __uint_as_float(rr[0]) + __uint_as_float(rr[1]); }
    if (hi == 0) wsf[32 + r32] = l_reg; asm volatile("s_waitcnt lgkmcnt(0)" ::: "memory");
    float rli[16];
#pragma unroll
    for (int r = 0; r < 16; ++r) rli[r] = __builtin_amdgcn_rcpf(wsf[32 + crow(r, hi)]);
    bf16_t* Ow = O + (rowbase + q0 + wid * 32) * PO + 512 + h * 64;
    { bf16_t* stg = (bf16_t*)(shm + LDS_OST) + wid * 2048;
#pragma unroll
      for (int r = 0; r < 16; ++r) { const int orow = crow(r, hi);
#pragma unroll
          for (int d0 = 0; d0 < 2; ++d0) stg[orow * 64 + d0 * 32 + r32] = f2bf(o[d0][r] * rli[r]); }
      asm volatile("s_waitcnt lgkmcnt(0)" ::: "memory");
#pragma unroll
      for (int i = 0; i < 4; ++i) { const int row = i * 8 + (lane >> 3), ch = lane & 7; const u32x4 v = *(const u32x4*)(stg + row * 64 + ch * 8); *(u32x4*)(Ow + (long)row * PO + ch * 8) = v; } }
    asm volatile("s_waitcnt lgkmcnt(0)\n\ts_barrier" ::: "memory");
#undef DMA_K
#undef DMA_V
#undef DMA_T
}
__device__ __forceinline__ void fox_phase_queue(char* shm, unsigned* qctr, int xg, const bf16_t* Q, const bf16_t* K, const bf16_t* V, const float* C2S, bf16_t* O, const float* qg, const float* kg) {
    float b2; { float m = fabsf(qg[threadIdx.x & 63] * kg[threadIdx.x & 63]);
#pragma unroll
        for (int o = 1; o < 64; o <<= 1) m = fmaxf(m, __shfl_xor(m, o));
        b2 = 8.f * LOG2E * 1.02f * m; }
    volatile __attribute__((address_space(3))) unsigned* uq = (volatile __attribute__((address_space(3))) unsigned*)((__attribute__((address_space(3))) char*)shm + LDS_Q);
    int qi = 0;
    for (;;) {
        if (threadIdx.x == 0) { unsigned u = 256u; int q = qi;
            for (; q < 8; ++q) { u = atomicAdd(qctr + 64 * ((xg + q) & 7), 1u); if (u < 256u) break; }
            uq[0] = u; uq[1] = (unsigned)q; }
        __syncthreads();
        const unsigned u = uq[0]; qi = (int)uq[1];
        __syncthreads();
        if (u >= 256u) break;
        const int bh = 16 * ((xg + qi) & 7) + (int)(u >> 4), qb = 15 - (int)(u & 15u);
        fox_unit(bh >> 3, bh & 7, qb, Q, K, V, O, shm, C2S + (size_t)bh * SEQL, b2);
    }
}
#undef FSBAR
#undef FWAIT_BAR
}
namespace gla {
using bf16x8 = __attribute__((ext_vector_type(8))) short;
using s16x4 = __attribute__((ext_vector_type(4))) short;
using f32x4 = __attribute__((ext_vector_type(4))) float;
using u32x4 = __attribute__((ext_vector_type(4))) unsigned;
using u32x2 = __attribute__((ext_vector_type(2))) unsigned;
typedef short v4i16_t __attribute__((ext_vector_type(4)));
#define GLAS __attribute__((address_space(3)))
constexpr int G_GLR = 0, G_SEG = 4096, G_DEC = 6144, G_QE = 6400, G_KE = 15616, G_KDT = 24832, G_SC = 34048, G_V = 43264, G_O = 61696, G_END = 95488;
constexpr int RS = 144, VS = 288, OS = 528;
static_assert(G_END <= 131072, "gla LDS");
typedef float f32x2_t __attribute__((ext_vector_type(2))); typedef __bf16 bf16x2_t __attribute__((ext_vector_type(2)));
__device__ __forceinline__ unsigned pk(float lo, float hi) { f32x2_t v = {lo, hi}; bf16x2_t b = __builtin_convertvector(v, bf16x2_t); return __builtin_bit_cast(unsigned, b); }
__device__ __forceinline__ bf16_t cv1(float x) { return (bf16_t)(pk(x, 0.f) & 0xffffu); }
__device__ __forceinline__ float ex2(float x) { return __builtin_amdgcn_exp2f(x); }
__device__ __forceinline__ float logsig2(float z) { return fminf(z, 0.f) * LOG2E - __builtin_amdgcn_logf(1.f + ex2(-fabsf(z) * LOG2E)); }
__device__ __forceinline__ s16x4 vtr(const GLAS char* p) { return __builtin_bit_cast(s16x4, __builtin_amdgcn_ds_read_tr16_b64_v4i16((GLAS v4i16_t*)p)); }

__device__ __forceinline__ void gla_unit(int b, int h, const bf16_t* GQ, const bf16_t* GK, const bf16_t* GV, const bf16_t* GR, const float* GLR, const float* w2, const float* ba, const float* gn, bf16_t* OGF, GLAS char* sm) {
    const int tid = threadIdx.x, lane = tid & 63, g = lane >> 4, c = lane & 15; const int wid = __builtin_amdgcn_readfirstlane(tid >> 6);
    const int d = lane, seg = wid;
    float w2c[16];
#pragma unroll
    for (int r = 0; r < 16; ++r) w2c[r] = w2[r * 256 + h * 64 + d];
    const float bac = ba[h * 64 + d];
    f32x4 S[4];
#pragma unroll
    for (int mb = 0; mb < 4; ++mb) S[mb] = (f32x4){0.f, 0.f, 0.f, 0.f};
    const int el = tid >> 3, ej = tid & 7;
    f32x4 pf_glr = {0.f, 0.f, 0.f, 0.f}; u32x4 pf_v[2], pf_gr[2]; unsigned short pf_q[8], pf_k[8];
#define GLA_PREFETCH(CH) do { const size_t mm_ = (size_t)b * 4096 + 64 * (CH); \
        if (tid < 256) pf_glr = *(const f32x4*)(GLR + (mm_ + (tid >> 2)) * 16 + 4 * (tid & 3)); \
        _Pragma("unroll") for (int i = 0; i < 2; ++i) { const int p = tid + 512 * i, row = p >> 4, ch = p & 15; pf_v[i] = *(const u32x4*)(GV + (mm_ + row) * 512 + h * 128 + 8 * ch); } \
        _Pragma("unroll") for (int i = 0; i < 8; ++i) { pf_q[i] = GQ[(mm_ + 8 * seg + i) * 256 + h * 64 + d]; pf_k[i] = GK[(mm_ + 8 * seg + i) * 256 + h * 64 + d]; } \
        { const bf16_t* grp = GR + (mm_ + el) * 512 + h * 128 + 16 * ej; pf_gr[0] = *(const u32x4*)grp; pf_gr[1] = *(const u32x4*)(grp + 8); } } while (0)
    GLA_PREFETCH(0);
    f32x4 gnv[4];
#pragma unroll
    for (int j = 0; j < 4; ++j) gnv[j] = *(const f32x4*)(gn + h * 128 + 16 * ej + 4 * j);
    for (int chunk = 0; chunk < 64; ++chunk) {
        const size_t m0 = (size_t)b * 4096 + 64 * chunk;
        if (tid < 256) *(GLAS f32x4*)(sm + G_GLR + tid * 16) = pf_glr;
#pragma unroll
        for (int i = 0; i < 2; ++i) { const int p = tid + 512 * i, row = p >> 4, ch = p & 15; *(GLAS u32x4*)(sm + G_V + row * VS + ch * 16) = pf_v[i]; }
        float qv[8], kv[8];
#pragma unroll
        for (int i = 0; i < 8; ++i) { qv[i] = bf2f(pf_q[i]); kv[i] = bf2f(pf_k[i]); }
        const u32x4 g0 = pf_gr[0], g1 = pf_gr[1];
        if (chunk + 1 < 64) GLA_PREFETCH(chunk + 1);
        __syncthreads();
        float la[8];
#pragma unroll
        for (int i = 0; i < 8; ++i) { float z = bac; const GLAS f32x4* gp = (const GLAS f32x4*)(sm + G_GLR + (8 * seg + i) * 64);
#pragma unroll
            for (int r4 = 0; r4 < 4; ++r4) { const f32x4 t = gp[r4]; z += t[0] * w2c[4 * r4] + t[1] * w2c[4 * r4 + 1] + t[2] * w2c[4 * r4 + 2] + t[3] * w2c[4 * r4 + 3]; }
            la[i] = logsig2(z) * (1.f / 16.f); }
#pragma unroll
        for (int i = 1; i < 8; ++i) la[i] += la[i - 1];
        *(GLAS float*)(sm + G_SEG + (seg * 64 + d) * 4) = la[7];
        __syncthreads();
        float pre = 0.f, tot = 0.f;
#pragma unroll
        for (int s = 0; s < 8; ++s) { const float v = *(const GLAS float*)(sm + G_SEG + (s * 64 + d) * 4); tot += v; pre += (s < seg) ? v : 0.f; }
        { float kd[8];
#pragma unroll
          for (int i = 0; i < 8; ++i) { const float bb = la[i] + pre; const int l = 8 * seg + i;
              *(GLAS bf16_t*)(sm + G_QE + l * RS + d * 2) = cv1(qv[i] * ex2(bb)); *(GLAS bf16_t*)(sm + G_KE + l * RS + d * 2) = cv1(kv[i] * ex2(-bb)); kd[i] = kv[i] * ex2(tot - bb); }
          *(GLAS u32x4*)(sm + G_KDT + d * RS + seg * 16) = (u32x4){pk(kd[0], kd[1]), pk(kd[2], kd[3]), pk(kd[4], kd[5]), pk(kd[6], kd[7])};
          if (seg == 0) *(GLAS float*)(sm + G_DEC + d * 4) = ex2(tot); }
        __syncthreads();
        { const int lb = wid >> 1;
#pragma unroll
          for (int mm = 0; mm < 2; ++mm) { const int mbk = 2 * (wid & 1) + mm; f32x4 acc = {0.f, 0.f, 0.f, 0.f};
#pragma unroll
              for (int ks = 0; ks < 2; ++ks) { const bf16x8 a = *(const GLAS bf16x8*)(sm + G_KE + (16 * mbk + c) * RS + (32 * ks + 8 * g) * 2), bq = *(const GLAS bf16x8*)(sm + G_QE + (16 * lb + c) * RS + (32 * ks + 8 * g) * 2);
                  acc = __builtin_amdgcn_mfma_f32_16x16x32_bf16(a, bq, acc, 0, 0, 0); }
              const int l = 16 * lb + c, mq = 16 * mbk + 4 * g;
#pragma unroll
              for (int r = 0; r < 4; ++r) acc[r] = (l >= mq + r) ? acc[r] : 0.f;
              *(GLAS u32x2*)(sm + G_SC + l * RS + mq * 2) = (u32x2){pk(acc[0], acc[1]), pk(acc[2], acc[3])}; } }
        __syncthreads();
        bf16x8 vf[2], sf[2];
        { const int q = c >> 2, p = c & 3;
#pragma unroll
          for (int ks = 0; ks < 2; ++ks) { const GLAS char* ap = sm + G_V + (32 * ks + 8 * g + q) * VS + (16 * wid + 4 * p) * 2; const s16x4 r1 = vtr(ap), r2 = vtr(ap + 4 * VS);
              vf[ks] = (bf16x8){r1[0], r1[1], r1[2], r1[3], r2[0], r2[1], r2[2], r2[3]}; } }
#pragma unroll
        for (int s = 0; s < 2; ++s) { const u32x4 w = {pk(S[2 * s][0], S[2 * s][1]), pk(S[2 * s][2], S[2 * s][3]), pk(S[2 * s + 1][0], S[2 * s + 1][1]), pk(S[2 * s + 1][2], S[2 * s + 1][3])}; sf[s] = __builtin_bit_cast(bf16x8, w); }
        f32x4 oacc[4];
#pragma unroll
        for (int lb = 0; lb < 4; ++lb) { f32x4 acc = {0.f, 0.f, 0.f, 0.f};
#pragma unroll
            for (int ks = 0; ks < 2; ++ks) { const bf16x8 a = *(const GLAS bf16x8*)(sm + G_SC + (16 * lb + c) * RS + (32 * ks + 8 * g) * 2); acc = __builtin_amdgcn_mfma_f32_16x16x32_bf16(a, vf[ks], acc, 0, 0, 0); }
#pragma unroll
            for (int s = 0; s < 2; ++s) { const GLAS char* ap = sm + G_QE + (16 * lb + c) * RS + (32 * s + 4 * g) * 2; const s16x4 lo = *(const GLAS s16x4*)ap, hi = *(const GLAS s16x4*)(ap + 32);
                const bf16x8 a = {lo[0], lo[1], lo[2], lo[3], hi[0], hi[1], hi[2], hi[3]}; acc = __builtin_amdgcn_mfma_f32_16x16x32_bf16(a, sf[s], acc, 0, 0, 0); }
            oacc[lb] = acc; }
#pragma unroll
        for (int mb = 0; mb < 4; ++mb) { const f32x4 dec = *(const GLAS f32x4*)(sm + G_DEC + (16 * mb + 4 * g) * 4); f32x4 acc = S[mb] * dec;
#pragma unroll
            for (int ks = 0; ks < 2; ++ks) { const bf16x8 a = *(const GLAS bf16x8*)(sm + G_KDT + (16 * mb + c) * RS + (32 * ks + 8 * g) * 2); acc = __builtin_amdgcn_mfma_f32_16x16x32_bf16(a, vf[ks], acc, 0, 0, 0); }
            S[mb] = acc; }
#pragma unroll
        for (int lb = 0; lb < 4; ++lb)
#pragma unroll
            for (int r = 0; r < 4; ++r) *(GLAS float*)(sm + G_O + (16 * lb + 4 * g + r) * OS + (16 * wid + c) * 4) = oacc[lb][r];
        __syncthreads();
        { f32x4 o4[4]; float ss = 0.f;
#pragma unroll
          for (int j = 0; j < 4; ++j) { o4[j] = *(const GLAS f32x4*)(sm + G_O + el * OS + ej * 64 + j * 16); ss += (o4[j][0] * o4[j][0] + o4[j][1] * o4[j][1]) + (o4[j][2] * o4[j][2] + o4[j][3] * o4[j][3]); }
          ss += __shfl_xor(ss, 1); ss += __shfl_xor(ss, 2); ss += __shfl_xor(ss, 4);
          const float rs = rsqrtf(ss * (1.f / 128.f) + 1e-6f);
          const unsigned gw[8] = {g0.x, g0.y, g0.z, g0.w, g1.x, g1.y, g1.z, g1.w};
          unsigned ow[8];
#pragma unroll
          for (int j = 0; j < 4; ++j) { const f32x4 gv = gnv[j]; float r[4];
#pragma unroll
              for (int i = 0; i < 4; ++i) { const unsigned w = gw[2 * j + (i >> 1)]; const float gr = (i & 1) ? __uint_as_float(w & 0xffff0000u) : __uint_as_float(w << 16);
                  r[i] = o4[j][i] * rs * gv[i] * gr * __builtin_amdgcn_rcpf(1.f + ex2(-LOG2E * gr)); }
              ow[2 * j] = pk(r[0], r[1]); ow[2 * j + 1] = pk(r[2], r[3]); }
          bf16_t* op = OGF + (m0 + el) * 1024 + h * 128 + 16 * ej;
          *(u32x4*)op = (u32x4){ow[0], ow[1], ow[2], ow[3]}; *(u32x4*)(op + 8) = (u32x4){ow[4], ow[5], ow[6], ow[7]}; }
    }
}
__device__ __forceinline__ void gla_phase(GLAS char* sm, int vcu, const bf16_t* GQ, const bf16_t* GK, const bf16_t* GV, const bf16_t* GR, const float* GLR, const float* w2, const float* ba, const float* gn, bf16_t* OGF) {
    gla_unit(vcu >> 2, vcu & 3, GQ, GK, GV, GR, GLR, w2, ba, gn, OGF, sm);
}
#undef GLA_PREFETCH
#undef GLAS
}
#define PHASE_GLA do { if (args.pad == 0) { if (F.vcu < 128) fox::fox_cumsum(LF2, F.vcu >> 3, F.vcu & 7, (char*)lds + RING_OFF, C2S + (size_t)F.vcu * 4096); GRID_BAR(); } \
    if ((F.vcu & 3) == 0 && args.pad != 2) gla::gla_phase((__attribute__((address_space(3))) char*)(F.lds + RING_OFF), F.vcu >> 2, GQ, GK, GV, GR, GLR, args.in[3], args.in[4], args.in[5], A); \
    if (args.pad != 1) fox::fox_phase_queue((char*)lds + RING_OFF, (unsigned*)(F.ctl + CW_FOXQ + 512 * args.li), F.vcu >> 5, FQ, FK, FV, C2S, A, args.in[7], args.in[8]); } while (0)
#define PHASE_FOX do {} while (0)
constexpr int NWAVES = 8;
constexpr int RING_OFF = 0, RING_BYTES = 131072, LDSCTL_OFF = RING_BYTES, MISC_OFF = LDSCTL_OFF + 320, LDS_BYTES = 147456;
constexpr size_t CTL_ZERO_BYTES = 1 * MiB;
constexpr int CW_TMO = 0, CW_CODE = 1, CW_FOXQ = 64, CW_BAR = 4096;
constexpr int N_PHASES = 12;
constexpr size_t WS_WIN = WS_W, WS_WGF = WS_WIN + (size_t)5376 * 1024 * 2, WS_WOUT = WS_WGF + 2 * MiB, WS_WUP = WS_WOUT + 2 * MiB, WS_WDN = WS_WUP + (size_t)5632 * 1024 * 2;
static_assert(WS_WDN + (size_t)1024 * 2816 * 2 <= WS_A, "weights fit below WS_A");
constexpr size_t WS_EDGE = WS_C;

struct Frame {
    LAS unsigned char* lds; volatile LAS unsigned* MISC; gu32* ctl;
    int tid, lane, wave, vcu, G;
};
__device__ __forceinline__ float wave_sum(float v) {
#pragma unroll
    for (int o = 1; o < 64; o <<= 1) v += __shfl_xor(v, o);
    return v;
}
__device__ __forceinline__ void p0_xpose(const float* colp, int ldw, bf16_t* dst, int ldd, LAS float* scr, int lane, const float* ksc) {
#pragma unroll 8
    for (int i = 0; i < 32; ++i) { const int kk = 2 * i + (lane >> 5); scr[kk * 33 + (lane & 31)] = colp ? colp[(size_t)kk * ldw] * (ksc ? ksc[kk] : 1.f) : 0.f; }
    LDS_WAIT(); asm volatile("" ::: "memory");
    const int c = lane & 7;
#pragma unroll
    for (int j = 0; j < 4; ++j) { const int n = (lane >> 3) + 8 * j; const LAS float* s = scr + (8 * c) * 33 + n;
        v4u o; o.x = pk2(s[0 * 33], s[1 * 33]); o.y = pk2(s[2 * 33], s[3 * 33]); o.z = pk2(s[4 * 33], s[5 * 33]); o.w = pk2(s[6 * 33], s[7 * 33]);
        *(GAS v4u*)(dst + (size_t)n * ldd + 8 * c) = o; }
    LDS_WAIT(); asm volatile("" ::: "memory");
}
__device__ __forceinline__ int inproj_base(int pn) { return pn < 6 ? 256 * pn : (pn < 12 ? 1552 + 256 * (pn - 6) : 3096 + 256 * (pn - 12)); }
struct Args { const float* in[19]; float* out; unsigned char* ws; int ph_lo, ph_hi, li, pad; };

__device__ __forceinline__ void p0_weights(Frame& F, const Args& a) {
    LAS float* scr = (LAS float*)(F.lds + RING_OFF + F.wave * 16384);
    const int gw = F.vcu * NWAVES + F.wave, NGW = F.G * NWAVES, lane = F.lane, c = lane & 31;
    constexpr int I_IN = 16 * 168, I_GF = 16 * 32, I_OUT = 16 * 32, I_UP = 16 * 176, I_DN = 44 * 32, NITEMS = I_IN + I_GF + I_OUT + I_UP + I_DN;
    unsigned char* ws = a.ws;
    for (int it = gw; it < NITEMS; it += NGW) {
        int r = it; const float* colp; int ldw, ldd; bf16_t* dst; const float* ksc = nullptr;
        if (r < I_IN) { const int kb = r / 168, nb = r % 168, pn = nb >> 3, pb = nb & 7, q0 = 64 * (pb & 3) + 32 * (pb >> 2);
            int col; if (pn < 12) col = inproj_base(pn) + q0 + c; else if (pn < 20) col = ((pb >> 2) ? 4120 : 3096) + 128 * (pn - 12) + 32 * (pb & 3) + c; else col = (q0 == 0) ? (c < 16 ? 1536 + c : (c < 24 ? 3088 + c - 16 : -1)) : -1;
            ldw = INC; ldd = 1024; colp = col >= 0 ? a.in[2] + (size_t)(64 * kb) * INC + col : nullptr; dst = (bf16_t*)(ws + WS_WIN) + (size_t)(32 * nb) * 1024 + 64 * kb;
        } else if ((r -= I_IN) < I_GF) { const int kb = r / 32, nb = r % 32, pn = nb >> 3, pb = nb & 7, col = 256 * pn + 64 * (pb & 3) + 32 * (pb >> 2) + c;
            ldw = 1024; ldd = 1024; colp = (kb < 8 ? a.in[10] + (size_t)(64 * kb) * 1024 : a.in[11] + (size_t)(64 * (kb - 8)) * 1024) + col; dst = (bf16_t*)(ws + WS_WGF) + (size_t)(32 * nb) * 1024 + 64 * kb;
        } else if ((r -= I_GF) < I_OUT) { const int kb = r / 32, nb = r % 32, pn = nb >> 3, pb = nb & 7, col = 256 * pn + 64 * (pb & 3) + 32 * (pb >> 2) + c;
            ldw = 1024; ldd = 1024; colp = a.in[12] + (size_t)(64 * kb) * 1024 + col; dst = (bf16_t*)(ws + WS_WOUT) + (size_t)(32 * nb) * 1024 + 64 * kb;
        } else if ((r -= I_OUT) < I_UP) { const int kb = r / 176, nb = r % 176, pn = nb >> 3, pb = nb & 7, col = (pb >> 2) * 2816 + 128 * pn + 32 * (pb & 3) + c;
            ldw = 5632; ldd = 1024; ksc = a.in[13] + 64 * kb; colp = a.in[14] + (size_t)(64 * kb) * 5632 + col; dst = (bf16_t*)(ws + WS_WUP) + (size_t)(32 * nb) * 1024 + 64 * kb;
        } else { r -= I_UP; const int kb = r / 32, nb = r % 32, pn = nb >> 3, pb = nb & 7, col = 256 * pn + 64 * (pb & 3) + 32 * (pb >> 2) + c;
            ldw = 1024; ldd = 2816; colp = a.in[17] + (size_t)(64 * kb) * 1024 + col; dst = (bf16_t*)(ws + WS_WDN) + (size_t)(32 * nb) * 2816 + 64 * kb; }
        p0_xpose(colp, ldw, dst, ldd, scr, lane, ksc);
    }
}
__device__ __forceinline__ void rms_rows_bf16(Frame& F, const float* x, const float* g, bf16_t* out, float* ssz) {
    const int gw = F.vcu * NWAVES + F.wave, NGW = F.G * NWAVES;
    f32x4 gv[4];
#pragma unroll
    for (int j = 0; j < 4; ++j) gv[j] = ((const GAS f32x4*)g)[F.lane + 64 * j];
    for (int m = gw; m < M_TOK; m += NGW) {
        const GAS f32x4* xr = (const GAS f32x4*)(x + (size_t)m * 1024) + F.lane;
        f32x4 v[4]; float s = 0.f;
#pragma unroll
        for (int j = 0; j < 4; ++j) { v[j] = xr[64 * j]; s += (v[j].x * v[j].x + v[j].y * v[j].y) + (v[j].z * v[j].z + v[j].w * v[j].w); }
        const float rs = rsqrtf(wave_sum(s) * (1.f / 1024.f) + 1e-6f);
        GAS unsigned long long* o8 = (GAS unsigned long long*)(out + (size_t)m * 1024) + F.lane;
#pragma unroll
        for (int j = 0; j < 4; ++j) { const f32x4 y = v[j] * rs * gv[j]; o8[64 * j] = (unsigned long long)pk2(y.x, y.y) | ((unsigned long long)pk2(y.z, y.w) << 32); }
    }
}
__device__ __forceinline__ void final_rows(Frame& F, const bf16_t* x2b, const float* ss2, const float* g, float* out) {
    const int gw = F.vcu * NWAVES + F.wave, NGW = F.G * NWAVES;
    f32x4 gv[4];
#pragma unroll
    for (int j = 0; j < 4; ++j) gv[j] = ((const GAS f32x4*)g)[4 * F.lane + j];
    for (int m = gw; m < M_TOK; m += NGW) {
        const v4u a = ((const GAS v4u*)(x2b + (size_t)m * 1024))[2 * F.lane], b = ((const GAS v4u*)(x2b + (size_t)m * 1024))[2 * F.lane + 1];
        const float rs = rsqrtf(ss2[m] * (1.f / 1024.f) + 1e-6f);
        f32x4 v0, v1, v2, v3; pg8::unpack8(a, v0, v1); pg8::unpack8(b, v2, v3);
        GAS f32x4* o = (GAS f32x4*)(out + (size_t)m * 1024) + 4 * F.lane;
        o[0] = v0 * rs * gv[0]; o[1] = v1 * rs * gv[1]; o[2] = v2 * rs * gv[2]; o[3] = v3 * rs * gv[3];
    }
}
__device__ __forceinline__ void conv_fixup(Frame& F, const float* EDGE, const float* cw, const float* cb, bf16_t* HM) {
    const int gt = (F.vcu * NWAVES + F.wave) * 64 + F.lane, NT = F.G * NWAVES * 64;
    constexpr int NQ = 2816 / 4, TOTAL = 1024 * 2 * NQ;
    for (int it = gt; it < TOTAL; it += NT) {
        const int q = it % NQ, j = (it / NQ) & 1, g = it / (2 * NQ); const int c = 4 * q;
        const bool prev = ((g * 64) & 4095) != 0;
        const float* eg = EDGE + (size_t)g * (6 * 2816) + c; const float* ep = eg - 6 * 2816;
        const f32x4 z = {0.f, 0.f, 0.f, 0.f};
        const f32x4 a0 = *(const f32x4*)(eg + j * 2816);
        const f32x4 a1 = j ? *(const f32x4*)(eg) : (prev ? *(const f32x4*)(ep + 3 * 2816) : z);
        const f32x4 a2 = j ? (prev ? *(const f32x4*)(ep + 3 * 2816) : z) : (prev ? *(const f32x4*)(ep + 2 * 2816) : z);
        const f32x4 vl = *(const f32x4*)(eg + (4 + j) * 2816);
        const f32x4 w0 = *(const f32x4*)(cw + c), w1 = *(const f32x4*)(cw + 2816 + c), w2 = *(const f32x4*)(cw + 5632 + c), b = *(const f32x4*)(cb + c);
        const f32x4 cv = b + w0 * a2 + w1 * a1 + w2 * a0;
        unsigned long long o = (unsigned long long)pk2(pg8::gelu_tanh_fast(cv.x) * vl.x, pg8::gelu_tanh_fast(cv.y) * vl.y) | ((unsigned long long)pk2(pg8::gelu_tanh_fast(cv.z) * vl.z, pg8::gelu_tanh_fast(cv.w) * vl.w) << 32);
        *(unsigned long long*)(HM + ((size_t)g * 64 + j) * 2816 + c) = o;
    }
}

#ifndef STAGGER_N
#define STAGGER_N 0
#endif
#define STAGGER() do { if (STAGGER_N && (F.vcu & 1)) { for (int i_ = 0; i_ < STAGGER_N; ++i_) __builtin_amdgcn_s_sleep(127); } } while (0)
#ifndef PG_ALIGN
#define PG_ALIGN true
#endif
#ifndef PG_SP2
#define PG_SP2 true
#endif
#ifndef REP0
#define REP0 1
#endif
#ifndef REP1
#define REP1 1
#endif
#ifndef REP2
#define REP2 1
#endif
#ifndef REP3
#define REP3 1
#endif
#ifndef REP4
#define REP4 1
#endif
#ifndef REP5
#define REP5 1
#endif
#ifndef REP6
#define REP6 1
#endif
#ifndef REP7
#define REP7 1
#endif
#ifndef REP8
#define REP8 1
#endif
#ifndef REP9
#define REP9 1
#endif
#ifndef REP10
#define REP10 1
#endif
#ifndef REP11
#define REP11 1
#endif
__global__ void __launch_bounds__(NWAVES * 64, 2) skel_fwd(Args args) {
    extern __shared__ __attribute__((aligned(16))) unsigned char lds[];
    Frame F;
    F.lds = (LAS unsigned char*)lds; F.MISC = (volatile LAS unsigned*)(F.lds + MISC_OFF);
    F.tid = threadIdx.x; F.lane = F.tid & 63; F.wave = __builtin_amdgcn_readfirstlane(F.tid >> 6);
    F.G = gridDim.x; { const int bx = blockIdx.x; F.vcu = (F.G % 8 == 0) ? (bx % 8) * (F.G / 8) + bx / 8 : bx; }
    unsigned char* ws = args.ws;
    F.ctl = (gu32*)(ws + WS_CTL);
    for (int u = F.tid; u < (LDS_BYTES - LDSCTL_OFF) / 4; u += NWAVES * 64) ((LAS unsigned*)(F.lds + LDSCTL_OFF))[u] = 0u;
    __syncthreads();
    XcdBarrier bar = xcd_barrier_post((unsigned*)(F.ctl + CW_BAR) + args.li * XCD_BAR_WORDS, F.MISC + 8);
#define GRID_BAR() xcd_barrier(bar)
    const int lo = args.ph_lo, hi = args.ph_hi;
#define IN(k) (lo <= (k) && (k) < hi)
#define BOTH(k) (IN(k) && IN((k) + 1))
    bf16_t* const A = (bf16_t*)(ws + WS_A);
    bf16_t *GQ = (bf16_t*)(ws + WS_GQ), *GK = (bf16_t*)(ws + WS_GK), *GV = (bf16_t*)(ws + WS_GV), *GR = (bf16_t*)(ws + WS_GR), *FQ = (bf16_t*)(ws + WS_FQ), *FK = (bf16_t*)(ws + WS_FK), *FV = (bf16_t*)(ws + WS_FV);
    bf16_t *SG = (bf16_t*)(ws + WS_SG), *SF = (bf16_t*)(ws + WS_SF), *Y = (bf16_t*)(ws + WS_Y), *HM = (bf16_t*)(ws + WS_HM);
    float *GLR = (float*)(ws + WS_GLR), *LF2 = (float*)(ws + WS_LF2), *EDGE = (float*)(ws + WS_EDGE), *C2S = (float*)(ws + WS_C2S), *SS1 = (float*)(ws + WS_SS), *SS2 = SS1 + M_TOK;
    bf16_t* const X2B = (bf16_t*)(ws + WS_SG);

    if (IN(0)) { p0_weights(F, args); __syncthreads(); }
    if (IN(1)) { for (int rp_ = 0; rp_ < REP1; ++rp_) { rms_rows_bf16(F, args.in[0], args.in[1], A, SS1); if (rp_ + 1 < REP1) GRID_BAR(); } if (BOTH(1)) GRID_BAR(); }
    if (IN(2)) { for (int rp_ = 0; rp_ < REP2; ++rp_) {
        pg8::Gemm g{A, (const bf16_t*)(ws + WS_WIN), M_TOK, 5376, 1024}; pg8::StaticOrder S; S.init(M_TOK, 5376, F.G, (int)blockIdx.x);
        pg8::EpiInProj E{GQ, GK, GV, GR, FQ, FK, FV, SG, SF, GLR, LF2, args.in[6], args.in[7], args.in[8], args.in[9]};
        pg8::gemm_phase<pg8::EpiInProj, pg8::StaticOrder, PG_ALIGN, PG_SP2>(F.lds + RING_OFF, g, S, E);
        if (rp_ + 1 < REP2) GRID_BAR(); } if (BOTH(2)) GRID_BAR();
    }
    if (IN(3)) { for (int rp_ = 0; rp_ < REP3; ++rp_) { PHASE_GLA; if (rp_ + 1 < REP3) GRID_BAR(); } if (BOTH(3)) GRID_BAR(); }
    if (IN(5)) { for (int rp_ = 0; rp_ < REP5; ++rp_) {
        STAGGER();
        pg8::Gemm g{A, (const bf16_t*)(ws + WS_WGF), M_TOK, 1024, 1024}; pg8::StaticOrder S; S.init(M_TOK, 1024, F.G, (int)blockIdx.x);
        pg8::EpiMerge E{SG, SF, Y};
        pg8::gemm_phase<pg8::EpiMerge, pg8::StaticOrder, PG_ALIGN, PG_SP2>(F.lds + RING_OFF, g, S, E);
        if (rp_ + 1 < REP5) GRID_BAR(); } if (BOTH(5)) GRID_BAR();
    }
    if (IN(6)) { for (int rp_ = 0; rp_ < REP6; ++rp_) {
        STAGGER();
        pg8::Gemm g{Y, (const bf16_t*)(ws + WS_WOUT), M_TOK, 1024, 1024}; pg8::StaticOrder S; S.init(M_TOK, 1024, F.G, (int)blockIdx.x);
        pg8::EpiOut E{args.in[0], A, SS1};
        pg8::gemm_phase<pg8::EpiOut, pg8::StaticOrder, PG_ALIGN, PG_SP2>(F.lds + RING_OFF, g, S, E);
        if (rp_ + 1 < REP6) GRID_BAR(); } if (BOTH(6)) GRID_BAR();
    }
    if (IN(8)) { for (int rp_ = 0; rp_ < REP8; ++rp_) {
        pg8::Gemm g{A, (const bf16_t*)(ws + WS_WUP), M_TOK, 5632, 1024}; pg8::StaticOrder S; S.init(M_TOK, 5632, F.G, (int)blockIdx.x);
        pg8::EpiUp E{HM, EDGE, args.in[15], args.in[16], SS1};
        pg8::gemm_phase<pg8::EpiUp, pg8::StaticOrder, PG_ALIGN, PG_SP2>(F.lds + RING_OFF, g, S, E);
        if (rp_ + 1 < REP8) GRID_BAR(); } if (BOTH(8)) GRID_BAR();
    }
    if (IN(9)) { for (int rp_ = 0; rp_ < REP9; ++rp_) { conv_fixup(F, EDGE, args.in[15], args.in[16], HM); if (rp_ + 1 < REP9) GRID_BAR(); } if (BOTH(9)) GRID_BAR(); }
    if (IN(10)) { for (int rp_ = 0; rp_ < REP10; ++rp_) {
        STAGGER();
        pg8::Gemm g{HM, (const bf16_t*)(ws + WS_WDN), M_TOK, 1024, 2816}; pg8::StaticOrder S; S.init(M_TOK, 1024, F.G, (int)blockIdx.x);
        pg8::EpiDown E{A, X2B, SS2};
        pg8::gemm_phase<pg8::EpiDown, pg8::StaticOrder, PG_ALIGN, PG_SP2>(F.lds + RING_OFF, g, S, E);
        if (rp_ + 1 < REP10) GRID_BAR(); } if (BOTH(10)) GRID_BAR();
    }
    if (IN(11)) { for (int rp_ = 0; rp_ < REP11; ++rp_) { final_rows(F, X2B, SS2, args.in[18], args.out); } }
#undef IN
#undef BOTH
}
static const int ST_PH_LO[10] = {1, 2, 3, 4, 5, 6, 7, 8, 10, 11}, ST_PH_HI[10] = {2, 3, 4, 5, 6, 7, 8, 10, 11, 12};
#ifndef OPT_MASK
#define OPT_MASK 0x3F3
#endif
extern "C" void kernel_launch(void* const* d_in, const int* in_sizes, int n_in, void* d_out, int out_size, void* d_ws, size_t ws_size, hipStream_t stream) {
    static int grid = 0;
    if (grid == 0) {
        if (n_in != 19 || out_size != M_TOK * DM || ws_size < WS_END) { fprintf(stderr, "kernel_launch: unexpected shapes (n_in %d out %d ws %zu)\n", n_in, out_size, ws_size); grid = -1; return; }
        int dev = 0, cus = 0, per_cu = 0;
        if (hipGetDevice(&dev) != hipSuccess || hipDeviceGetAttribute(&cus, hipDeviceAttributeMultiprocessorCount, dev) != hipSuccess) { grid = -1; return; }
        if (hipFuncSetAttribute((const void*)skel_fwd, hipFuncAttributeMaxDynamicSharedMemorySize, LDS_BYTES) != hipSuccess) { fprintf(stderr, "kernel_launch: hipFuncSetAttribute failed\n"); grid = -1; return; }
        if (hipOccupancyMaxActiveBlocksPerMultiprocessor(&per_cu, (const void*)skel_fwd, NWAVES * 64, LDS_BYTES) != hipSuccess || per_cu < 1) fprintf(stderr, "kernel_launch: occupancy query reports %d\n", per_cu);
        (void)hipGetLastError();
        grid = cus;
    }
    if (grid < 0) return;
    (void)hipMemsetAsync((char*)d_ws + WS_CTL, 0, CTL_ZERO_BYTES, stream);
    Args a{};
    for (int i = 0; i < 19; ++i) a.in[i] = (const float*)d_in[i];
    a.out = (float*)d_out; a.ws = (unsigned char*)d_ws;
    int li = 0;
    auto launch = [&](int lo, int hi) { a.ph_lo = lo; a.ph_hi = hi; a.li = li++; hipLaunchKernelGGL(skel_fwd, dim3(grid), dim3(NWAVES * 64), LDS_BYTES, stream, a); };
    const unsigned mask = OPT_MASK;
#ifdef PROBE_SPLIT
    launch(0, PROBE_SPLIT + 1);
#ifdef PROBE_DUP
#ifdef PROBE_PAD
    a.pad = PROBE_PAD;
#endif
    launch(PROBE_SPLIT, PROBE_SPLIT + 1); a.pad = 0;
#endif
    launch(PROBE_SPLIT + 1, N_PHASES);
    return;
#endif
    int pend_lo = 0, pend_hi = 1;
    for (int s = 0; s < 10; ++s) {
#ifdef DBG_G1MASK
        if (s == 1 && (mask & 2u)) { launch(pend_lo, ST_PH_HI[1]); pend_lo = pend_hi = 0; gold_forward(d_in, (float*)d_out, (unsigned char*)d_ws, stream, 1, 2, DBG_G1MASK); continue; }
#endif
        if (mask & (1u << s)) { if (pend_hi == ST_PH_LO[s]) pend_hi = ST_PH_HI[s]; else { if (pend_hi > pend_lo) launch(pend_lo, pend_hi); pend_lo = ST_PH_LO[s]; pend_hi = ST_PH_HI[s]; } }
        else { if (pend_hi > pend_lo) launch(pend_lo, pend_hi); pend_lo = pend_hi = 0; gold_forward(d_in, (float*)d_out, (unsigned char*)d_ws, stream, s, s + 1); }
    }
    if (pend_hi > pend_lo) launch(pend_lo, pend_hi);
#ifdef PROBE_EXTRA
#ifndef PROBE_PAD
#define PROBE_PAD 0
#endif
    a.pad = PROBE_PAD; launch(PROBE_EXTRA, PROBE_EXTRA + 1);
#endif
}
```
